# Optimizing an MI355X kernel written in HIP

```python
import math
import jax, jax.numpy as jnp
from jax import lax
import numpy as np

D_MODEL = 1024
BATCH = 8
SEQ = 2048
DEPTH = 2

GRID_W = 64
CTX_LEN = 256

FOURIER_GROUPS = 4
FOURIER_GROUP_DIM = 64
FOURIER_WIDTH = FOURIER_GROUPS * FOURIER_GROUP_DIM
CONV_WIDTH = 256
CONV_K = 3
ATTN_HEADS = 4
QK_DIM = 64
V_DIM = 2 * QK_DIM
ATTN_QK_WIDTH = ATTN_HEADS * 2 * QK_DIM
ATTN_V_WIDTH = ATTN_HEADS * V_DIM
Q_BLOCK = 128
ROPE_BASE = 10000.0
ROPE_AXIS_DIM = QK_DIM // 2
N_BRANCH = 3
D_FF = -(-8 * D_MODEL // (3 * 256)) * 256
EPS = 1e-6

F_OFF = 0
CB_OFF = F_OFF + FOURIER_WIDTH
CC_OFF = CB_OFF + CONV_WIDTH
CX_OFF = CC_OFF + CONV_WIDTH
Q_OFF = CX_OFF + CONV_WIDTH
K_OFF = Q_OFF + ATTN_QK_WIDTH
V_OFF = K_OFF + ATTN_QK_WIDTH
G_OFF = V_OFF + ATTN_V_WIDTH
D_IN = G_OFF + N_BRANCH * D_MODEL

kernel_name = "hybrid_fourier_conv_diffattn_dit_block"


def rmsnorm(x, g):
    xf = x.astype(jnp.float32)
    y = xf * lax.rsqrt(jnp.mean(xf * xf, axis=-1, keepdims=True) + EPS)
    return (y * g.astype(jnp.float32)).astype(x.dtype)


def modulate(h, shift, scale):
    return h * (1 + scale[:, None, :]) + shift[:, None, :]


def rot_half(x, cos, sin):
    n = x.shape[-1] // 2
    x1, x2 = x[..., :n], x[..., n:]
    return jnp.concatenate([x1 * cos - x2 * sin, x2 * cos + x1 * sin], axis=-1)


def axial_rope(x, cos_r, sin_r, cos_c, sin_c):
    a = ROPE_AXIS_DIM
    return jnp.concatenate([rot_half(x[..., :a], cos_r, sin_r),
                            rot_half(x[..., a:], cos_c, sin_c)], axis=-1)


def rope_tables(pos, dtype):
    freqs = ROPE_BASE ** (-jnp.arange(0, ROPE_AXIS_DIM, 2, dtype=jnp.float32) / ROPE_AXIS_DIM)
    ang = pos.astype(jnp.float32)[:, None] * freqs[None, :]
    ang = ang[:, None, None, :]
    return jnp.cos(ang).astype(dtype), jnp.sin(ang).astype(dtype)


def split_qkv(p):
    B, L, _ = p.shape
    q = p[..., Q_OFF:K_OFF].reshape(B, L, ATTN_HEADS, 2, QK_DIM)
    k = p[..., K_OFF:V_OFF].reshape(B, L, ATTN_HEADS, 2, QK_DIM)
    v = p[..., V_OFF:G_OFF].reshape(B, L, ATTN_HEADS, V_DIM)
    return q, k, v


def to_heads_qk(t):
    return t.transpose(0, 2, 3, 1, 4)


def diff_attn_core(q, k, v, lam):
    s = jnp.einsum('bhcqd,bhckd->bhcqk', q, k).astype(jnp.float32) * (QK_DIM ** -0.5)
    pr = jax.nn.softmax(s, axis=-1)
    a = pr[:, :, 0] - lam * pr[:, :, 1]
    return jnp.einsum('bhqk,bhkv->bhqv', a.astype(v.dtype), v)


def diff_attn_blocked(q, k, v, lam):
    B, H, _, L, d = q.shape
    nb = L // Q_BLOCK
    qb = jnp.moveaxis(q.reshape(B, H, 2, nb, Q_BLOCK, d), 3, 0)
    ob = lax.map(lambda qi: diff_attn_core(qi, k, v, lam), qb)
    return jnp.moveaxis(ob, 0, 2).reshape(B, H, L, V_DIM)


def fourier_mix(u):
    B, L, _ = u.shape
    ug = u.astype(jnp.float32).reshape(B, L, FOURIER_GROUPS, FOURIER_GROUP_DIM)
    y = jnp.fft.fft2(ug, axes=(1, 3), norm='ortho').real
    return y.reshape(B, L, FOURIER_WIDTH).astype(u.dtype)


def short_gated_conv(bg, cg, xin, w, b):
    z = cg * xin
    zp = jnp.pad(z, ((0, 0), (1, 1), (0, 0)))
    conv = zp[:, :-2] * w[0] + zp[:, 1:-1] * w[1] + zp[:, 2:] * w[2] + b
    return bg * conv


def merge_branches(p, attn_o, lambda_init, conv_w, conv_b, w_fourier_out, w_conv_out,
                   w_attn_out, subln_g, w_out):
    B, L, _ = p.shape
    y_f = fourier_mix(p[..., F_OFF:CB_OFF]) @ w_fourier_out
    y_c = short_gated_conv(p[..., CB_OFF:CC_OFF], p[..., CC_OFF:CX_OFF], p[..., CX_OFF:Q_OFF],
                           conv_w, conv_b) @ w_conv_out
    o = rmsnorm(attn_o.transpose(0, 2, 1, 3), subln_g) * (1.0 - lambda_init)
    y_a = o.reshape(B, L, ATTN_V_WIDTH) @ w_attn_out
    gates = jax.nn.sigmoid(p[..., G_OFF:].reshape(B, L, N_BRANCH, D_MODEL))
    y = gates[:, :, 0] * y_f + gates[:, :, 1] * y_c + gates[:, :, 2] * y_a
    return y @ w_out


def swiglu(h, wg, wu, wd):
    return (jax.nn.silu(h @ wg) * (h @ wu)) @ wd


def setup_inputs(seed: int = 0) -> dict:
    key = jax.random.key(seed)
    ks = jax.random.split(key, 25)
    n = lambda k, shape, s: jax.random.normal(k, shape, jnp.float32) * s
    D = D_MODEL
    return {
        "x": n(ks[0], (BATCH, SEQ, D), 1.0),
        "c": n(ks[1], (BATCH, D), 1.0),
        "ctx": n(ks[2], (BATCH, CTX_LEN, D), 1.0),
        "c_ctx": n(ks[3], (D,), 1.0),
        "w_ada": n(ks[4], (DEPTH, D, 6 * D), 0.2 * D ** -0.5),
        "b_ada": n(ks[5], (DEPTH, 6 * D), 0.01),
        "norm1_g": 1.0 + n(ks[6], (DEPTH, D), 0.02),
        "norm2_g": 1.0 + n(ks[7], (DEPTH, D), 0.02),
        "w_in": n(ks[8], (DEPTH, D, D_IN), D ** -0.5),
        "b_in": n(ks[9], (DEPTH, D_IN), 0.01),
        "conv_w": n(ks[10], (DEPTH, CONV_K, CONV_WIDTH), CONV_K ** -0.5),
        "conv_b": n(ks[11], (DEPTH, CONV_WIDTH), 0.01),
        "w_fourier_out": n(ks[12], (DEPTH, FOURIER_WIDTH, D), FOURIER_WIDTH ** -0.5),
        "w_conv_out": n(ks[13], (DEPTH, CONV_WIDTH, D), CONV_WIDTH ** -0.5),
        "w_attn_out": n(ks[14], (DEPTH, ATTN_V_WIDTH, D), ATTN_V_WIDTH ** -0.5),
        "lambda_q1": n(ks[15], (DEPTH, QK_DIM), 0.1),
        "lambda_k1": n(ks[16], (DEPTH, QK_DIM), 0.1),
        "lambda_q2": n(ks[17], (DEPTH, QK_DIM), 0.1),
        "lambda_k2": n(ks[18], (DEPTH, QK_DIM), 0.1),
        "subln_g": 1.0 + n(ks[19], (DEPTH, V_DIM), 0.02),
        "w_out": n(ks[20], (DEPTH, D, D), D ** -0.5),
        "w_ffn_gate": n(ks[21], (DEPTH, D, D_FF), D ** -0.5),
        "w_ffn_up": n(ks[22], (DEPTH, D, D_FF), D ** -0.5),
        "w_ffn_down": n(ks[23], (DEPTH, D_FF, D), D_FF ** -0.5),
        "final_g": 1.0 + n(ks[24], (D,), 0.02),
    }


def reference(x, c, ctx, c_ctx, w_ada, b_ada, norm1_g, norm2_g, w_in, b_in, conv_w, conv_b,
              w_fourier_out, w_conv_out, w_attn_out, lambda_q1, lambda_k1, lambda_q2, lambda_k2,
              subln_g, w_out, w_ffn_gate, w_ffn_up, w_ffn_down, final_g):
    L = x.shape[1]
    n_rows = L // GRID_W
    row = jnp.repeat(jnp.arange(n_rows), GRID_W)
    col = jnp.tile(jnp.arange(GRID_W), n_rows)
    cos_r, sin_r = rope_tables(row, x.dtype)
    cos_c, sin_c = rope_tables(col, x.dtype)

    s_c = jax.nn.silu(c)
    s_cc = jax.nn.silu(c_ctx)[None, :]
    xl, xc = x, ctx
    for l in range(DEPTH):
        last = l == DEPTH - 1
        lambda_init = 0.8 - 0.6 * math.exp(-0.3 * l)
        mod = s_c @ w_ada[l] + b_ada[l]
        modc = s_cc @ w_ada[l] + b_ada[l]
        sh1, sc1, g1, sh2, sc2, g2 = jnp.split(mod, 6, axis=-1)
        csh1, csc1, cg1, csh2, csc2, cg2 = jnp.split(modc, 6, axis=-1)

        h = modulate(rmsnorm(xl, norm1_g[l]), sh1, sc1)
        hc = modulate(rmsnorm(xc, norm1_g[l]), csh1, csc1)
        p = h @ w_in[l] + b_in[l]
        pc = hc @ w_in[l] + b_in[l]

        q, k, v = split_qkv(p)
        q = axial_rope(q, cos_r, sin_r, cos_c, sin_c)
        k = axial_rope(k, cos_r, sin_r, cos_c, sin_c)
        qc, kc, vc = split_qkv(pc)
        q, k, qc, kc = to_heads_qk(q), to_heads_qk(k), to_heads_qk(qc), to_heads_qk(kc)
        v, vc = v.transpose(0, 2, 1, 3), vc.transpose(0, 2, 1, 3)

        lam = (jnp.exp(jnp.sum(lambda_q1[l].astype(jnp.float32) * lambda_k1[l].astype(jnp.float32)))
               - jnp.exp(jnp.sum(lambda_q2[l].astype(jnp.float32) * lambda_k2[l].astype(jnp.float32)))
               + lambda_init)

        k_all = jnp.concatenate([k, kc], axis=3)
        v_all = jnp.concatenate([v, vc], axis=2)
        o = diff_attn_blocked(q, k_all, v_all, lam)

        xl = xl + g1[:, None, :] * merge_branches(p, o, lambda_init, conv_w[l], conv_b[l],
                                                  w_fourier_out[l], w_conv_out[l], w_attn_out[l],
                                                  subln_g[l], w_out[l])
        h2 = modulate(rmsnorm(xl, norm2_g[l]), sh2, sc2)
        xl = xl + g2[:, None, :] * swiglu(h2, w_ffn_gate[l], w_ffn_up[l], w_ffn_down[l])

        if not last:
            oc = diff_attn_core(qc, kc, vc, lam)
            xc = xc + cg1[:, None, :] * merge_branches(pc, oc, lambda_init, conv_w[l], conv_b[l],
                                                       w_fourier_out[l], w_conv_out[l],
                                                       w_attn_out[l], subln_g[l], w_out[l])
            hc2 = modulate(rmsnorm(xc, norm2_g[l]), csh2, csc2)
            xc = xc + cg2[:, None, :] * swiglu(hc2, w_ffn_gate[l], w_ffn_up[l], w_ffn_down[l])

    return rmsnorm(xl, final_g)
```

```cpp
#include <hip/hip_runtime.h>
#include <hip/hip_cooperative_groups.h>
#include <cstdio>
#include <cstdint>
namespace cg = cooperative_groups;

#ifndef PROBE_ATT
#define PROBE_ATT 0
#endif
#ifndef PROBE_FOUR
#define PROBE_FOUR 0
#endif
#ifndef DUP_MASK
#define DUP_MASK 0
#endif
#ifndef MK_MULTI_LAUNCH
#define MK_MULTI_LAUNCH 0
#endif

#define LAS __attribute__((address_space(3)))
#define GAS __attribute__((address_space(1)))
typedef unsigned short bf16_t;
typedef short bf16x8 __attribute__((ext_vector_type(8)));
typedef short s16x4 __attribute__((ext_vector_type(4)));
typedef float f32x4 __attribute__((ext_vector_type(4)));
typedef float f32x16 __attribute__((ext_vector_type(16)));
typedef unsigned u32x4 __attribute__((ext_vector_type(4)));
typedef unsigned u32x2 __attribute__((ext_vector_type(2)));

constexpr int D = 1024, NB = 8, SEQ = 2048, CTXL = 256, DFF = 2816;
constexpr int ML = NB * SEQ;
constexpr int MC = NB * CTXL;
constexpr int MT = ML + MC;
constexpr int DIN = 5632;
constexpr int NIN = 5888;
constexpr int NP1 = 2816;
constexpr int LDP = 2304;
constexpr int PCB = 0, PCC = 256, PCX = 512, PQ = 768, PK = 1280, PV = 1792;
constexpr float QSCALE = 0.125f * 1.4426950408889634f;
constexpr float EPS = 1e-6f;

constexpr size_t MiB = 1u << 20;
constexpr size_t WS_MOD = 0;
constexpr size_t WS_ROPE = 448 * 1024;
constexpr size_t WS_BIASIN = 464 * 1024;
constexpr size_t WS_LAM = 1020 * 1024;
constexpr size_t WS_DFT256 = 1 * MiB;
constexpr size_t WS_DFT = 2 * MiB;
constexpr size_t WS_XC = 18 * MiB;
constexpr size_t WS_WIN = 26 * MiB;
constexpr size_t WS_WB = WS_WIN + 5888 * 1024 * 2;
constexpr size_t WS_WOUT = WS_WB + 2 * MiB;
constexpr size_t WS_WGU0 = WS_WOUT + 2 * MiB;
constexpr size_t WS_WD0 = WS_WGU0 + 11 * MiB;
constexpr size_t WS_WGU1 = WS_WD0 + 5632 * 1024;
constexpr size_t WS_WD1 = WS_WGU1 + 11 * MiB;
constexpr size_t WS_H = 75 * MiB;
constexpr size_t WS_BR = 111 * MiB;
constexpr size_t WS_P = 147 * MiB;
constexpr size_t WS_FT0 = WS_WGU1, WS_FT1 = WS_WGU0, WS_FTC = WS_XC;
constexpr size_t WS_BAR = 255 * MiB;
constexpr size_t WS_END = 255 * MiB + 65536;
static_assert(WS_WD1 + 5632 * 1024 <= WS_H && WS_FT0 + 16 * MiB <= WS_H && WS_FT1 + 16 * MiB <= WS_WGU1, "ws map");
static_assert((size_t)MT * LDP * 2 <= 81 * MiB && (size_t)MT * 3072 * 2 <= 108 * MiB, "ws map");

constexpr int LDS_BYTES = 147456;
constexpr int LDS_XB = 144384;
constexpr int LDS_COSTAB = 131072;

typedef float f32x2_t __attribute__((ext_vector_type(2))); typedef __bf16 bf16x2_t __attribute__((ext_vector_type(2)));
__device__ __forceinline__ unsigned cvt_pk_bf16(float lo, float hi) { f32x2_t v = {lo, hi}; bf16x2_t b = __builtin_convertvector(v, bf16x2_t); return __builtin_bit_cast(unsigned, b); }
__device__ __forceinline__ unsigned f2bf(float f) { unsigned u = __float_as_uint(f); return (u + 0x7fffu + ((u >> 16) & 1u)) >> 16; }
__device__ __forceinline__ unsigned pk2(float lo, float hi) { return f2bf(lo) | (f2bf(hi) << 16); }
__device__ __forceinline__ float bflo(unsigned w) { return __uint_as_float(w << 16); }
__device__ __forceinline__ float bfhi(unsigned w) { return __uint_as_float(w & 0xffff0000u); }
__device__ __forceinline__ float fast_exp2(float x) { return __builtin_amdgcn_exp2f(x); }
__device__ __forceinline__ float fast_rcp(float x) { return __builtin_amdgcn_rcpf(x); }
__device__ __forceinline__ float sigmoidf_(float x) { return fast_rcp(1.0f + fast_exp2(-1.4426950408889634f * x)); }
__device__ __forceinline__ float wave_sum(float v) {
#pragma unroll
    for (int o = 1; o < 64; o <<= 1) v += __shfl_xor(v, o);
    return v;
}

namespace pg8 {
constexpr int BM = 256, BK = 64, HALF = 128, HTB = HALF * BK * 2, STAGE_BYTES = 8 * HTB, NXCD = 8, WGM = 8;
__host__ __device__ __forceinline__ int lds_byte(int r, int c) { const int st = (r >> 4) * 2 + (c >> 5), rr = r & 15, cc = c & 31, ob = rr * 64 + cc * 2; return st * 1024 + (ob ^ (((ob >> 9) & 1) << 5)); }
__host__ __device__ __forceinline__ void stage_rc(int b, int& R, int& C) { const int st = b / 1024, sb = b % 1024, swz = sb ^ (((sb >> 9) & 1) << 5); R = (st >> 1) * 16 + swz / 64; C = (st & 1) * 32 + (swz % 64) / 2; }
__host__ __device__ __forceinline__ int perm32(int rho) { const int n = rho >> 4, i = rho & 15; return 8 * (i >> 2) + 4 * n + (i & 3); }
struct Unit { int pm, pn; };
struct Gemm { const bf16_t* A; const bf16_t* Bt; int M, N, K, lda, ldb; };
struct StaticOrder {
    int nM, nN, nwg, G, c;
    __device__ void init(int M, int N, int G_, int c_) { nM = M / BM; nN = N / BM; nwg = nM * nN; G = G_; c = c_; }
    __device__ bool next(int i, Unit& u) const {
        const long L = (long)i * G + c; if (L >= nwg) return false;
        int wgid = (int)L; { const int q = nwg / NXCD, r = nwg % NXCD, xcd = wgid % NXCD, off = wgid / NXCD; wgid = (xcd < r ? xcd * (q + 1) : r * (q + 1) + (xcd - r) * q) + off; }
        const int nig = WGM * nN, gid = wgid / nig, fm = gid * WGM, gsz = (nM - fm) < WGM ? (nM - fm) : WGM;
        u.pm = fm + ((wgid % nig) % gsz); u.pn = (wgid % nig) / gsz; return true;
    }
};

template <class Epi, class Sched>
__device__ __forceinline__ void gemm_phase(LAS unsigned char* lds, const Gemm g, const Sched& S, const Epi& E, const int tid) {
    const int wid = __builtin_amdgcn_readfirstlane(tid >> 6), lane = tid & 63, wr = wid >> 2, wc = wid & 3, fr = lane & 15, fq = lane >> 4;
    const int K = g.K, nt = K / BK;
    unsigned voffA[2], voffB[2];
#pragma unroll
    for (int i = 0; i < 2; ++i) { int R, C; stage_rc(tid * 16 + i * 8192, R, C); const int Rb = (R & ~31) + perm32(R & 31);
        voffA[i] = (unsigned)(R * g.lda + C) * 2u; voffB[i] = (unsigned)(Rb * g.ldb + C) * 2u; }
    const size_t kstep = (size_t)(BK * 2);
    const size_t hA = (size_t)HALF * g.lda * 2, hB = (size_t)HALF * g.ldb * 2;
    const size_t tA = 2 * hA, tB = 2 * hB;
    const unsigned ldsw = (unsigned)wid * 1024u;
    const int aoff = lds_byte(wr * 64 + fr, fq * 8), boff = lds_byte(wc * 32 + fr, fq * 8);
#define PG8_SA(b, h) (((b) * 2 + (h)) * HTB)
#define PG8_SB(b, h) ((4 + (b) * 2 + (h)) * HTB)
#define PG8_STAGE(bufoff, gbase, voff) do { _Pragma("unroll") for (int _i = 0; _i < 2; ++_i) \
        __builtin_amdgcn_global_load_lds((const unsigned*)((const char*)(gbase) + (voff)[_i]), (LAS unsigned*)(lds + (bufoff) + ldsw + _i * 8192), 16, 0, 0); } while (0)
#define PG8_LDA(dst, b, h) do { _Pragma("unroll") for (int m = 0; m < 4; ++m) _Pragma("unroll") for (int k = 0; k < 2; ++k) dst[m][k] = *(const LAS bf16x8*)(lds + PG8_SA(b, h) + aoff + m * 2048 + k * 1024); } while (0)
#define PG8_LDB(dst, b, h) do { _Pragma("unroll") for (int n = 0; n < 2; ++n) _Pragma("unroll") for (int k = 0; k < 2; ++k) dst[n][k] = *(const LAS bf16x8*)(lds + PG8_SB(b, h) + boff + n * 2048 + k * 1024); } while (0)
#define PG8_MMA(ai, bj, At, Bt) do { __builtin_amdgcn_s_setprio(1); _Pragma("unroll") for (int m = 0; m < 4; ++m) _Pragma("unroll") for (int n = 0; n < 2; ++n) _Pragma("unroll") for (int k = 0; k < 2; ++k) \
        acc[ai][bj][m][n] = __builtin_amdgcn_mfma_f32_16x16x32_bf16(Bt[n][k], At[m][k], acc[ai][bj][m][n], 0, 0, 0); __builtin_amdgcn_s_setprio(0); } while (0)
#define PG8_WAIT_V(n) asm volatile("s_waitcnt vmcnt(" #n ")" ::: "memory")
#define PG8_WAIT_L(n) asm volatile("s_waitcnt lgkmcnt(" #n ")" ::: "memory")
#define PG8_BAR __builtin_amdgcn_s_barrier()
#define PG8_SCHED __builtin_amdgcn_sched_barrier(0)
    Unit cur, nxt; int ui = 0;
    if (!S.next(0, cur)) return;
    const bool hz = E.horner();
    f32x4 acc[2][2][4][2];
#pragma unroll
    for (int a = 0; a < 2; ++a)
#pragma unroll
        for (int b = 0; b < 2; ++b)
#pragma unroll
            for (int m = 0; m < 4; ++m)
#pragma unroll
                for (int n = 0; n < 2; ++n) acc[a][b][m][n] = (f32x4){0.f, 0.f, 0.f, 0.f};
    bf16x8 At[4][2], B0[2][2], B1[2][2];
    const char* cA = (const char*)g.A + (size_t)cur.pm * tA; const char* cB = (const char*)g.Bt + (size_t)cur.pn * tB;
    PG8_STAGE(PG8_SB(0, 0), cB, voffB); PG8_STAGE(PG8_SB(0, 1), cB + hB, voffB); PG8_STAGE(PG8_SA(0, 0), cA, voffA); PG8_STAGE(PG8_SA(0, 1), cA + hA, voffA);
    if (wr == 1) PG8_BAR;
    PG8_WAIT_V(2); PG8_BAR;
    PG8_STAGE(PG8_SB(1, 0), cB + kstep, voffB); PG8_STAGE(PG8_SA(1, 0), cA + kstep, voffA); PG8_STAGE(PG8_SB(1, 1), cB + hB + kstep, voffB);
    PG8_WAIT_V(6); PG8_BAR;
    for (;;) {
        const bool has_next = S.next(ui + 1, nxt);
        const char* nA = has_next ? (const char*)g.A + (size_t)nxt.pm * tA : cA; const char* nB = has_next ? (const char*)g.Bt + (size_t)nxt.pn * tB : cB;
        for (int t = 0; t < nt; t += 2) {
            if (hz && (t == 4 || t == 8)) E.mid(acc, cur, t >> 3, wr, wc, fr, fq);
            const bool last = (t == nt - 2);
            const char* a1 = cA + (size_t)(t + 1) * kstep;
            const char* a2 = last ? nA : cA + (size_t)(t + 2) * kstep; const char* b2 = last ? nB : cB + (size_t)(t + 2) * kstep;
            const char* a3 = a2 + kstep; const char* b3 = b2 + kstep;
            PG8_LDB(B0, 0, 0); PG8_LDB(B1, 0, 1); PG8_SCHED; PG8_LDA(At, 0, 0); PG8_STAGE(PG8_SA(1, 1), a1 + hA, voffA);
            PG8_WAIT_V(8); PG8_WAIT_L(0); PG8_BAR; PG8_MMA(0, 0, At, B0); PG8_MMA(0, 1, At, B1); PG8_BAR; PG8_SCHED;
            PG8_LDA(At, 0, 1); PG8_STAGE(PG8_SB(0, 0), b2, voffB); PG8_STAGE(PG8_SB(0, 1), b2 + hB, voffB); PG8_STAGE(PG8_SA(0, 0), a2, voffA);
            PG8_WAIT_V(8); PG8_WAIT_L(0); PG8_BAR; PG8_MMA(1, 0, At, B0); PG8_MMA(1, 1, At, B1); PG8_BAR; PG8_SCHED;
            PG8_LDB(B0, 1, 0); PG8_LDB(B1, 1, 1); PG8_SCHED; PG8_LDA(At, 1, 0); PG8_STAGE(PG8_SA(0, 1), a2 + hA, voffA);
            PG8_WAIT_V(8); PG8_WAIT_L(0); PG8_BAR; PG8_MMA(0, 0, At, B0); PG8_MMA(0, 1, At, B1); PG8_BAR; PG8_SCHED;
            PG8_LDA(At, 1, 1); PG8_STAGE(PG8_SB(1, 0), b3, voffB); PG8_STAGE(PG8_SB(1, 1), b3 + hB, voffB); PG8_STAGE(PG8_SA(1, 0), a3, voffA);
            PG8_WAIT_V(8); PG8_WAIT_L(0); PG8_BAR; PG8_MMA(1, 0, At, B0); PG8_MMA(1, 1, At, B1); PG8_BAR; PG8_SCHED;
        }
        if (wr == 0) PG8_BAR;
        E(acc, cur, wr, wc, fr, fq);
        if (!has_next) break;
#pragma unroll
        for (int a = 0; a < 2; ++a)
#pragma unroll
            for (int b = 0; b < 2; ++b)
#pragma unroll
                for (int m = 0; m < 4; ++m)
#pragma unroll
                    for (int n = 0; n < 2; ++n) acc[a][b][m][n] = (f32x4){0.f, 0.f, 0.f, 0.f};
        cur = nxt; cA = nA; cB = nB; ++ui;
        if (wr == 1) PG8_BAR;
    }
    PG8_WAIT_V(0);
    PG8_BAR;
#undef PG8_SA
#undef PG8_SB
#undef PG8_STAGE
#undef PG8_LDA
#undef PG8_LDB
#undef PG8_MMA
#undef PG8_WAIT_V
#undef PG8_WAIT_L
#undef PG8_BAR
#undef PG8_SCHED
}
}

enum { E_INPROJ = 0, E_GATE = 1, E_BRANCH = 2, E_RESID = 3, E_GU = 4, E_FOUR = 5 };
constexpr int LDS_EPI = 143360;
struct EpiD {
    int mode;
    int row_base;
    int ctx;
    int aux;
    float scale;
    int pad;
    void* out;
    const void* p1;
    const void* p2;
    void* p3; void* p4;
};
#define RFL2(x) ((unsigned)__builtin_amdgcn_readfirstlane((int)(x)))
struct Epi {
    const LAS unsigned* ed;
    __device__ __forceinline__ bool horner() const { return __builtin_amdgcn_readfirstlane((int)ed[0]) == E_BRANCH; }
    __device__ __forceinline__ void mid(f32x4 (&acc)[2][2][4][2], const pg8::Unit& u, int which, int wr, int wc, int fr, int fq) const {
        asm volatile("" : "+v"(fr), "+v"(fq));
        const int row_base = __builtin_amdgcn_readfirstlane((int)ed[1]);
        const unsigned lo = (unsigned)__builtin_amdgcn_readfirstlane((int)ed[8]), hi_ = (unsigned)__builtin_amdgcn_readfirstlane((int)ed[9]);
        const bf16_t* gbase = (const bf16_t*)(((unsigned long long)hi_ << 32) | lo) + (size_t)(row_base + u.pm * 256 + wr * 64 + fr) * 3072 + which * 1024 + u.pn * 256 + wc * 32 + 8 * fq;
#pragma unroll
        for (int ai = 0; ai < 2; ++ai) {
            u32x4 na[4][2], nb[4][2];
#pragma unroll
            for (int m = 0; m < 4; ++m)
#pragma unroll
                for (int bj = 0; bj < 2; ++bj) { const bf16_t* gp = gbase + (size_t)(ai * 128 + m * 16) * 3072 + bj * 128; na[m][bj] = *(const GAS u32x4*)gp; nb[m][bj] = *(const GAS u32x4*)(gp + 1024); }
            __builtin_amdgcn_sched_barrier(0);
#pragma unroll
            for (int m = 0; m < 4; ++m)
#pragma unroll
                for (int bj = 0; bj < 2; ++bj) {
                    const u32x4 xa = na[m][bj], xb = nb[m][bj];
                    f32x4 r0, r1;
                    r0[0] = bflo(xa.x) * fast_rcp(bflo(xb.x)); r0[1] = bfhi(xa.x) * fast_rcp(bfhi(xb.x)); r0[2] = bflo(xa.y) * fast_rcp(bflo(xb.y)); r0[3] = bfhi(xa.y) * fast_rcp(bfhi(xb.y));
                    r1[0] = bflo(xa.z) * fast_rcp(bflo(xb.z)); r1[1] = bfhi(xa.z) * fast_rcp(bfhi(xb.z)); r1[2] = bflo(xa.w) * fast_rcp(bflo(xb.w)); r1[3] = bfhi(xa.w) * fast_rcp(bfhi(xb.w));
                    acc[ai][bj][m][0] = acc[ai][bj][m][0] * r0; acc[ai][bj][m][1] = acc[ai][bj][m][1] * r1;
                }
            __builtin_amdgcn_sched_barrier(0);
        }
    }
    __device__ __forceinline__ void operator()(const f32x4 (&acc)[2][2][4][2], const pg8::Unit& u, int wr, int wc, int fr, int fq) const {
        asm volatile("" : "+v"(fr), "+v"(fq));
#define RFL(x) ((unsigned)__builtin_amdgcn_readfirstlane((int)(x)))
        const int mode = (int)RFL(ed[0]), row_base = (int)RFL(ed[1]), ctx = (int)RFL(ed[2]), aux = (int)RFL(ed[3]);
        const float scale = __uint_as_float(RFL(ed[4]));
        void* const out = (void*)(((unsigned long long)RFL(ed[7]) << 32) | RFL(ed[6]));
        const void* const p1 = (const void*)(((unsigned long long)RFL(ed[9]) << 32) | RFL(ed[8]));
        const void* const p2 = (const void*)(((unsigned long long)RFL(ed[11]) << 32) | RFL(ed[10]));
#undef RFL
        const int r0 = u.pm * 256 + wr * 64 + fr;
        const int c0 = wc * 32 + 8 * fq;
        const int colt = u.pn * 256;
        if (mode == E_INPROJ) {
            const int ct = aux + u.pn;
            const float* bias = (const float*)p1;
            if (ct < 2) {
                const int gpm = (row_base >> 8) + u.pm;
                bf16_t* dst; int ld, n0;
                if (ctx) { const int b = gpm - 64; dst = (bf16_t*)(((unsigned long long)RFL2(ed[15]) << 32) | RFL2(ed[14])) + (size_t)(b * 256) * 512 + ct * 256; ld = 512; n0 = 0; }
                else { const int b = gpm >> 3; dst = (bf16_t*)(((unsigned long long)RFL2(ed[13]) << 32) | RFL2(ed[12])) + (size_t)(b * 256) * 4096 + ct * 2048; ld = 4096; n0 = (gpm & 7) * 256; }
                LAS unsigned char* stg = (LAS unsigned char*)ed - LDS_EPI + 131072 + (wr * 4 + wc) * 1536;
                const int lane_ = fq * 16 + fr, tcol = lane_ >> 1, thalf = lane_ & 1;
#pragma unroll
                for (int bj = 0; bj < 2; ++bj) {
                    const f32x4 b0 = *(const GAS f32x4*)(bias + colt + bj * 128 + c0), b1 = *(const GAS f32x4*)(bias + colt + bj * 128 + c0 + 4);
                    bf16_t* dcol = dst + (size_t)(bj * 128 + wc * 32 + tcol) * ld + n0 + wr * 64 + thalf * 8;
#pragma unroll
                    for (int ai = 0; ai < 2; ++ai)
#pragma unroll
                        for (int m = 0; m < 4; ++m) {
                            const f32x4 v0 = acc[ai][bj][m][0] + b0, v1 = acc[ai][bj][m][1] + b1;
                            LAS bf16_t* sp = (LAS bf16_t*)stg + (fq * 8) * 16 + fr;
                            sp[0 * 16] = (bf16_t)f2bf(v0[0]); sp[1 * 16] = (bf16_t)f2bf(v0[1]); sp[2 * 16] = (bf16_t)f2bf(v0[2]); sp[3 * 16] = (bf16_t)f2bf(v0[3]);
                            sp[4 * 16] = (bf16_t)f2bf(v1[0]); sp[5 * 16] = (bf16_t)f2bf(v1[1]); sp[6 * 16] = (bf16_t)f2bf(v1[2]); sp[7 * 16] = (bf16_t)f2bf(v1[3]);
                            asm volatile("s_waitcnt lgkmcnt(0)" ::: "memory");
                            const u32x4 w = *(const LAS u32x4*)(stg + tcol * 32 + thalf * 16);
                            *(GAS u32x4*)(dcol + ai * 128 + m * 16) = w;
                            asm volatile("s_waitcnt lgkmcnt(0)" ::: "memory");
                        }
                }
            } else {
                const bool isqk = (ct >= 5 && ct <= 8), dorope = isqk && !ctx;
                const float sc = (ct == 5 || ct == 6) ? QSCALE : 1.0f;
                const int axis = wc & 1, half = fq >> 1;
                const float* rope = (const float*)p2 + 8 * (fq & 1);
                bf16_t* obase = (bf16_t*)out + (size_t)(row_base + r0) * LDP + (ct - 2) * 256 + c0;
#pragma unroll
                for (int bj = 0; bj < 2; ++bj) {
                    const f32x4 b0 = *(const GAS f32x4*)(bias + colt + bj * 128 + c0), b1 = *(const GAS f32x4*)(bias + colt + bj * 128 + c0 + 4);
#pragma unroll
                    for (int ai = 0; ai < 2; ++ai)
#pragma unroll
                        for (int m = 0; m < 4; ++m) {
                            f32x4 v0 = acc[ai][bj][m][0] + b0, v1 = acc[ai][bj][m][1] + b1;
                            if (dorope) {
                                const int t = (row_base + r0 + ai * 128 + m * 16) & 2047, pos = axis ? (t & 63) : (t >> 6);
                                const float* cp = rope + pos * 16;
                                const f32x4 cs0 = *(const GAS f32x4*)cp, cs1 = *(const GAS f32x4*)(cp + 4), sn0 = *(const GAS f32x4*)(cp + 1024), sn1 = *(const GAS f32x4*)(cp + 1028);
                                f32x4 w0, w1;
#pragma unroll
                                for (int j = 0; j < 4; ++j) { w0[j] = __shfl_xor(v0[j], 32); w1[j] = __shfl_xor(v1[j], 32); }
                                if (half) { v0 = v0 * cs0 + w0 * sn0; v1 = v1 * cs1 + w1 * sn1; }
                                else { v0 = v0 * cs0 - w0 * sn0; v1 = v1 * cs1 - w1 * sn1; }
                            }
                            v0 = v0 * sc; v1 = v1 * sc;
                            u32x4 w; w.x = cvt_pk_bf16(v0[0], v0[1]); w.y = cvt_pk_bf16(v0[2], v0[3]); w.z = cvt_pk_bf16(v1[0], v1[1]); w.w = cvt_pk_bf16(v1[2], v1[3]);
                            *(GAS u32x4*)(obase + (size_t)(ai * 128 + m * 16) * LDP + bj * 128) = w;
                        }
                }
            }
        } else if (mode == E_GATE) {
            const float* bias = (const float*)p1;
            bf16_t* obase = (bf16_t*)out + (size_t)(row_base + r0) * 3072 + colt + c0;
#pragma unroll
            for (int bj = 0; bj < 2; ++bj) {
                const f32x4 b0 = *(const GAS f32x4*)(bias + colt + bj * 128 + c0), b1 = *(const GAS f32x4*)(bias + colt + bj * 128 + c0 + 4);
#pragma unroll
                for (int ai = 0; ai < 2; ++ai)
#pragma unroll
                    for (int m = 0; m < 4; ++m) {
                        f32x4 v0 = acc[ai][bj][m][0] + b0, v1 = acc[ai][bj][m][1] + b1;
#pragma unroll
                        for (int j = 0; j < 4; ++j) { v0[j] = fmaxf(sigmoidf_(v0[j]), 1e-18f); v1[j] = fmaxf(sigmoidf_(v1[j]), 1e-18f); }
                        u32x4 w; w.x = cvt_pk_bf16(v0[0], v0[1]); w.y = cvt_pk_bf16(v0[2], v0[3]); w.z = cvt_pk_bf16(v1[0], v1[1]); w.w = cvt_pk_bf16(v1[2], v1[3]);
                        *(GAS u32x4*)(obase + (size_t)(ai * 128 + m * 16) * 3072 + bj * 128) = w;
                    }
            }
        } else if (mode == E_BRANCH) {
            const bf16_t* gbase = (const bf16_t*)p1 + (size_t)(row_base + r0) * 3072 + 2048 + colt + c0;
            bf16_t* ybase = (bf16_t*)out + (size_t)(row_base + r0) * 1024 + colt + c0;
            u32x4 gw[2][4][2];
#pragma unroll
            for (int ai = 0; ai < 2; ++ai)
#pragma unroll
                for (int m = 0; m < 4; ++m)
#pragma unroll
                    for (int bj = 0; bj < 2; ++bj) gw[ai][m][bj] = *(const GAS u32x4*)(gbase + (size_t)(ai * 128 + m * 16) * 3072 + bj * 128);
            __builtin_amdgcn_sched_barrier(0);
#pragma unroll
            for (int ai = 0; ai < 2; ++ai)
#pragma unroll
                for (int m = 0; m < 4; ++m) {
#pragma unroll
                    for (int bj = 0; bj < 2; ++bj) {
                        const u32x4 g = gw[ai][m][bj];
                        const f32x4 g0 = (f32x4){bflo(g.x), bfhi(g.x), bflo(g.y), bfhi(g.y)}, g1 = (f32x4){bflo(g.z), bfhi(g.z), bflo(g.w), bfhi(g.w)};
                        const f32x4 y0 = g0 * acc[ai][bj][m][0], y1 = g1 * acc[ai][bj][m][1];
                        u32x4 w; w.x = cvt_pk_bf16(y0[0], y0[1]); w.y = cvt_pk_bf16(y0[2], y0[3]); w.z = cvt_pk_bf16(y1[0], y1[1]); w.w = cvt_pk_bf16(y1[2], y1[3]);
                        *(GAS u32x4*)(ybase + (size_t)(ai * 128 + m * 16) * 1024 + bj * 128) = w;
                    }
                }
        } else if (mode == E_RESID) {
            const float* xin = (const float*)p1 + (size_t)r0 * 1024 + colt + c0;
            float* xout = (float*)out + (size_t)r0 * 1024 + colt + c0;
            const int b = ctx ? 8 : (u.pm >> 3);
            const float* modg = (const float*)p2 + (size_t)b * 6144 + colt + c0;
            f32x4 gv[2][2];
#pragma unroll
            for (int bj = 0; bj < 2; ++bj) { gv[bj][0] = *(const GAS f32x4*)(modg + bj * 128); gv[bj][1] = *(const GAS f32x4*)(modg + bj * 128 + 4); }
#pragma unroll
            for (int ai = 0; ai < 2; ++ai) {
                f32x4 xv[4][2][2];
#pragma unroll
                for (int m = 0; m < 4; ++m)
#pragma unroll
                    for (int bj = 0; bj < 2; ++bj) { const float* xi = xin + (size_t)(ai * 128 + m * 16) * 1024 + bj * 128; xv[m][bj][0] = *(const GAS f32x4*)xi; xv[m][bj][1] = *(const GAS f32x4*)(xi + 4); }
                __builtin_amdgcn_sched_barrier(0);
#pragma unroll
                for (int m = 0; m < 4; ++m)
#pragma unroll
                    for (int bj = 0; bj < 2; ++bj) { float* xo = xout + (size_t)(ai * 128 + m * 16) * 1024 + bj * 128;
                        *(GAS f32x4*)xo = xv[m][bj][0] + gv[bj][0] * acc[ai][bj][m][0]; *(GAS f32x4*)(xo + 4) = xv[m][bj][1] + gv[bj][1] * acc[ai][bj][m][1]; }
                __builtin_amdgcn_sched_barrier(0);
            }
        } else if (mode == E_GU) {
            bf16_t* obase = (bf16_t*)out + (size_t)(row_base + r0) * DFF + u.pn * 128 + c0;
#pragma unroll
            for (int ai = 0; ai < 2; ++ai)
#pragma unroll
                for (int m = 0; m < 4; ++m) {
                    f32x4 v0, v1;
#pragma unroll
                    for (int j = 0; j < 4; ++j) { const float a = acc[ai][0][m][0][j], b = acc[ai][0][m][1][j];
                        v0[j] = a * sigmoidf_(a) * acc[ai][1][m][0][j]; v1[j] = b * sigmoidf_(b) * acc[ai][1][m][1][j]; }
                    u32x4 w; w.x = cvt_pk_bf16(v0[0], v0[1]); w.y = cvt_pk_bf16(v0[2], v0[3]); w.z = cvt_pk_bf16(v1[0], v1[1]); w.w = cvt_pk_bf16(v1[2], v1[3]);
                    *(GAS u32x4*)(obase + (size_t)(ai * 128 + m * 16) * DFF) = w;
                }
        } else {
            const int L = ctx ? CTXL : SEQ;
            bf16_t* obase = (bf16_t*)out + (size_t)(row_base + u.pn * L + r0) * 1024 + c0;
#pragma unroll
            for (int ai = 0; ai < 2; ++ai)
#pragma unroll
                for (int m = 0; m < 4; ++m) {
#pragma unroll
                    for (int bj = 0; bj < 2; ++bj) {
                        const f32x4 v0 = acc[ai][bj][m][0] * scale, v1 = acc[ai][bj][m][1] * scale;
                        u32x4 w; w.x = cvt_pk_bf16(v0[0], v0[1]); w.y = cvt_pk_bf16(v0[2], v0[3]); w.z = cvt_pk_bf16(v1[0], v1[1]); w.w = cvt_pk_bf16(v1[2], v1[3]);
                        *(GAS u32x4*)(obase + (size_t)(ai * 128 + m * 16) * 1024 + bj * 128) = w;
                    }
                }
        }
    }
};

struct Args {
    const float* in[25];
    float* out; unsigned char* ws;
    int ph_lo, ph_hi;
};
enum { I_X = 0, I_C, I_CTX, I_CCTX, I_WADA, I_BADA, I_N1G, I_N2G, I_WIN, I_BIN, I_CONVW, I_CONVB, I_WFO, I_WCO, I_WAO, I_LQ1, I_LK1, I_LQ2, I_LK2, I_SUBG, I_WOUT, I_WG, I_WU, I_WD, I_FING };

struct Frame {
    LAS unsigned char* lds;
    int tid, lane, wave, G, bx, vcu, rot;
};

struct GJob { const bf16_t* A; const bf16_t* Bt; int lda, ldb, M, N, K, rot; int gfirst, gsub; EpiD E; };
__device__ __forceinline__ void gemm_call(Frame& F, const GJob& j) {
    pg8::Gemm g{j.A, j.Bt, j.M, j.N, j.K, j.lda, j.ldb};
    if (j.rot >= 0) F.rot = j.rot % F.G;
    pg8::StaticOrder S; int c = F.bx - F.rot; if (c < 0) c += F.G;
    int Ge = F.G;
    if (j.gsub > 0) { Ge = j.gsub; c = F.bx - j.gfirst; if (c < 0 || c >= j.gsub) c = 1 << 28; }
    S.init(j.M, j.N, Ge, c);
    if (F.tid == 0) { LAS unsigned* d = (LAS unsigned*)(F.lds + LDS_EPI);
        const unsigned long long o_ = (unsigned long long)j.E.out, a_ = (unsigned long long)j.E.p1, b_ = (unsigned long long)j.E.p2;
        d[0] = (unsigned)j.E.mode; d[1] = (unsigned)j.E.row_base; d[2] = (unsigned)j.E.ctx; d[3] = (unsigned)j.E.aux; d[4] = __float_as_uint(j.E.scale); d[5] = 0u;
        d[6] = (unsigned)o_; d[7] = (unsigned)(o_ >> 32); d[8] = (unsigned)a_; d[9] = (unsigned)(a_ >> 32); d[10] = (unsigned)b_; d[11] = (unsigned)(b_ >> 32);
        const unsigned long long c_ = (unsigned long long)j.E.p3, e_ = (unsigned long long)j.E.p4; d[12] = (unsigned)c_; d[13] = (unsigned)(c_ >> 32); d[14] = (unsigned)e_; d[15] = (unsigned)(e_ >> 32); }
    __syncthreads();
    Epi E{(const LAS unsigned*)(F.lds + LDS_EPI)};
    pg8::gemm_phase<Epi, pg8::StaticOrder>(F.lds, g, S, E, F.tid);
    F.rot = (F.rot + (j.M / 256) * (j.N / 256)) % F.G;
}

__device__ __forceinline__ void tr_item(const float* src, int ldsrc, bf16_t* dst, int ldd, LAS float* scr, int lane) {
#pragma unroll 8
    for (int i = 0; i < 32; ++i) { const int kk = 2 * i + (lane >> 5); scr[kk * 33 + (lane & 31)] = src[(size_t)kk * ldsrc + (lane & 31)]; }
    asm volatile("s_waitcnt lgkmcnt(0)" ::: "memory");
    const int c = lane & 7;
#pragma unroll
    for (int j = 0; j < 4; ++j) { const int n = (lane >> 3) + 8 * j; const LAS float* s = scr + (8 * c) * 33 + n;
        u32x4 o; o.x = pk2(s[0 * 33], s[1 * 33]); o.y = pk2(s[2 * 33], s[3 * 33]); o.z = pk2(s[4 * 33], s[5 * 33]); o.w = pk2(s[6 * 33], s[7 * 33]);
        *(u32x4*)(dst + (size_t)n * ldd + 8 * c) = o; }
    asm volatile("s_waitcnt lgkmcnt(0)" ::: "memory");
}

__device__ __forceinline__ void conv_setA(Frame& F, const Args& a, int l, int pidx, int pcnt, int part) {
    unsigned char* ws = a.ws;
    bf16_t* Win = (bf16_t*)(ws + WS_WIN); bf16_t* Wb = (bf16_t*)(ws + WS_WB); bf16_t* Wout = (bf16_t*)(ws + WS_WOUT);
    const float* w_in = a.in[I_WIN] + (size_t)l * D * DIN;
    LAS float* scr = (LAS float*)(F.lds + F.wave * 16384);
    const int gw = pidx * 8 + F.wave, NGW = pcnt * 8;
    constexpr int I1 = 16 * 168, I2 = 128, I3 = 128, I4 = 256, I5 = 512;
    for (int it = gw; it < I1 + I2 + I3 + I4 + I5; it += NGW) {
        int r = it;
        if (r < I1) { const int kb = r / 168, nb = r % 168, k0 = kb * 64, n0 = 256 + nb * 32;
            if (!((part >> (nb >= 72 ? 1 : 0)) & 1)) continue;
            tr_item(w_in + (size_t)k0 * DIN + n0, DIN, Win + (size_t)(n0 + 256) * 1024 + k0, 1024, scr, F.lane); continue; } r -= I1;
        if (!(part & 2)) break;
        if (r < I2) { const int kb = r / 32, nb = r % 32; tr_item(a.in[I_WFO] + (size_t)l * 256 * D + (size_t)kb * 64 * D + nb * 32, D, Wb + (size_t)(nb * 32) * 1024 + kb * 64, 1024, scr, F.lane); continue; } r -= I2;
        if (r < I3) { const int kb = r / 32, nb = r % 32; tr_item(a.in[I_WCO] + (size_t)l * 256 * D + (size_t)kb * 64 * D + nb * 32, D, Wb + (size_t)(nb * 32) * 1024 + 256 + kb * 64, 1024, scr, F.lane); continue; } r -= I3;
        if (r < I4) { const int kb = r / 32, nb = r % 32; tr_item(a.in[I_WAO] + (size_t)l * 512 * D + (size_t)kb * 64 * D + nb * 32, D, Wb + (size_t)(nb * 32) * 1024 + 512 + kb * 64, 1024, scr, F.lane); continue; } r -= I4;
        { const int kb = r / 32, nb = r % 32; tr_item(a.in[I_WOUT] + (size_t)l * D * D + (size_t)kb * 64 * D + nb * 32, D, Wout + (size_t)(nb * 32) * 1024 + kb * 64, 1024, scr, F.lane); }
    }
    if (!(part & 1)) return;
    const LAS float* ct = (const LAS float*)(F.lds + LDS_COSTAB);
    const int gt = pidx * 512 + F.tid, NGT = pcnt * 512;
    for (int o = gt; o < 1024 * 128; o += NGT) {
        const int k = o & 1023, g = (o >> 10) & 3, mq = o >> 12;
        const float* wp = w_in + (size_t)k * DIN + g * 64;
        f32x4 wv[16];
#pragma unroll
        for (int i = 0; i < 16; ++i) wv[i] = *(const f32x4*)(wp + 4 * i);
#pragma unroll 1
        for (int mm = 0; mm < 2; ++mm) {
            const int m = mq * 2 + mm; float sc = 0.f, ss = 0.f;
#pragma unroll
            for (int j = 0; j < 64; ++j) { const int i = ((j * m) & 63) * 32; const float w = wv[j >> 2][j & 3]; sc += w * ct[i]; ss += w * ct[(i + 1536) & 2047]; }
            Win[(size_t)(g * 64 + m) * 1024 + k] = (bf16_t)f2bf(sc * 0.125f);
            Win[(size_t)(256 + g * 64 + m) * 1024 + k] = (bf16_t)f2bf(ss * 0.125f);
        }
    }
    float* bi = (float*)(ws + WS_BIASIN) + l * NIN; const float* b_in = a.in[I_BIN] + (size_t)l * DIN;
    for (int r = gt; r < NIN; r += NGT) {
        float v;
        if (r < 512) { const int pt = r >> 8, g = (r >> 6) & 3, m = r & 63; float s_ = 0.f;
            for (int j = 0; j < 64; ++j) { const int i = (j * m) & 63; s_ += b_in[g * 64 + j] * ct[(i * 32 + (pt ? 1536 : 0)) & 2047]; }
            v = s_ * 0.125f; }
        else v = b_in[r - 256];
        bi[r] = v;
    }
}
__device__ __forceinline__ void conv_setB(Frame& F, const Args& a, int l, int pidx, int pcnt) {
    unsigned char* ws = a.ws;
    bf16_t* Wgu = (bf16_t*)(ws + (l ? WS_WGU1 : WS_WGU0)); bf16_t* Wd = (bf16_t*)(ws + (l ? WS_WD1 : WS_WD0));
    LAS float* scr = (LAS float*)(F.lds + F.wave * 16384);
    const int gw = pidx * 8 + F.wave, NGW = pcnt * 8;
    constexpr int J1 = 16 * 88, J3 = 44 * 32;
    for (int it = gw; it < 2 * J1 + J3; it += NGW) {
        int r = it;
        if (r < 2 * J1) { const int up = r >= J1; if (up) r -= J1; const int kb = r / 88, nb = r % 88, n0 = nb * 32;
            const float* W = a.in[up ? I_WU : I_WG] + (size_t)l * D * DFF;
            tr_item(W + (size_t)kb * 64 * DFF + n0, DFF, Wgu + (size_t)((n0 >> 7) * 256 + up * 128 + (n0 & 127)) * 1024 + kb * 64, 1024, scr, F.lane); continue; }
        r -= 2 * J1;
        { const int kb = r / 32, nb = r % 32; tr_item(a.in[I_WD] + (size_t)l * DFF * D + (size_t)kb * 64 * D + nb * 32, D, Wd + (size_t)(nb * 32) * DFF + kb * 64, DFF, scr, F.lane); }
    }
}

__device__ __forceinline__ void norm_row(const float* xrow, const float* g, const float* sh, const float* sc, bf16_t* orow, float* fout, int lane) {
    f32x4 v[4]; float s = 0.f;
#pragma unroll
    for (int j = 0; j < 4; ++j) { v[j] = *((const f32x4*)xrow + lane + 64 * j); s += (v[j].x * v[j].x + v[j].y * v[j].y) + (v[j].z * v[j].z + v[j].w * v[j].w); }
    const float rstd = 1.0f / sqrtf(wave_sum(s) * (1.0f / D) + EPS);
#pragma unroll
    for (int j = 0; j < 4; ++j) {
        const int c = (lane + 64 * j) * 4;
        f32x4 y = v[j] * rstd * *(const f32x4*)(g + c);
        if (fout) { *(f32x4*)(fout + c) = y; }
        else { y = y * (*(const f32x4*)(sc + c) + 1.0f) + *(const f32x4*)(sh + c);
            u32x2 w; w.x = cvt_pk_bf16(y.x, y.y); w.y = cvt_pk_bf16(y.z, y.w); *(u32x2*)(orow + c) = w; }
    }
}
__device__ __forceinline__ void norm_phase(Frame& F, const float* xl, const float* xc, const float* g, const float* mod, int sh_off, int sc_off, bf16_t* H, bool with_ctx) {
    const int gw = F.vcu * 8 + F.wave, NGW = F.G * 8, nrows = with_ctx ? MT : ML;
    for (int r = gw; r < nrows; r += NGW) {
        const int b = r < ML ? (r >> 11) : 8;
        const float* xr = r < ML ? xl + (size_t)r * D : xc + (size_t)(r - ML) * D;
        norm_row(xr, g, mod + (size_t)b * 6144 + sh_off, mod + (size_t)b * 6144 + sc_off, H + (size_t)r * D, nullptr, F.lane);
    }
}

__device__ __forceinline__ int crow(int r, int hi) { return (r & 3) + 8 * (r >> 2) + 4 * hi; }
__device__ __forceinline__ s16x4 vtr(const LAS unsigned char* p) { return __builtin_bit_cast(s16x4, __builtin_amdgcn_ds_read_tr16_b64_v4i16((LAS s16x4*)p)); }
constexpr int AT_WSF = 131072;
__device__ __forceinline__ void at_softmax(f32x16& p0, f32x16& p1, f32x16& negm, float& mhat, float& lsum, f32x16 (&o)[4], bf16x8 (&pa)[4], LAS float* wsf, bool first, int r32, int hi) {
    float rm = fmaxf(fmaxf(p0[0], p0[1]), p1[0]);
    { float rb = fmaxf(fmaxf(p0[2], p0[3]), p1[1]); rm = fmaxf(fmaxf(rm, p1[2]), p1[3]);
#pragma unroll
      for (int r = 4; r < 16; r += 4) { rm = fmaxf(fmaxf(rm, p0[r]), p0[r + 1]); rb = fmaxf(fmaxf(rb, p0[r + 2]), p0[r + 3]); rm = fmaxf(fmaxf(rm, p1[r]), p1[r + 1]); rb = fmaxf(fmaxf(rb, p1[r + 2]), p1[r + 3]); }
      rm = fmaxf(rm, rb); }
    rm = fmaxf(rm, __shfl_xor(rm, 32));
    const bool need = first || (rm > 6.0f);
    if (__any(need)) {
        const float dl = need ? rm : 0.f;
        mhat += dl;
#pragma unroll
        for (int r = 0; r < 16; ++r) { p0[r] -= dl; p1[r] -= dl; negm[r] = -mhat; }
        if (!first) {
            const float f = fast_exp2(-dl);
            lsum *= f;
            asm volatile("" ::: "memory");
            if (hi == 0) wsf[r32] = f;
            asm volatile("s_waitcnt lgkmcnt(0)" ::: "memory");
#pragma unroll
            for (int r = 0; r < 16; ++r) { const float fr_ = wsf[crow(r, hi)];
#pragma unroll
                for (int d0 = 0; d0 < 4; ++d0) o[d0][r] *= fr_; }
            asm volatile("s_waitcnt lgkmcnt(0)" ::: "memory");
        }
    }
    f32x2_t ls2 = (f32x2_t){0.f, 0.f};
#pragma unroll
    for (int r = 0; r < 16; r += 2) { p0[r] = fast_exp2(p0[r]); p0[r + 1] = fast_exp2(p0[r + 1]); p1[r] = fast_exp2(p1[r]); p1[r + 1] = fast_exp2(p1[r + 1]);
        ls2 += (f32x2_t){p0[r], p0[r + 1]}; ls2 += (f32x2_t){p1[r], p1[r + 1]}; }
    lsum += ls2.x + ls2.y;
    u32x4 w;
    w.x = cvt_pk_bf16(p0[0], p0[1]); w.y = cvt_pk_bf16(p0[2], p0[3]); w.z = cvt_pk_bf16(p0[4], p0[5]); w.w = cvt_pk_bf16(p0[6], p0[7]); pa[0] = __builtin_bit_cast(bf16x8, w);
    w.x = cvt_pk_bf16(p0[8], p0[9]); w.y = cvt_pk_bf16(p0[10], p0[11]); w.z = cvt_pk_bf16(p0[12], p0[13]); w.w = cvt_pk_bf16(p0[14], p0[15]); pa[1] = __builtin_bit_cast(bf16x8, w);
    w.x = cvt_pk_bf16(p1[0], p1[1]); w.y = cvt_pk_bf16(p1[2], p1[3]); w.z = cvt_pk_bf16(p1[4], p1[5]); w.w = cvt_pk_bf16(p1[6], p1[7]); pa[2] = __builtin_bit_cast(bf16x8, w);
    w.x = cvt_pk_bf16(p1[8], p1[9]); w.y = cvt_pk_bf16(p1[10], p1[11]); w.z = cvt_pk_bf16(p1[12], p1[13]); w.w = cvt_pk_bf16(p1[14], p1[15]); pa[3] = __builtin_bit_cast(bf16x8, w);
}
__device__ __forceinline__ void attn_unit(Frame& F, const bf16_t* P, bf16_t* BR, int qrow0, int base1, int n1, int base2, int nt, int h, float lam, float oscale, const float* subg) {
    LAS unsigned char* lds = F.lds;
    const int tid = F.tid, lane = F.lane, wid = F.wave, r32 = lane & 31, hi = lane >> 5, qg = wid & 3, comp = wid >> 2;
    bf16x8 qf[4];
    { const bf16_t* qp = P + (size_t)(qrow0 + qg * 32 + r32) * LDP + PQ + h * 128 + comp * 64 + hi * 8;
#pragma unroll
      for (int d0 = 0; d0 < 4; ++d0) qf[d0] = *(const bf16x8*)(qp + d0 * 16); }
    int ksrc[2], kdst[2], vsrc[2], vdst[2];
#pragma unroll
    for (int i = 0; i < 2; ++i) { const int pc = wid * 2 + i;
        { const int cmp = pc >> 3, rg = pc & 7, row = rg * 8 + (lane >> 3), c8 = (lane & 7) ^ (lane >> 3); ksrc[i] = row * LDP + PK + h * 128 + cmp * 64 + c8 * 8; kdst[i] = cmp * 8192 + rg * 1024; }
        { const int d0 = pc >> 2, rg = pc & 3; vsrc[i] = (rg * 16 + (lane >> 2)) * LDP + PV + h * 128 + d0 * 32 + (lane & 3) * 8; vdst[i] = 16384 + d0 * 4096 + rg * 1024; } }
#define AT_TROW(t) ((t) < n1 ? base1 + 64 * (t) : base2 + 64 * ((t) - n1))
    LAS float* wsf = (LAS float*)(lds + AT_WSF) + wid * 64;
    float mhat = 0.f, lsum = 0.f;
    f32x16 negm;
#pragma unroll
    for (int r = 0; r < 16; ++r) negm[r] = 0.f;
    f32x16 o[4];
#pragma unroll
    for (int d0 = 0; d0 < 4; ++d0)
#pragma unroll
        for (int r = 0; r < 16; ++r) o[d0][r] = 0.f;
    bf16x8 pa[4];
#pragma unroll
    for (int i = 0; i < 4; ++i) pa[i] = (bf16x8){0, 0, 0, 0, 0, 0, 0, 0};
    s16x4 va[8], vb[8];
#pragma unroll
    for (int i = 0; i < 8; ++i) { va[i] = (s16x4){0, 0, 0, 0}; vb[i] = (s16x4){0, 0, 0, 0}; }
    const int vlane = ((lane >> 4) & 1) * 32 + (lane & 3) * 8 + (4 * hi + ((lane & 15) >> 2)) * 64;
    const int klane = comp * 8192 + r32 * 128;
    int koff[4];
#pragma unroll
    for (int d0 = 0; d0 < 4; ++d0) koff[d0] = ((2 * d0 + hi) ^ (r32 & 7)) * 16;
#define AT_SB() __builtin_amdgcn_sched_barrier(0)
#define AT_DMA4(t, OFF) do { const bf16_t* tp = P + (size_t)AT_TROW(t) * LDP; \
        __builtin_amdgcn_global_load_lds((const unsigned*)(tp + ksrc[0]), (LAS unsigned*)(lds + (OFF) + kdst[0]), 16, 0, 0); \
        __builtin_amdgcn_global_load_lds((const unsigned*)(tp + ksrc[1]), (LAS unsigned*)(lds + (OFF) + kdst[1]), 16, 0, 0); \
        __builtin_amdgcn_global_load_lds((const unsigned*)(tp + vsrc[0]), (LAS unsigned*)(lds + (OFF) + vdst[0]), 16, 0, 0); \
        __builtin_amdgcn_global_load_lds((const unsigned*)(tp + vsrc[1]), (LAS unsigned*)(lds + (OFF) + vdst[1]), 16, 0, 0); } while (0)
#define AT_VF(x, s) ((bf16x8){x[2 * (s)][0], x[2 * (s)][1], x[2 * (s)][2], x[2 * (s)][3], x[2 * (s) + 1][0], x[2 * (s) + 1][1], x[2 * (s) + 1][2], x[2 * (s) + 1][3]})
#define AT_TR(dst, addr, off) asm volatile("ds_read_b64_tr_b16 %0, %1 offset:%c2" : "=&v"(dst) : "v"(addr), "i"(off) : "memory")
    const unsigned ldsb = (unsigned)(unsigned long long)lds;
#define AT_VPRE(OFF) do { const unsigned vp_ = ldsb + (OFF) + 16384 + vlane; \
        _Pragma("unroll") for (int s_ = 0; s_ < 4; ++s_) { AT_TR(va[2 * s_], vp_, s_ * 1024); AT_TR(va[2 * s_ + 1], vp_, s_ * 1024 + 512); AT_TR(vb[2 * s_], vp_, 4096 + s_ * 1024); AT_TR(vb[2 * s_ + 1], vp_, 4096 + s_ * 1024 + 512); } } while (0)
#define AT_PVMMA(OFF) do { const unsigned vp_ = ldsb + (OFF) + 16384 + vlane; \
        asm volatile("s_waitcnt lgkmcnt(0)" ::: "memory"); AT_SB(); __builtin_amdgcn_s_setprio(1); \
        _Pragma("unroll") for (int s_ = 0; s_ < 4; ++s_) { \
            o[0] = __builtin_amdgcn_mfma_f32_32x32x16_bf16(pa[s_], AT_VF(va, s_), o[0], 0, 0, 0); \
            o[1] = __builtin_amdgcn_mfma_f32_32x32x16_bf16(pa[s_], AT_VF(vb, s_), o[1], 0, 0, 0); \
            AT_SB(); \
            AT_TR(va[2 * s_], vp_, 8192 + s_ * 1024); AT_TR(va[2 * s_ + 1], vp_, 8192 + s_ * 1024 + 512); AT_TR(vb[2 * s_], vp_, 12288 + s_ * 1024); AT_TR(vb[2 * s_ + 1], vp_, 12288 + s_ * 1024 + 512); \
            AT_SB(); } \
        asm volatile("s_waitcnt lgkmcnt(0)" ::: "memory"); AT_SB(); \
        _Pragma("unroll") for (int s_ = 0; s_ < 4; ++s_) { \
            o[2] = __builtin_amdgcn_mfma_f32_32x32x16_bf16(pa[s_], AT_VF(va, s_), o[2], 0, 0, 0); \
            o[3] = __builtin_amdgcn_mfma_f32_32x32x16_bf16(pa[s_], AT_VF(vb, s_), o[3], 0, 0, 0); } \
        __builtin_amdgcn_s_setprio(0); AT_SB(); } while (0)
#define AT_STEP(t, CUR, NX2, PRV) do { \
        if ((t) + 2 < nt) AT_DMA4((t) + 2, NX2); \
        if (comp == 1 && (t) > 0) AT_PVMMA(PRV); \
        f32x16 p0, p1; \
        {   bf16x8 kf[8]; const LAS unsigned char* kb = lds + (CUR) + klane; \
            _Pragma("unroll") for (int d0 = 0; d0 < 4; ++d0) { kf[2 * d0] = *(const LAS bf16x8*)(kb + koff[d0]); kf[2 * d0 + 1] = *(const LAS bf16x8*)(kb + koff[d0] + 4096); } \
            AT_SB(); __builtin_amdgcn_s_setprio(1); \
            p0 = __builtin_amdgcn_mfma_f32_32x32x16_bf16(kf[0], qf[0], negm, 0, 0, 0); \
            p1 = __builtin_amdgcn_mfma_f32_32x32x16_bf16(kf[1], qf[0], negm, 0, 0, 0); \
            _Pragma("unroll") for (int d0 = 1; d0 < 4; ++d0) { \
                p0 = __builtin_amdgcn_mfma_f32_32x32x16_bf16(kf[2 * d0], qf[d0], p0, 0, 0, 0); \
                p1 = __builtin_amdgcn_mfma_f32_32x32x16_bf16(kf[2 * d0 + 1], qf[d0], p1, 0, 0, 0); } __builtin_amdgcn_s_setprio(0); } \
        AT_SB(); \
        AT_VPRE(CUR); \
        AT_SB(); \
        at_softmax(p0, p1, negm, mhat, lsum, o, pa, wsf, (t) == 0, r32, hi); \
        AT_SB(); \
        if (comp == 0) AT_PVMMA(CUR); \
          \
        if ((t) + 2 < nt) asm volatile("s_waitcnt vmcnt(4)" ::: "memory"); else asm volatile("s_waitcnt vmcnt(0)" ::: "memory"); \
        AT_SB(); __builtin_amdgcn_s_barrier(); AT_SB(); } while (0)
    AT_DMA4(0, 0);
    if (nt > 1) AT_DMA4(1, 32768);
    if (nt > 1) asm volatile("s_waitcnt vmcnt(4)" ::: "memory"); else asm volatile("s_waitcnt vmcnt(0)" ::: "memory");
    __syncthreads();
#pragma unroll 1
    for (int t = 0; t < nt; t += 4) {
        AT_STEP(t, 0, 65536, 98304);
        if (t + 1 < nt) AT_STEP(t + 1, 32768, 98304, 0);
        if (t + 2 < nt) AT_STEP(t + 2, 65536, 0, 32768);
        if (t + 3 < nt) AT_STEP(t + 3, 98304, 32768, 65536);
    }
    if (comp == 1) { const int lo_ = ((nt - 1) & 3) * 32768; AT_PVMMA(lo_); }
    __syncthreads();
#undef AT_STEP
#undef AT_PVMMA
#undef AT_VPRE
#undef AT_TR
#undef AT_VF
#undef AT_DMA4
#undef AT_SB
    lsum += __shfl_xor(lsum, 32);
    { float inv = 1.0f / lsum; if (comp) inv *= lam;
      asm volatile("" ::: "memory");
      if (hi == 0) wsf[r32] = inv;
      asm volatile("s_waitcnt lgkmcnt(0)" ::: "memory");
#pragma unroll
      for (int r = 0; r < 16; ++r) { const float fr_ = wsf[crow(r, hi)];
#pragma unroll
          for (int d0 = 0; d0 < 4; ++d0) o[d0][r] *= fr_; } }
    LAS float* X = (LAS float*)lds + qg * (32 * 132);
    if (comp == 1) {
#pragma unroll
        for (int d0 = 0; d0 < 4; ++d0)
#pragma unroll
            for (int r = 0; r < 16; ++r) X[crow(r, hi) * 132 + d0 * 32 + r32] = o[d0][r];
    }
    __syncthreads();
    if (comp == 0) {
#pragma unroll
        for (int d0 = 0; d0 < 4; ++d0)
#pragma unroll
            for (int r = 0; r < 16; ++r) { const int ix = crow(r, hi) * 132 + d0 * 32 + r32; X[ix] = o[d0][r] - X[ix]; }
        asm volatile("s_waitcnt lgkmcnt(0)" ::: "memory");
        const int row = lane >> 1, hf = lane & 1;
        const LAS float* xr = X + row * 132 + hf * 64;
        float ss = 0.f;
#pragma unroll
        for (int c = 0; c < 16; ++c) { const f32x4 v = *(const LAS f32x4*)(xr + c * 4); ss += (v.x * v.x + v.y * v.y) + (v.z * v.z + v.w * v.w); }
        ss += __shfl_xor(ss, 1);
        const float rstd = oscale / sqrtf(ss * (1.0f / 128.0f) + EPS);
        bf16_t* op = BR + (size_t)(qrow0 + qg * 32 + row) * 1024 + 512 + h * 128 + hf * 64;
        const float* gp = subg + hf * 64;
#pragma unroll
        for (int c = 0; c < 8; ++c) {
            const f32x4 v0 = *(const LAS f32x4*)(xr + c * 8) * rstd * *(const f32x4*)(gp + c * 8), v1 = *(const LAS f32x4*)(xr + c * 8 + 4) * rstd * *(const f32x4*)(gp + c * 8 + 4);
            u32x4 w; w.x = cvt_pk_bf16(v0.x, v0.y); w.y = cvt_pk_bf16(v0.z, v0.w); w.z = cvt_pk_bf16(v1.x, v1.y); w.w = cvt_pk_bf16(v1.z, v1.w);
            *(u32x4*)(op + c * 8) = w;
        }
    }
    __syncthreads();
#undef AT_TROW
}

__device__ __forceinline__ void norm_rows4(const float* x0, size_t xstride, const float* g, const float* sh, const float* sc, bf16_t* o0, size_t ostride, float* fout, int lane) {
    f32x4 v[4][4]; float ss[4];
#pragma unroll
    for (int r = 0; r < 4; ++r)
#pragma unroll
        for (int j = 0; j < 4; ++j) v[r][j] = *((const f32x4*)(x0 + (size_t)r * xstride) + lane + 64 * j);
#pragma unroll
    for (int r = 0; r < 4; ++r) { float s = 0.f;
#pragma unroll
        for (int j = 0; j < 4; ++j) s += (v[r][j].x * v[r][j].x + v[r][j].y * v[r][j].y) + (v[r][j].z * v[r][j].z + v[r][j].w * v[r][j].w);
        ss[r] = 1.0f / sqrtf(wave_sum(s) * (1.0f / D) + EPS); }
#pragma unroll
    for (int j = 0; j < 4; ++j) {
        const int c = (lane + 64 * j) * 4;
        const f32x4 gv = *(const f32x4*)(g + c);
        if (fout) {
#pragma unroll
            for (int r = 0; r < 4; ++r) *(f32x4*)(fout + (size_t)r * xstride + c) = v[r][j] * ss[r] * gv;
        } else {
            const f32x4 m1 = *(const f32x4*)(sc + c) + 1.0f, sv = *(const f32x4*)(sh + c);
#pragma unroll
            for (int r = 0; r < 4; ++r) { const f32x4 y = v[r][j] * ss[r] * gv * m1 + sv;
                u32x2 w; w.x = cvt_pk_bf16(y.x, y.y); w.y = cvt_pk_bf16(y.z, y.w); *(u32x2*)(o0 + (size_t)r * ostride + c) = w; }
        }
    }
}
#define XB_TMO      128
#define XB_XCNT(j)  (256  + 64 * (j))
#define XB_XSUB(j)  (1280 + 64 * (j))
#define XB_XGEN(j)  (2304 + 64 * (j))
#define XB_TOP      3328
#define XB_TOPGEN   3392
#define XCD_BAR_WORDS 3456
#define XB_SPIN_CAP (1u << 18)
__device__ __forceinline__ unsigned xb_ld(unsigned* p)              { return __hip_atomic_load(p, __ATOMIC_RELAXED, __HIP_MEMORY_SCOPE_AGENT); }
__device__ __forceinline__ unsigned xb_add(unsigned* p, unsigned v) { return __hip_atomic_fetch_add(p, v, __ATOMIC_RELAXED, __HIP_MEMORY_SCOPE_AGENT); }
__device__ __forceinline__ unsigned xb_xcc_id() { return (unsigned)__builtin_amdgcn_s_getreg((3 << 11) | 20) & 0xFu; }
#define XB_SPIN(cond, bar) do { unsigned _sp = 0; while (cond) { __builtin_amdgcn_s_sleep(1); \
    if ((++_sp & 255u) == 0u) { if (xb_ld(&(bar)[XB_TMO])) break; if (_sp > XB_SPIN_CAP) { atomicAdd(&(bar)[XB_TMO], 1u); break; } } } } while (0)
struct XcdBarrier { unsigned* bar; unsigned x; volatile LAS unsigned* st; };
__device__ __forceinline__ XcdBarrier xcd_barrier_post(unsigned* bar, volatile LAS unsigned* st) {
    XcdBarrier b; b.bar = bar; b.x = xb_xcc_id(); b.st = st;
    if (threadIdx.x == 0) (void)xb_add(&bar[XB_XCNT(b.x)], 1u);
    return b;
}
__device__ __forceinline__ void xcd_barrier_complete(unsigned* bar, unsigned x, unsigned& nloc, unsigned& nx) {
    const unsigned G = gridDim.x * gridDim.y * gridDim.z;
    unsigned sum, cnt, mine, sp = 0u;
    for (;;) {
        sum = 0u; cnt = 0u; mine = 0u;
#pragma unroll
        for (unsigned j = 0; j < 16; ++j) { const unsigned c = xb_ld(&bar[XB_XCNT(j)]); sum += c; cnt += (c > 0u) ? 1u : 0u; mine = (j == x) ? c : mine; }
        if (sum == G) break;
        __builtin_amdgcn_s_sleep(1);
        if ((++sp & 255u) == 0u) { if (xb_ld(&bar[XB_TMO])) break; if (sp > XB_SPIN_CAP) { atomicAdd(&bar[XB_TMO], 1u); break; } }
    }
    nloc = mine > 0u ? mine : 1u; nx = cnt > 0u ? cnt : 1u;
}
__device__ __forceinline__ void xcd_barrier(const XcdBarrier& b) {
    asm volatile("s_waitcnt vmcnt(0)" ::: "memory");
    __syncthreads();
    if (threadIdx.x == 0) {
        unsigned* bar = b.bar;
        __builtin_amdgcn_s_waitcnt(0);
        unsigned nloc = b.st[0], nx = b.st[1];
        if (nloc == 0u) { xcd_barrier_complete(bar, b.x, nloc, nx); b.st[0] = nloc; b.st[1] = nx; }
        const unsigned old = xb_add(&bar[XB_XSUB(b.x)], 1u);
        const unsigned gen = old / nloc;
        if (old + 1u == (gen + 1u) * nloc) {
            __builtin_amdgcn_fence(__ATOMIC_RELEASE, "agent");
            asm volatile("s_waitcnt vmcnt(0)" ::: "memory");
            const unsigned og = xb_add(&bar[XB_TOP], 1u);
            const unsigned tg = og / nx;
            if (og + 1u == (tg + 1u) * nx) xb_add(&bar[XB_TOPGEN], 1u);
            else XB_SPIN(xb_ld(&bar[XB_TOPGEN]) == tg, bar);
            __builtin_amdgcn_fence(__ATOMIC_ACQUIRE, "agent");
            xb_add(&bar[XB_XGEN(b.x)], 1u);
            asm volatile("s_waitcnt vmcnt(0)" ::: "memory");
        } else {
            XB_SPIN(xb_ld(&bar[XB_XGEN(b.x)]) == gen, bar);
            __builtin_amdgcn_fence(__ATOMIC_ACQUIRE, "agent");
            asm volatile("s_waitcnt vmcnt(0)" ::: "memory");
        }
    }
    __syncthreads();
}

constexpr int N_PHASES = 16;
__global__ void __launch_bounds__(512, 2) fwd_kernel(Args args) {
    extern __shared__ __attribute__((aligned(16))) unsigned char lds_raw[];
    Frame F;
    F.lds = (LAS unsigned char*)lds_raw;
    F.tid = threadIdx.x; F.lane = F.tid & 63; F.wave = __builtin_amdgcn_readfirstlane(F.tid >> 6);
    F.G = gridDim.x; F.bx = blockIdx.x; F.vcu = (F.G % 8 == 0) ? (F.bx % 8) * (F.G / 8) + F.bx / 8 : F.bx; F.rot = 0;
    unsigned char* const ws = args.ws;
    float* const XL = args.out;
    if (F.tid < 2) ((LAS unsigned*)(F.lds + LDS_XB))[F.tid] = 0u;
    __syncthreads();
    if (args.ph_hi - args.ph_lo > 1) (void)xcd_barrier_post((unsigned*)(ws + WS_BAR), (volatile LAS unsigned*)(F.lds + LDS_XB));
#define WSP(T, off) ((T*)(ws + (off)))
#pragma unroll 1
    for (int ph = args.ph_lo, rep = 0; ph < args.ph_hi;) {
#define REFRESH_LANE() do { int l_ = (int)__builtin_amdgcn_mbcnt_hi(~0u, __builtin_amdgcn_mbcnt_lo(~0u, 0u)); asm volatile("" : "+v"(l_)); F.lane = l_; F.tid = F.wave * 64 + l_; } while (0)
        REFRESH_LANE();
        const int kidx = ph < 2 ? 0 : (ph - 2) % 7;
        const int kind = ph < 2 ? ph : (kidx < 5 ? 2 + kidx : 3 + kidx);
        const int l = ph < 2 ? 0 : (ph - 2) / 7;
        const bool last = (l == 1);
#define mod (WSP(float, WS_MOD) + (size_t)l * 9 * 6144)
#define biasin (WSP(float, WS_BIASIN) + l * NIN)
        if (kind == 0) {
            LAS float* ct = (LAS float*)(F.lds + LDS_COSTAB);
            for (int i = F.tid; i < 2048; i += 512) ct[i] = cospif((float)i * (1.0f / 1024.0f));
            __syncthreads();
        }
        if (kind == 0) {
            if (F.bx < 192) {
                LAS float* sv = (LAS float*)F.lds;
                LAS float* red = (LAS float*)(F.lds + 40960);
                for (int i = F.tid; i < 9 * 1024; i += 512) { const int r = i >> 10, k = i & 1023; const float c = r < 8 ? args.in[I_C][r * 1024 + k] : args.in[I_CCTX][k]; sv[i] = c / (1.0f + __expf(-c)); }
                __syncthreads();
                for (int job = F.bx; job < 192; job += F.G) {
                    const int jl = job / 96, n0 = (job % 96) * 64, kg = F.tid >> 6, nn = F.tid & 63;
                    const float* wp = args.in[I_WADA] + (size_t)jl * D * 6144 + (size_t)(kg * 128) * 6144 + n0 + nn;
                    float ac[9];
#pragma unroll
                    for (int r = 0; r < 9; ++r) ac[r] = 0.f;
#pragma unroll 1
                    for (int k0 = 0; k0 < 128; k0 += 16) {
                        float wv[16];
#pragma unroll
                        for (int i = 0; i < 16; ++i) wv[i] = wp[(size_t)(k0 + i) * 6144];
#pragma unroll
                        for (int i = 0; i < 16; ++i)
#pragma unroll
                            for (int r = 0; r < 9; ++r) ac[r] += sv[r * 1024 + kg * 128 + k0 + i] * wv[i]; }
#pragma unroll
                    for (int r = 0; r < 9; ++r) red[(kg * 9 + r) * 64 + nn] = ac[r];
                    __syncthreads();
                    for (int o = F.tid; o < 576; o += 512) { const int r = o >> 6, n = o & 63; float s = args.in[I_BADA][jl * 6144 + n0 + n];
#pragma unroll
                        for (int q = 0; q < 8; ++q) s += red[(q * 9 + r) * 64 + n];
                        WSP(float, WS_MOD)[((size_t)jl * 9 + r) * 6144 + n0 + n] = s; }
                    __syncthreads();
                }
            }
            __syncthreads();
            if (F.bx == F.G - 1) {
                float* ROPE = WSP(float, WS_ROPE);
                for (int i = F.tid; i < 1024; i += 512) { const int pos = i >> 4, f = i & 15; const float fr = powf(10000.0f, -(float)f * (1.0f / 16.0f)); const float ang = (float)pos * fr; ROPE[i] = cosf(ang); ROPE[1024 + i] = sinf(ang); }
                if (F.tid < 2) { const int jl = F.tid; float s1 = 0.f, s2 = 0.f;
                    for (int j = 0; j < 64; ++j) { s1 += args.in[I_LQ1][jl * 64 + j] * args.in[I_LK1][jl * 64 + j]; s2 += args.in[I_LQ2][jl * 64 + j] * args.in[I_LK2][jl * 64 + j]; }
                    WSP(float, WS_LAM)[jl] = expf(s1) - expf(s2) + (0.8f - 0.6f * expf(-0.3f * (float)jl)); }
            }
            __syncthreads();
        }
        if (kind == 0) { REFRESH_LANE(); conv_setA(F, args, 0, F.vcu, F.G, 1); }
        if (kind == 1) {
            REFRESH_LANE();
            norm_phase(F, args.in[I_X], args.in[I_CTX], args.in[I_N1G], mod, 0, 1024, WSP(bf16_t, WS_H), true);
        }
        if (kind == 3) {
            const float lam = WSP(float, WS_LAM)[l]; const float osc = 1.0f - (0.8f - 0.6f * expf(-0.3f * (float)l)); const float* subg = args.in[I_SUBG] + l * 128;
            const bf16_t* P = WSP(bf16_t, WS_P); bf16_t* BR = WSP(bf16_t, WS_BR);
            const int npairs = (2 * F.vcu < 512) ? (512 - 2 * F.vcu + 2 * F.G - 1) / (2 * F.G) : 0, nlat = 2 * npairs;
#pragma unroll 1
            for (int rp = 0; rp <= PROBE_ATT; ++rp)
#pragma unroll 1
            for (int i = 0;; ++i) {
                int qrow0, base1, n1, base2, nt, h;
                if (i < nlat) { const int un = (i >> 1) * 2 * F.G + 2 * F.vcu + (i & 1); const int bh = un >> 4, qb = un & 15, b = bh >> 2; h = bh & 3;
                    qrow0 = b * SEQ + qb * 128; base1 = b * SEQ; n1 = 32; base2 = ML + b * CTXL; nt = 36; }
                else { const int cu = F.vcu + (i - nlat) * F.G; if (last || cu >= 64) break; const int bh = cu >> 1, qb = cu & 1, b = bh >> 2; h = bh & 3;
                    qrow0 = ML + b * CTXL + qb * 128; base1 = ML + b * CTXL; n1 = 4; base2 = 0; nt = 4; }
                REFRESH_LANE();
                attn_unit(F, P, BR, qrow0, base1, n1, base2, nt, h, lam, osc, subg);
            }
        }
#pragma unroll 1
        for (int j = 0; j < 3; ++j) {
            GJob J{}; bool have = false;
            J.lda = 1024; J.ldb = 1024; J.K = 1024; J.rot = -1;
            if (kind == 2) {
                if (j < 2) { have = true; J.A = WSP(bf16_t, WS_H) + (j ? (size_t)ML * 1024 : 0); J.Bt = WSP(bf16_t, WS_WIN); J.M = j ? MC : ML; J.N = NP1;
                    J.E.mode = E_INPROJ; J.E.out = WSP(bf16_t, WS_P); J.E.p1 = biasin; J.E.p2 = WSP(float, WS_ROPE); J.E.row_base = j ? ML : 0; J.E.ctx = j; J.E.aux = 0; J.E.p3 = WSP(bf16_t, (l ? WS_FT1 : WS_FT0)); J.E.p4 = WSP(bf16_t, WS_FTC);
                    if (j == 0) J.rot = 0;
                    if (j && last) { J.Bt = WSP(bf16_t, WS_WIN) + (size_t)7 * 256 * 1024; J.N = 1024; J.E.aux = 7; J.E.p1 = biasin + 7 * 256; } }
            } else if (kind == 4) {
                const int nf = (F.G >= 128) ? 64 : 0;
                if (j == 0) { have = true; J.A = WSP(bf16_t, WS_DFT); J.lda = 4096; J.Bt = WSP(bf16_t, (l ? WS_FT1 : WS_FT0)); J.ldb = 4096; J.M = 2048; J.N = 2048; J.K = 4096; J.rot = 0;
                    if (nf) { J.gfirst = 0; J.gsub = nf; }
                    J.E.mode = E_FOUR; J.E.out = WSP(bf16_t, WS_BR); J.E.row_base = 0; J.E.ctx = 0; J.E.scale = 0.02209708691207961f; }
                else if (j == 1 && !last) { have = true; J.A = WSP(bf16_t, WS_DFT256); J.lda = 512; J.Bt = WSP(bf16_t, WS_FTC); J.ldb = 512; J.M = 256; J.N = 2048; J.K = 512; J.rot = 0;
                    if (nf) { J.gfirst = nf; J.gsub = F.G - nf; }
                    J.E.mode = E_FOUR; J.E.out = WSP(bf16_t, WS_BR); J.E.row_base = ML; J.E.ctx = 1; J.E.scale = 0.0625f; }
                else if (j == 2) { have = true; J.A = WSP(bf16_t, WS_H); J.Bt = WSP(bf16_t, WS_WIN) + (size_t)NP1 * 1024; J.M = last ? ML : MT; J.N = 3072; J.rot = 0;
                    if (nf) { J.gfirst = nf; J.gsub = F.G - nf; }
                    J.E.mode = E_GATE; J.E.out = WSP(bf16_t, WS_P); J.E.p1 = biasin + NP1; J.E.row_base = 0; }
            } else if (kind == 5) {
                if (j == 0) { have = true; J.A = WSP(bf16_t, WS_BR); J.Bt = WSP(bf16_t, WS_WB); J.M = last ? ML : MT; J.N = 1024; J.K = 1024; J.rot = 0;
                    J.E.mode = E_BRANCH; J.E.out = WSP(bf16_t, WS_H); J.E.p1 = WSP(bf16_t, WS_P); J.E.aux = 0; J.E.row_base = 0; }
            } else if (kind == 6 || kind == 9) {
                if (j == 0 || (j == 1 && !last)) { have = true;
                    const bool dn = (kind == 9);
                    const bf16_t* Abase = dn ? WSP(bf16_t, WS_P) : WSP(bf16_t, WS_H);
                    J.lda = dn ? DFF : 1024; J.ldb = J.lda; J.K = J.lda;
                    J.A = Abase + (j ? (size_t)ML * J.lda : 0);
                    J.Bt = dn ? WSP(bf16_t, (l ? WS_WD1 : WS_WD0)) : WSP(bf16_t, WS_WOUT);
                    J.M = j ? MC : ML; J.N = 1024; if (j == 0) J.rot = 0;
                    J.E.mode = E_RESID; J.E.ctx = j; J.E.p2 = mod + (dn ? 5120 : 2048);
                    const float* xin_l = (!dn && l == 0) ? args.in[I_X] : XL; const float* xin_c = (!dn && l == 0) ? args.in[I_CTX] : WSP(float, WS_XC);
                    J.E.p1 = j ? xin_c : xin_l; J.E.out = j ? (void*)WSP(float, WS_XC) : (void*)XL; }
            } else if (kind == 8) {
                if (j == 0) { have = true; J.A = WSP(bf16_t, WS_BR); J.Bt = WSP(bf16_t, (l ? WS_WGU1 : WS_WGU0)); J.M = last ? ML : MT; J.N = 2 * DFF; J.rot = 0;
                    J.E.mode = E_GU; J.E.out = WSP(bf16_t, WS_P); J.E.row_base = 0; }
            }
            if (!have) { if (kind == 4) continue; break; }
            REFRESH_LANE();
            const int rot_used = (J.rot >= 0) ? J.rot % F.G : F.rot;
            gemm_call(F, J);
            if (kind == 6 || kind == 9) {
                REFRESH_LANE();
                int phx = ph; asm volatile("" : "+s"(phx));
                const int lk = ((phx - 2) / 7) * 2 + (((phx - 2) % 7) == 6 ? 1 : 0);
                __syncthreads();
                if (F.tid == 0) {
                    unsigned* cnt = (unsigned*)(ws + WS_BAR + 16384) + (size_t)(lk * 72) * 16;
                    pg8::StaticOrder S2; { int c2 = F.bx - rot_used; if (c2 < 0) c2 += F.G; S2.init(j ? MC : ML, 1024, F.G, c2); }
                    pg8::Unit u2;
                    __builtin_amdgcn_fence(__ATOMIC_RELEASE, "agent");
                    asm volatile("s_waitcnt vmcnt(0)" ::: "memory");
                    for (int i = 0; S2.next(i, u2); ++i) (void)xb_add(&cnt[(size_t)(u2.pm + (j ? 64 : 0)) * 16], 1u);
                }
            }
        }
        if (kind == 6 || kind == 9) {
            unsigned* cnt = (unsigned*)(ws + WS_BAR + 16384) + (size_t)((l * 2 + (kind == 9 ? 1 : 0)) * 72) * 16;
#pragma unroll 1
            for (int jj = 0; jj < (last ? 1 : 2); ++jj) {
                pg8::StaticOrder S2; { int c2 = F.bx - (jj ? ((ML / 256) * 4) % F.G : 0); if (c2 < 0) c2 += F.G; S2.init(jj ? MC : ML, 1024, F.G, c2); }
                pg8::Unit u2;
#pragma unroll 1
                for (int i = 0; S2.next(i, u2); ++i) {
                    const int gpm = u2.pm + (jj ? 64 : 0);
                    REFRESH_LANE();
                    if (F.tid == 0) {
                        unsigned sp = 0;
                        while (xb_ld(&cnt[(size_t)gpm * 16]) < 4u) { __builtin_amdgcn_s_sleep(1); if (++sp > (1u << 22)) break; }
                        __builtin_amdgcn_fence(__ATOMIC_ACQUIRE, "agent");
                        asm volatile("s_waitcnt vmcnt(0)" ::: "memory");
                    }
                    __syncthreads();
                    REFRESH_LANE();
                    const int lrow0 = u2.pm * 256 + u2.pn * 64 + F.wave * 8;
                    const int b = jj ? 8 : (lrow0 >> 11);
                    const float* xs_ = (jj ? WSP(float, WS_XC) : XL) + (size_t)lrow0 * D;
                    const int grow0 = (jj ? ML : 0) + lrow0;
                    if (kind == 9 && last) {
#pragma unroll 1
                        for (int q = 0; q < 2; ++q) norm_rows4(xs_ + (size_t)q * 4 * D, D, args.in[I_FING], nullptr, nullptr, nullptr, 0, XL + (size_t)(lrow0 + q * 4) * D, F.lane);
                    } else {
                        const bool n2 = (kind == 6);
                        const float* g = n2 ? args.in[I_N2G] + l * 1024 : args.in[I_N1G] + 1024;
                        const float* m = WSP(float, WS_MOD) + (size_t)(n2 ? l : 1) * 9 * 6144 + (size_t)b * 6144;
                        bf16_t* dst = (n2 ? WSP(bf16_t, WS_BR) : WSP(bf16_t, WS_H)) + (size_t)grow0 * D;
#pragma unroll 1
                        for (int q = 0; q < 2; ++q) norm_rows4(xs_ + (size_t)q * 4 * D, D, g, m + (n2 ? 3072 : 0), m + (n2 ? 4096 : 1024), dst + (size_t)q * 4 * D, D, nullptr, F.lane);
                    }
                    __syncthreads();
                }
            }
        }
        if (!last && kind == 2) {
            const int nskip = (F.G > 64) ? 24 : 0;
            if (F.bx >= nskip) {
                const int pidx = F.bx - nskip, pcnt = F.G - nskip;
                REFRESH_LANE();
                { LAS float* ctw = (LAS float*)(F.lds + LDS_COSTAB);
                  for (int i = F.tid; i < 2048; i += 512) ctw[i] = cospif((float)i * (1.0f / 1024.0f));
                  __syncthreads(); }
            {
              const LAS float* ct = (const LAS float*)(F.lds + LDS_COSTAB);
              bf16_t* DFT = WSP(bf16_t, WS_DFT); bf16_t* DFT256 = WSP(bf16_t, WS_DFT256);
              const int gt = pidx * 512 + F.tid, NGT = pcnt * 512;
              for (int q = gt; q < 2048 * 512; q += NGT) { const int k = q >> 9, c8 = (q & 511) * 8; unsigned w[4];
#pragma unroll
                  for (int e = 0; e < 8; e += 2) { float v[2];
#pragma unroll
                      for (int z = 0; z < 2; ++z) { const int np = c8 + e + z; v[z] = np < 2048 ? ct[(k * np) & 2047] : -ct[((k * (np - 2048)) + 1536) & 2047]; }
                      w[e >> 1] = pk2(v[0], v[1]); }
                  *(u32x4*)(DFT + (size_t)k * 4096 + c8) = (u32x4){w[0], w[1], w[2], w[3]}; }
              for (int q = gt; q < 256 * 64; q += NGT) { const int k = q >> 6, c8 = (q & 63) * 8; unsigned w[4];
#pragma unroll
                  for (int e = 0; e < 8; e += 2) { float v[2];
#pragma unroll
                      for (int z = 0; z < 2; ++z) { const int np = c8 + e + z; v[z] = np < 256 ? ct[(((k * np) & 255) * 8) & 2047] : -ct[((((k * (np - 256)) & 255) * 8) + 1536) & 2047]; }
                      w[e >> 1] = pk2(v[0], v[1]); }
                  *(u32x4*)(DFT256 + (size_t)k * 512 + c8) = (u32x4){w[0], w[1], w[2], w[3]}; } }
                __syncthreads();
                REFRESH_LANE();
                conv_setA(F, args, 0, pidx, pcnt, 2);
            }
        }
        if (!last && (kind == 6 || kind == 9)) {
            const int nskip = (F.G > 64) ? 32 : 0;
            if (F.bx >= nskip) {
                const int pidx = F.bx - nskip, pcnt = F.G - nskip;
                if (kind == 6) { REFRESH_LANE(); conv_setB(F, args, 0, pidx, pcnt); }
                else {
                    LAS float* ct = (LAS float*)(F.lds + LDS_COSTAB);
                    REFRESH_LANE();
                    for (int i = F.tid; i < 2048; i += 512) ct[i] = cospif((float)i * (1.0f / 1024.0f));
                    __syncthreads();
                    conv_setA(F, args, 1, pidx, pcnt, 3);
                    REFRESH_LANE();
                    conv_setB(F, args, 1, pidx, pcnt);
                }
            }
        }
        if (kind == 3) {
            REFRESH_LANE();
            const bf16_t* P = WSP(bf16_t, WS_P); bf16_t* BR = WSP(bf16_t, WS_BR);
            const float* cw = args.in[I_CONVW] + l * 768; const float* cb_ = args.in[I_CONVB] + l * 256;
            const int nrows = last ? ML : MT, gt = F.vcu * 512 + F.tid, NGT = F.G * 512;
            for (int idx = gt; idx < nrows * 32; idx += NGT) {
                const int row = idx >> 5, c8 = (idx & 31) * 8;
                const int L = row < ML ? SEQ : CTXL, t = row < ML ? (row & (SEQ - 1)) : ((row - ML) & (CTXL - 1));
                const bf16_t* pr = P + (size_t)row * LDP;
                const u32x4 cbv = *(const u32x4*)(pr + PCB + c8), c0 = *(const u32x4*)(pr + PCC + c8), x0 = *(const u32x4*)(pr + PCX + c8);
                u32x4 cm = (u32x4){0, 0, 0, 0}, xm = cm, cp = cm, xp = cm;
                if (t > 0) { cm = *(const u32x4*)(pr - LDP + PCC + c8); xm = *(const u32x4*)(pr - LDP + PCX + c8); }
                if (t < L - 1) { cp = *(const u32x4*)(pr + LDP + PCC + c8); xp = *(const u32x4*)(pr + LDP + PCX + c8); }
                unsigned ow[4];
#pragma unroll
                for (int e = 0; e < 4; ++e) {
                    const int c = c8 + 2 * e;
                    const float zl = bflo(c0[e]) * bflo(x0[e]), zh = bfhi(c0[e]) * bfhi(x0[e]);
                    const float ml = bflo(cm[e]) * bflo(xm[e]), mh = bfhi(cm[e]) * bfhi(xm[e]);
                    const float pl = bflo(cp[e]) * bflo(xp[e]), phh = bfhi(cp[e]) * bfhi(xp[e]);
                    const float vl = bflo(cbv[e]) * (cw[c] * ml + cw[256 + c] * zl + cw[512 + c] * pl + cb_[c]);
                    const float vh = bfhi(cbv[e]) * (cw[c + 1] * mh + cw[256 + c + 1] * zh + cw[512 + c + 1] * phh + cb_[c + 1]);
                    ow[e] = cvt_pk_bf16(vl, vh);
                }
                *(u32x4*)(BR + (size_t)row * 1024 + 256 + c8) = (u32x4){ow[0], ow[1], ow[2], ow[3]};
            }
        }
        const bool dup_again = (rep == 0) && (((DUP_MASK) >> kind) & 1);
        if (ph + 1 < args.ph_hi || dup_again) {
            if (args.ph_hi > 1000) cg::this_grid().sync();
            { XcdBarrier xbar; xbar.bar = (unsigned*)(ws + WS_BAR); xbar.x = xb_xcc_id(); xbar.st = (volatile LAS unsigned*)(F.lds + LDS_XB); xcd_barrier(xbar); }
        }
        if (dup_again) rep = 1; else { rep = 0; ++ph; }
    }
#undef mod
#undef biasin
#undef WSP
}


#ifndef DBG_STOP
#define DBG_STOP N_PHASES
#endif
#ifndef DBG_DUMP
#define DBG_DUMP 0
#endif
__global__ void dbg_dump(const bf16_t* src, float* out, size_t n) {
    for (size_t i = (size_t)blockIdx.x * blockDim.x + threadIdx.x; i < n; i += (size_t)gridDim.x * blockDim.x) out[i] = __uint_as_float(((unsigned)src[i]) << 16);
}
extern "C" void kernel_launch(void* const* d_in, const int* in_sizes, int n_in, void* d_out, int out_size, void* d_ws, size_t ws_size, hipStream_t stream) {
    static int grid = 0;
    if (grid == 0) {
        if (n_in != 25 || in_sizes[0] != ML * D || out_size != ML * D || ws_size < WS_END) { fprintf(stderr, "kernel_launch: unexpected shapes (n_in %d, in0 %d, out %d, ws %zu)\n", n_in, n_in > 0 ? in_sizes[0] : -1, out_size, ws_size); grid = -1; return; }
        int dev = 0, cus = 0, per_cu = 0;
        hipGetDevice(&dev); hipDeviceGetAttribute(&cus, hipDeviceAttributeMultiprocessorCount, dev);
        if (hipFuncSetAttribute((const void*)fwd_kernel, hipFuncAttributeMaxDynamicSharedMemorySize, LDS_BYTES) != hipSuccess) { fprintf(stderr, "kernel_launch: hipFuncSetAttribute failed\n"); grid = -1; return; }
        if (hipOccupancyMaxActiveBlocksPerMultiprocessor(&per_cu, (const void*)fwd_kernel, 512, LDS_BYTES) != hipSuccess || per_cu < 1) { fprintf(stderr, "kernel_launch: occupancy query says %d\n", per_cu); per_cu = 1; }
        (void)hipGetLastError();
        grid = cus * 1;
        if (grid <= 0) grid = 256;
    }
    if (grid < 0) return;
    if (hipMemsetAsync((unsigned char*)d_ws + WS_BAR, 0, 65536, stream) != hipSuccess) { fprintf(stderr, "kernel_launch: memset failed\n"); return; }
    Args a{};
    for (int i = 0; i < 25; ++i) a.in[i] = (const float*)d_in[i];
    a.out = (float*)d_out; a.ws = (unsigned char*)d_ws;
#if MK_MULTI_LAUNCH
    for (int p = 0; p < DBG_STOP; ++p) {
        a.ph_lo = p; a.ph_hi = p + 1;
        hipLaunchKernelGGL(fwd_kernel, dim3(grid), dim3(512), LDS_BYTES, stream, a);
    }
#else
    a.ph_lo = 0; a.ph_hi = DBG_STOP;
    void* kargs[] = {&a};
    hipError_t e = hipLaunchCooperativeKernel((const void*)fwd_kernel, dim3(grid), dim3(512), kargs, LDS_BYTES, stream);
    if (e != hipSuccess) fprintf(stderr, "kernel_launch: cooperative launch failed: %s (grid %d)\n", hipGetErrorString(e), grid);
#endif
#if DBG_DUMP
    { const size_t off = DBG_DUMP == 1 ? WS_H : (DBG_DUMP == 2 ? WS_BR : (DBG_DUMP == 3 ? WS_P : WS_FT0));
      hipLaunchKernelGGL(dbg_dump, dim3(2048), dim3(256), 0, stream, (const bf16_t*)((unsigned char*)d_ws + off), (float*)d_out, (size_t)(DBG_DUMP == 4 ? 8 : 16) * 1024 * 1024); }
#endif
}
```

```cpp
#include <hip/hip_runtime.h>
#include <hip/hip_cooperative_groups.h>
#include <cstdio>
#include <cstdint>
namespace cg = cooperative_groups;

#ifndef PROBE_ATT
#define PROBE_ATT 0
#endif
#ifndef PROBE_FOUR
#define PROBE_FOUR 0
#endif
#ifndef DUP_MASK
#define DUP_MASK 0
#endif
#ifndef MK_MULTI_LAUNCH
#define MK_MULTI_LAUNCH 0
#endif

#define LAS __attribute__((address_space(3)))
#define GAS __attribute__((address_space(1)))
typedef unsigned short bf16_t;
typedef short bf16x8 __attribute__((ext_vector_type(8)));
typedef short s16x4 __attribute__((ext_vector_type(4)));
typedef float f32x4 __attribute__((ext_vector_type(4)));
typedef float f32x16 __attribute__((ext_vector_type(16)));
typedef unsigned u32x4 __attribute__((ext_vector_type(4)));
typedef unsigned u32x2 __attribute__((ext_vector_type(2)));

constexpr int D = 1024, NB = 8, SEQ = 2048, CTXL = 256, DFF = 2816;
constexpr int ML = NB * SEQ;
constexpr int MC = NB * CTXL;
constexpr int MT = ML + MC;
constexpr int DIN = 5632;
constexpr int NIN = 5888;
constexpr int NP1 = 2816;
constexpr int LDP = 2304;
constexpr int PCB = 0, PCC = 256, PCX = 512, PQ = 768, PK = 1280, PV = 1792;
constexpr float QSCALE = 0.125f * 1.4426950408889634f;
constexpr float EPS = 1e-6f;

constexpr size_t MiB = 1u << 20;
constexpr size_t WS_MOD = 0;
constexpr size_t WS_ROPE = 448 * 1024;
constexpr size_t WS_BIASIN = 464 * 1024;
constexpr size_t WS_LAM = 1020 * 1024;
constexpr size_t WS_DFT256 = 1 * MiB;
constexpr size_t WS_DFT = 2 * MiB;
constexpr size_t WS_XC = 18 * MiB;
constexpr size_t WS_WIN = 26 * MiB;
constexpr size_t WS_WB = WS_WIN + 5888 * 1024 * 2;
constexpr size_t WS_WOUT = WS_WB + 2 * MiB;
constexpr size_t WS_WGU0 = WS_WOUT + 2 * MiB;
constexpr size_t WS_WD0 = WS_WGU0 + 11 * MiB;
constexpr size_t WS_WGU1 = WS_WD0 + 5632 * 1024;
constexpr size_t WS_WD1 = WS_WGU1 + 11 * MiB;
constexpr size_t WS_H = 75 * MiB;
constexpr size_t WS_BR = 111 * MiB;
constexpr size_t WS_P = 147 * MiB;
constexpr size_t WS_FT0 = WS_WGU1, WS_FT1 = WS_WGU0, WS_FTC = WS_XC;
constexpr size_t WS_BAR = 255 * MiB;
constexpr size_t WS_END = 255 * MiB + 65536;
static_assert(WS_WD1 + 5632 * 1024 <= WS_H && WS_FT0 + 16 * MiB <= WS_H && WS_FT1 + 16 * MiB <= WS_WGU1, "ws map");
static_assert((size_t)MT * LDP * 2 <= 81 * MiB && (size_t)MT * 3072 * 2 <= 108 * MiB, "ws map");

constexpr int LDS_BYTES = 147456;
constexpr int LDS_XB = 144384;
constexpr int LDS_COSTAB = 131072;

typedef float f32x2_t __attribute__((ext_vector_type(2))); typedef __bf16 bf16x2_t __attribute__((ext_vector_type(2)));
__device__ __forceinline__ unsigned cvt_pk_bf16(float lo, float hi) { f32x2_t v = {lo, hi}; bf16x2_t b = __builtin_convertvector(v, bf16x2_t); return __builtin_bit_cast(unsigned, b); }
__device__ __forceinline__ unsigned f2bf(float f) { unsigned u = __float_as_uint(f); return (u + 0x7fffu + ((u >> 16) & 1u)) >> 16; }
__device__ __forceinline__ unsigned pk2(float lo, float hi) { return f2bf(lo) | (f2bf(hi) << 16); }
__device__ __forceinline__ float bflo(unsigned w) { return __uint_as_float(w << 16); }
__device__ __forceinline__ float bfhi(unsigned w) { return __uint_as_float(w & 0xffff0000u); }
__device__ __forceinline__ float fast_exp2(float x) { return __builtin_amdgcn_exp2f(x); }
__device__ __forceinline__ float fast_rcp(float x) { return __builtin_amdgcn_rcpf(x); }
__device__ __forceinline__ float sigmoidf_(float x) { return fast_rcp(1.0f + fast_exp2(-1.4426950408889634f * x)); }
__device__ __forceinline__ float wave_sum(float v) {
#pragma unroll
    for (int o = 1; o < 64; o <<= 1) v += __shfl_xor(v, o);
    return v;
}

namespace pg8 {
constexpr int BM = 256, BK = 64, HALF = 128, HTB = HALF * BK * 2, STAGE_BYTES = 8 * HTB, NXCD = 8, WGM = 4;
__host__ __device__ __forceinline__ int lds_byte(int r, int c) { const int st = (r >> 4) * 2 + (c >> 5), rr = r & 15, cc = c & 31, ob = rr * 64 + cc * 2; return st * 1024 + (ob ^ (((ob >> 9) & 1) << 5)); }
__host__ __device__ __forceinline__ void stage_rc(int b, int& R, int& C) { const int st = b / 1024, sb = b % 1024, swz = sb ^ (((sb >> 9) & 1) << 5); R = (st >> 1) * 16 + swz / 64; C = (st & 1) * 32 + (swz % 64) / 2; }
__host__ __device__ __forceinline__ int perm32(int rho) { const int n = rho >> 4, i = rho & 15; return 8 * (i >> 2) + 4 * n + (i & 3); }
struct Unit { int pm, pn; };
struct Gemm { const bf16_t* A; const bf16_t* Bt; int M, N, K, lda, ldb; };
struct StaticOrder {
    int nM, nN, nwg, G, c;
    __device__ void init(int M, int N, int G_, int c_) { nM = M / BM; nN = N / BM; nwg = nM * nN; G = G_; c = c_; }
    __device__ bool next(int i, Unit& u) const {
        const long L = (long)i * G + c; if (L >= nwg) return false;
        int wgid = (int)L; { const int q = nwg / NXCD, r = nwg % NXCD, xcd = wgid % NXCD, off = wgid / NXCD; wgid = (xcd < r ? xcd * (q + 1) : r * (q + 1) + (xcd - r) * q) + off; }
        const int nig = WGM * nN, gid = wgid / nig, fm = gid * WGM, gsz = (nM - fm) < WGM ? (nM - fm) : WGM;
        u.pm = fm + ((wgid % nig) % gsz); u.pn = (wgid % nig) / gsz; return true;
    }
};

template <class Epi, class Sched>
__device__ __forceinline__ void gemm_phase(LAS unsigned char* lds, const Gemm g, const Sched& S, const Epi& E, const int tid) {
    const int wid = __builtin_amdgcn_readfirstlane(tid >> 6), lane = tid & 63, wr = wid >> 2, wc = wid & 3, fr = lane & 15, fq = lane >> 4;
    const int K = g.K, nt = K / BK;
    unsigned voffA[2], voffB[2];
#pragma unroll
    for (int i = 0; i < 2; ++i) { int R, C; stage_rc(tid * 16 + i * 8192, R, C); const int Rb = (R & ~31) + perm32(R & 31);
        voffA[i] = (unsigned)(R * g.lda + C) * 2u; voffB[i] = (unsigned)(Rb * g.ldb + C) * 2u; }
    const size_t kstep = (size_t)(BK * 2);
    const size_t hA = (size_t)HALF * g.lda * 2, hB = (size_t)HALF * g.ldb * 2;
    const size_t tA = 2 * hA, tB = 2 * hB;
    const unsigned ldsw = (unsigned)wid * 1024u;
    const int aoff = lds_byte(wr * 64 + fr, fq * 8), boff = lds_byte(wc * 32 + fr, fq * 8);
#define PG8_SA(b, h) (((b) * 2 + (h)) * HTB)
#define PG8_SB(b, h) ((4 + (b) * 2 + (h)) * HTB)
#define PG8_STAGE(bufoff, gbase, voff) do { _Pragma("unroll") for (int _i = 0; _i < 2; ++_i) \
        __builtin_amdgcn_global_load_lds((const unsigned*)((const char*)(gbase) + (voff)[_i]), (LAS unsigned*)(lds + (bufoff) + ldsw + _i * 8192), 16, 0, 0); } while (0)
#define PG8_LDA(dst, b, h) do { _Pragma("unroll") for (int m = 0; m < 4; ++m) _Pragma("unroll") for (int k = 0; k < 2; ++k) dst[m][k] = *(const LAS bf16x8*)(lds + PG8_SA(b, h) + aoff + m * 2048 + k * 1024); } while (0)
#define PG8_LDB(dst, b, h) do { _Pragma("unroll") for (int n = 0; n < 2; ++n) _Pragma("unroll") for (int k = 0; k < 2; ++k) dst[n][k] = *(const LAS bf16x8*)(lds + PG8_SB(b, h) + boff + n * 2048 + k * 1024); } while (0)
#define PG8_MMA(ai, bj, At, Bt) do { __builtin_amdgcn_s_setprio(1); _Pragma("unroll") for (int m = 0; m < 4; ++m) _Pragma("unroll") for (int n = 0; n < 2; ++n) _Pragma("unroll") for (int k = 0; k < 2; ++k) \
        acc[ai][bj][m][n] = __builtin_amdgcn_mfma_f32_16x16x32_bf16(Bt[n][k], At[m][k], acc[ai][bj][m][n], 0, 0, 0); __builtin_amdgcn_s_setprio(0); } while (0)
#define PG8_WAIT_V(n) asm volatile("s_waitcnt vmcnt(" #n ")" ::: "memory")
#define PG8_WAIT_L(n) asm volatile("s_waitcnt lgkmcnt(" #n ")" ::: "memory")
#define PG8_BAR __builtin_amdgcn_s_barrier()
#define PG8_SCHED __builtin_amdgcn_sched_barrier(0)
    Unit cur, nxt; int ui = 0;
    if (!S.next(0, cur)) return;
    const bool hz = E.horner();
    f32x4 acc[2][2][4][2];
#pragma unroll
    for (int a = 0; a < 2; ++a)
#pragma unroll
        for (int b = 0; b < 2; ++b)
#pragma unroll
            for (int m = 0; m < 4; ++m)
#pragma unroll
                for (int n = 0; n < 2; ++n) acc[a][b][m][n] = (f32x4){0.f, 0.f, 0.f, 0.f};
    bf16x8 At[4][2], B0[2][2], B1[2][2];
    const char* cA = (const char*)g.A + (size_t)cur.pm * tA; const char* cB = (const char*)g.Bt + (size_t)cur.pn * tB;
    PG8_STAGE(PG8_SB(0, 0), cB, voffB); PG8_STAGE(PG8_SB(0, 1), cB + hB, voffB); PG8_STAGE(PG8_SA(0, 0), cA, voffA); PG8_STAGE(PG8_SA(0, 1), cA + hA, voffA);
    if (wr == 1) PG8_BAR;
    PG8_WAIT_V(2); PG8_BAR;
    PG8_STAGE(PG8_SB(1, 0), cB + kstep, voffB); PG8_STAGE(PG8_SA(1, 0), cA + kstep, voffA); PG8_STAGE(PG8_SB(1, 1), cB + hB + kstep, voffB);
    PG8_WAIT_V(6); PG8_BAR;
    for (;;) {
        const bool has_next = S.next(ui + 1, nxt);
        const char* nA = has_next ? (const char*)g.A + (size_t)nxt.pm * tA : cA; const char* nB = has_next ? (const char*)g.Bt + (size_t)nxt.pn * tB : cB;
        for (int t = 0; t < nt; t += 2) {
            if (hz && (t == 4 || t == 8)) E.mid(acc, cur, t >> 3, wr, wc, fr, fq);
            const bool last = (t == nt - 2);
            const char* a1 = cA + (size_t)(t + 1) * kstep;
            const char* a2 = last ? nA : cA + (size_t)(t + 2) * kstep; const char* b2 = last ? nB : cB + (size_t)(t + 2) * kstep;
            const char* a3 = a2 + kstep; const char* b3 = b2 + kstep;
            PG8_LDB(B0, 0, 0); PG8_LDB(B1, 0, 1); PG8_SCHED; PG8_LDA(At, 0, 0); PG8_STAGE(PG8_SA(1, 1), a1 + hA, voffA);
            PG8_WAIT_V(8); PG8_WAIT_L(0); PG8_BAR; PG8_MMA(0, 0, At, B0); PG8_MMA(0, 1, At, B1); PG8_BAR; PG8_SCHED;
            PG8_LDA(At, 0, 1); PG8_STAGE(PG8_SB(0, 0), b2, voffB); PG8_STAGE(PG8_SB(0, 1), b2 + hB, voffB); PG8_STAGE(PG8_SA(0, 0), a2, voffA);
            PG8_WAIT_V(8); PG8_WAIT_L(0); PG8_BAR; PG8_MMA(1, 0, At, B0); PG8_MMA(1, 1, At, B1); PG8_BAR; PG8_SCHED;
            PG8_LDB(B0, 1, 0); PG8_LDB(B1, 1, 1); PG8_SCHED; PG8_LDA(At, 1, 0); PG8_STAGE(PG8_SA(0, 1), a2 + hA, voffA);
            PG8_WAIT_V(8); PG8_WAIT_L(0); PG8_BAR; PG8_MMA(0, 0, At, B0); PG8_MMA(0, 1, At, B1); PG8_BAR; PG8_SCHED;
            PG8_LDA(At, 1, 1); PG8_STAGE(PG8_SB(1, 0), b3, voffB); PG8_STAGE(PG8_SB(1, 1), b3 + hB, voffB); PG8_STAGE(PG8_SA(1, 0), a3, voffA);
            PG8_WAIT_V(8); PG8_WAIT_L(0); PG8_BAR; PG8_MMA(1, 0, At, B0); PG8_MMA(1, 1, At, B1); PG8_BAR; PG8_SCHED;
        }
        if (wr == 0) PG8_BAR;
        E(acc, cur, wr, wc, fr, fq);
        if (!has_next) break;
#pragma unroll
        for (int a = 0; a < 2; ++a)
#pragma unroll
            for (int b = 0; b < 2; ++b)
#pragma unroll
                for (int m = 0; m < 4; ++m)
#pragma unroll
                    for (int n = 0; n < 2; ++n) acc[a][b][m][n] = (f32x4){0.f, 0.f, 0.f, 0.f};
        cur = nxt; cA = nA; cB = nB; ++ui;
        if (wr == 1) PG8_BAR;
    }
    PG8_WAIT_V(0);
    PG8_BAR;
#undef PG8_SA
#undef PG8_SB
#undef PG8_STAGE
#undef PG8_LDA
#undef PG8_LDB
#undef PG8_MMA
#undef PG8_WAIT_V
#undef PG8_WAIT_L
#undef PG8_BAR
#undef PG8_SCHED
}
}

enum { E_INPROJ = 0, E_GATE = 1, E_BRANCH = 2, E_RESID = 3, E_GU = 4, E_FOUR = 5 };
constexpr int LDS_EPI = 143360;
struct EpiD {
    int mode;
    int row_base;
    int ctx;
    int aux;
    float scale;
    int pad;
    void* out;
    const void* p1;
    const void* p2;
    void* p3; void* p4;
};
#define RFL2(x) ((unsigned)__builtin_amdgcn_readfirstlane((int)(x)))
struct Epi {
    const LAS unsigned* ed;
    __device__ __forceinline__ bool horner() const { return __builtin_amdgcn_readfirstlane((int)ed[0]) == E_BRANCH; }
    __device__ __forceinline__ void mid(f32x4 (&acc)[2][2][4][2], const pg8::Unit& u, int which, int wr, int wc, int fr, int fq) const {
        asm volatile("" : "+v"(fr), "+v"(fq));
        const int row_base = __builtin_amdgcn_readfirstlane((int)ed[1]);
        const unsigned lo = (unsigned)__builtin_amdgcn_readfirstlane((int)ed[8]), hi_ = (unsigned)__builtin_amdgcn_readfirstlane((int)ed[9]);
        const bf16_t* gbase = (const bf16_t*)(((unsigned long long)hi_ << 32) | lo) + (size_t)(row_base + u.pm * 256 + wr * 64 + fr) * 3072 + which * 1024 + u.pn * 256 + wc * 32 + 8 * fq;
#pragma unroll
        for (int ai = 0; ai < 2; ++ai) {
            u32x4 na[4][2], nb[4][2];
#pragma unroll
            for (int m = 0; m < 4; ++m)
#pragma unroll
                for (int bj = 0; bj < 2; ++bj) { const bf16_t* gp = gbase + (size_t)(ai * 128 + m * 16) * 3072 + bj * 128; na[m][bj] = *(const GAS u32x4*)gp; nb[m][bj] = *(const GAS u32x4*)(gp + 1024); }
            __builtin_amdgcn_sched_barrier(0);
#pragma unroll
            for (int m = 0; m < 4; ++m)
#pragma unroll
                for (int bj = 0; bj < 2; ++bj) {
                    const u32x4 xa = na[m][bj], xb = nb[m][bj];
                    f32x4 r0, r1;
                    r0[0] = bflo(xa.x) * fast_rcp(bflo(xb.x)); r0[1] = bfhi(xa.x) * fast_rcp(bfhi(xb.x)); r0[2] = bflo(xa.y) * fast_rcp(bflo(xb.y)); r0[3] = bfhi(xa.y) * fast_rcp(bfhi(xb.y));
                    r1[0] = bflo(xa.z) * fast_rcp(bflo(xb.z)); r1[1] = bfhi(xa.z) * fast_rcp(bfhi(xb.z)); r1[2] = bflo(xa.w) * fast_rcp(bflo(xb.w)); r1[3] = bfhi(xa.w) * fast_rcp(bfhi(xb.w));
                    acc[ai][bj][m][0] = acc[ai][bj][m][0] * r0; acc[ai][bj][m][1] = acc[ai][bj][m][1] * r1;
                }
            __builtin_amdgcn_sched_barrier(0);
        }
    }
    __device__ __forceinline__ void operator()(const f32x4 (&acc)[2][2][4][2], const pg8::Unit& u, int wr, int wc, int fr, int fq) const {
        asm volatile("" : "+v"(fr), "+v"(fq));
#define RFL(x) ((unsigned)__builtin_amdgcn_readfirstlane((int)(x)))
        const int mode = (int)RFL(ed[0]), row_base = (int)RFL(ed[1]), ctx = (int)RFL(ed[2]), aux = (int)RFL(ed[3]);
        const float scale = __uint_as_float(RFL(ed[4]));
        void* const out = (void*)(((unsigned long long)RFL(ed[7]) << 32) | RFL(ed[6]));
        const void* const p1 = (const void*)(((unsigned long long)RFL(ed[9]) << 32) | RFL(ed[8]));
        const void* const p2 = (const void*)(((unsigned long long)RFL(ed[11]) << 32) | RFL(ed[10]));
#undef RFL
        const int r0 = u.pm * 256 + wr * 64 + fr;
        const int c0 = wc * 32 + 8 * fq;
        const int colt = u.pn * 256;
        if (mode == E_INPROJ) {
            const int ct = aux + u.pn;
            const float* bias = (const float*)p1;
            if (ct < 2) {
                const int gpm = (row_base >> 8) + u.pm;
                bf16_t* dst; int ld, n0;
                if (ctx) { const int b = gpm - 64; dst = (bf16_t*)(((unsigned long long)RFL2(ed[15]) << 32) | RFL2(ed[14])) + (size_t)(b * 256) * 512 + ct * 256; ld = 512; n0 = 0; }
                else { const int b = gpm >> 3; dst = (bf16_t*)(((unsigned long long)RFL2(ed[13]) << 32) | RFL2(ed[12])) + (size_t)(b * 256) * 4096 + ct * 2048; ld = 4096; n0 = (gpm & 7) * 256; }
                LAS unsigned char* stg = (LAS unsigned char*)ed - LDS_EPI + 131072 + (wr * 4 + wc) * 1536;
                const int lane_ = fq * 16 + fr, tcol = lane_ >> 1, thalf = lane_ & 1;
#pragma unroll
                for (int bj = 0; bj < 2; ++bj) {
                    const f32x4 b0 = *(const GAS f32x4*)(bias + colt + bj * 128 + c0), b1 = *(const GAS f32x4*)(bias + colt + bj * 128 + c0 + 4);
                    bf16_t* dcol = dst + (size_t)(bj * 128 + wc * 32 + tcol) * ld + n0 + wr * 64 + thalf * 8;
#pragma unroll
                    for (int ai = 0; ai < 2; ++ai)
#pragma unroll
                        for (int m = 0; m < 4; ++m) {
                            const f32x4 v0 = acc[ai][bj][m][0] + b0, v1 = acc[ai][bj][m][1] + b1;
                            LAS bf16_t* sp = (LAS bf16_t*)stg + (fq * 8) * 16 + fr;
                            sp[0 * 16] = (bf16_t)f2bf(v0[0]); sp[1 * 16] = (bf16_t)f2bf(v0[1]); sp[2 * 16] = (bf16_t)f2bf(v0[2]); sp[3 * 16] = (bf16_t)f2bf(v0[3]);
                            sp[4 * 16] = (bf16_t)f2bf(v1[0]); sp[5 * 16] = (bf16_t)f2bf(v1[1]); sp[6 * 16] = (bf16_t)f2bf(v1[2]); sp[7 * 16] = (bf16_t)f2bf(v1[3]);
                            asm volatile("s_waitcnt lgkmcnt(0)" ::: "memory");
                            const u32x4 w = *(const LAS u32x4*)(stg + tcol * 32 + thalf * 16);
                            *(GAS u32x4*)(dcol + ai * 128 + m * 16) = w;
                            asm volatile("s_waitcnt lgkmcnt(0)" ::: "memory");
                        }
                }
            } else {
                const bool isqk = (ct >= 5 && ct <= 8), dorope = isqk && !ctx;
                const float sc = (ct == 5 || ct == 6) ? QSCALE : 1.0f;
                const int axis = wc & 1, half = fq >> 1;
                const float* rope = (const float*)p2 + 8 * (fq & 1);
                bf16_t* obase = (bf16_t*)out + (size_t)(row_base + r0) * LDP + (ct - 2) * 256 + c0;
#pragma unroll
                for (int bj = 0; bj < 2; ++bj) {
                    const f32x4 b0 = *(const GAS f32x4*)(bias + colt + bj * 128 + c0), b1 = *(const GAS f32x4*)(bias + colt + bj * 128 + c0 + 4);
#pragma unroll
                    for (int ai = 0; ai < 2; ++ai)
#pragma unroll
                        for (int m = 0; m < 4; ++m) {
                            f32x4 v0 = acc[ai][bj][m][0] + b0, v1 = acc[ai][bj][m][1] + b1;
                            if (dorope) {
                                const int t = (row_base + r0 + ai * 128 + m * 16) & 2047, pos = axis ? (t & 63) : (t >> 6);
                                const float* cp = rope + pos * 16;
                                const f32x4 cs0 = *(const GAS f32x4*)cp, cs1 = *(const GAS f32x4*)(cp + 4), sn0 = *(const GAS f32x4*)(cp + 1024), sn1 = *(const GAS f32x4*)(cp + 1028);
                                f32x4 w0, w1;
#pragma unroll
                                for (int j = 0; j < 4; ++j) { w0[j] = __shfl_xor(v0[j], 32); w1[j] = __shfl_xor(v1[j], 32); }
                                if (half) { v0 = v0 * cs0 + w0 * sn0; v1 = v1 * cs1 + w1 * sn1; }
                                else { v0 = v0 * cs0 - w0 * sn0; v1 = v1 * cs1 - w1 * sn1; }
                            }
                            v0 = v0 * sc; v1 = v1 * sc;
                            u32x4 w; w.x = cvt_pk_bf16(v0[0], v0[1]); w.y = cvt_pk_bf16(v0[2], v0[3]); w.z = cvt_pk_bf16(v1[0], v1[1]); w.w = cvt_pk_bf16(v1[2], v1[3]);
                            *(GAS u32x4*)(obase + (size_t)(ai * 128 + m * 16) * LDP + bj * 128) = w;
                        }
                }
            }
        } else if (mode == E_GATE) {
            const float* bias = (const float*)p1;
            bf16_t* obase = (bf16_t*)out + (size_t)(row_base + r0) * 3072 + colt + c0;
#pragma unroll
            for (int bj = 0; bj < 2; ++bj) {
                const f32x4 b0 = *(const GAS f32x4*)(bias + colt + bj * 128 + c0), b1 = *(const GAS f32x4*)(bias + colt + bj * 128 + c0 + 4);
#pragma unroll
                for (int ai = 0; ai < 2; ++ai)
#pragma unroll
                    for (int m = 0; m < 4; ++m) {
                        f32x4 v0 = acc[ai][bj][m][0] + b0, v1 = acc[ai][bj][m][1] + b1;
#pragma unroll
                        for (int j = 0; j < 4; ++j) { v0[j] = fmaxf(sigmoidf_(v0[j]), 1e-18f); v1[j] = fmaxf(sigmoidf_(v1[j]), 1e-18f); }
                        u32x4 w; w.x = cvt_pk_bf16(v0[0], v0[1]); w.y = cvt_pk_bf16(v0[2], v0[3]); w.z = cvt_pk_bf16(v1[0], v1[1]); w.w = cvt_pk_bf16(v1[2], v1[3]);
                        *(GAS u32x4*)(obase + (size_t)(ai * 128 + m * 16) * 3072 + bj * 128) = w;
                    }
            }
        } else if (mode == E_BRANCH) {
            const bf16_t* gbase = (const bf16_t*)p1 + (size_t)(row_base + r0) * 3072 + 2048 + colt + c0;
            bf16_t* ybase = (bf16_t*)out + (size_t)(row_base + r0) * 1024 + colt + c0;
            u32x4 gw[2][4][2];
#pragma unroll
            for (int ai = 0; ai < 2; ++ai)
#pragma unroll
                for (int m = 0; m < 4; ++m)
#pragma unroll
                    for (int bj = 0; bj < 2; ++bj) gw[ai][m][bj] = *(const GAS u32x4*)(gbase + (size_t)(ai * 128 + m * 16) * 3072 + bj * 128);
            __builtin_amdgcn_sched_barrier(0);
#pragma unroll
            for (int ai = 0; ai < 2; ++ai)
#pragma unroll
                for (int m = 0; m < 4; ++m) {
#pragma unroll
                    for (int bj = 0; bj < 2; ++bj) {
                        const u32x4 g = gw[ai][m][bj];
                        const f32x4 g0 = (f32x4){bflo(g.x), bfhi(g.x), bflo(g.y), bfhi(g.y)}, g1 = (f32x4){bflo(g.z), bfhi(g.z), bflo(g.w), bfhi(g.w)};
                        const f32x4 y0 = g0 * acc[ai][bj][m][0], y1 = g1 * acc[ai][bj][m][1];
                        u32x4 w; w.x = cvt_pk_bf16(y0[0], y0[1]); w.y = cvt_pk_bf16(y0[2], y0[3]); w.z = cvt_pk_bf16(y1[0], y1[1]); w.w = cvt_pk_bf16(y1[2], y1[3]);
                        *(GAS u32x4*)(ybase + (size_t)(ai * 128 + m * 16) * 1024 + bj * 128) = w;
                    }
                }
        } else if (mode == E_RESID) {
            const float* xin = (const float*)p1 + (size_t)r0 * 1024 + colt + c0;
            float* xout = (float*)out + (size_t)r0 * 1024 + colt + c0;
            const int b = ctx ? 8 : (u.pm >> 3);
            const float* modg = (const float*)p2 + (size_t)b * 6144 + colt + c0;
            f32x4 gv[2][2];
#pragma unroll
            for (int bj = 0; bj < 2; ++bj) { gv[bj][0] = *(const GAS f32x4*)(modg + bj * 128); gv[bj][1] = *(const GAS f32x4*)(modg + bj * 128 + 4); }
#pragma unroll
            for (int ai = 0; ai < 2; ++ai) {
                f32x4 xv[4][2][2];
#pragma unroll
                for (int m = 0; m < 4; ++m)
#pragma unroll
                    for (int bj = 0; bj < 2; ++bj) { const float* xi = xin + (size_t)(ai * 128 + m * 16) * 1024 + bj * 128; xv[m][bj][0] = *(const GAS f32x4*)xi; xv[m][bj][1] = *(const GAS f32x4*)(xi + 4); }
                __builtin_amdgcn_sched_barrier(0);
#pragma unroll
                for (int m = 0; m < 4; ++m)
#pragma unroll
                    for (int bj = 0; bj < 2; ++bj) { float* xo = xout + (size_t)(ai * 128 + m * 16) * 1024 + bj * 128;
                        *(GAS f32x4*)xo = xv[m][bj][0] + gv[bj][0] * acc[ai][bj][m][0]; *(GAS f32x4*)(xo + 4) = xv[m][bj][1] + gv[bj][1] * acc[ai][bj][m][1]; }
                __builtin_amdgcn_sched_barrier(0);
            }
        } else if (mode == E_GU) {
            bf16_t* obase = (bf16_t*)out + (size_t)(row_base + r0) * DFF + u.pn * 128 + c0;
#pragma unroll
            for (int ai = 0; ai < 2; ++ai)
#pragma unroll
                for (int m = 0; m < 4; ++m) {
                    f32x4 v0, v1;
#pragma unroll
                    for (int j = 0; j < 4; ++j) { const float a = acc[ai][0][m][0][j], b = acc[ai][0][m][1][j];
                        v0[j] = a * sigmoidf_(a) * acc[ai][1][m][0][j]; v1[j] = b * sigmoidf_(b) * acc[ai][1][m][1][j]; }
                    u32x4 w; w.x = cvt_pk_bf16(v0[0], v0[1]); w.y = cvt_pk_bf16(v0[2], v0[3]); w.z = cvt_pk_bf16(v1[0], v1[1]); w.w = cvt_pk_bf16(v1[2], v1[3]);
                    *(GAS u32x4*)(obase + (size_t)(ai * 128 + m * 16) * DFF) = w;
                }
        } else {
            const int L = ctx ? CTXL : SEQ;
            bf16_t* obase = (bf16_t*)out + (size_t)(row_base + u.pn * L + r0) * 1024 + c0;
#pragma unroll
            for (int ai = 0; ai < 2; ++ai)
#pragma unroll
                for (int m = 0; m < 4; ++m) {
#pragma unroll
                    for (int bj = 0; bj < 2; ++bj) {
                        const f32x4 v0 = acc[ai][bj][m][0] * scale, v1 = acc[ai][bj][m][1] * scale;
                        u32x4 w; w.x = cvt_pk_bf16(v0[0], v0[1]); w.y = cvt_pk_bf16(v0[2], v0[3]); w.z = cvt_pk_bf16(v1[0], v1[1]); w.w = cvt_pk_bf16(v1[2], v1[3]);
                        *(GAS u32x4*)(obase + (size_t)(ai * 128 + m * 16) * 1024 + bj * 128) = w;
                    }
                }
        }
    }
};

struct Args {
    const float* in[25];
    float* out; unsigned char* ws;
    int ph_lo, ph_hi;
};
enum { I_X = 0, I_C, I_CTX, I_CCTX, I_WADA, I_BADA, I_N1G, I_N2G, I_WIN, I_BIN, I_CONVW, I_CONVB, I_WFO, I_WCO, I_WAO, I_LQ1, I_LK1, I_LQ2, I_LK2, I_SUBG, I_WOUT, I_WG, I_WU, I_WD, I_FING };

struct Frame {
    LAS unsigned char* lds;
    int tid, lane, wave, G, bx, vcu, rot;
};

struct GJob { const bf16_t* A; const bf16_t* Bt; int lda, ldb, M, N, K, rot; int gfirst, gsub; EpiD E; };
__device__ __forceinline__ void gemm_call(Frame& F, const GJob& j) {
    pg8::Gemm g{j.A, j.Bt, j.M, j.N, j.K, j.lda, j.ldb};
    if (j.rot >= 0) F.rot = j.rot % F.G;
    pg8::StaticOrder S; int c = F.bx - F.rot; if (c < 0) c += F.G;
    int Ge = F.G;
    if (j.gsub > 0) { Ge = j.gsub; c = F.bx - j.gfirst; if (c < 0 || c >= j.gsub) c = 1 << 28; }
    S.init(j.M, j.N, Ge, c);
    if (F.tid == 0) { LAS unsigned* d = (LAS unsigned*)(F.lds + LDS_EPI);
        const unsigned long long o_ = (unsigned long long)j.E.out, a_ = (unsigned long long)j.E.p1, b_ = (unsigned long long)j.E.p2;
        d[0] = (unsigned)j.E.mode; d[1] = (unsigned)j.E.row_base; d[2] = (unsigned)j.E.ctx; d[3] = (unsigned)j.E.aux; d[4] = __float_as_uint(j.E.scale); d[5] = 0u;
        d[6] = (unsigned)o_; d[7] = (unsigned)(o_ >> 32); d[8] = (unsigned)a_; d[9] = (unsigned)(a_ >> 32); d[10] = (unsigned)b_; d[11] = (unsigned)(b_ >> 32);
        const unsigned long long c_ = (unsigned long long)j.E.p3, e_ = (unsigned long long)j.E.p4; d[12] = (unsigned)c_; d[13] = (unsigned)(c_ >> 32); d[14] = (unsigned)e_; d[15] = (unsigned)(e_ >> 32); }
    __syncthreads();
    Epi E{(const LAS unsigned*)(F.lds + LDS_EPI)};
    pg8::gemm_phase<Epi, pg8::StaticOrder>(F.lds, g, S, E, F.tid);
    F.rot = (F.rot + (j.M / 256) * (j.N / 256)) % F.G;
}

__device__ __forceinline__ void tr_item(const float* src, int ldsrc, bf16_t* dst, int ldd, LAS float* scr, int lane) {
#pragma unroll 8
    for (int i = 0; i < 32; ++i) { const int kk = 2 * i + (lane >> 5); scr[kk * 33 + (lane & 31)] = src[(size_t)kk * ldsrc + (lane & 31)]; }
    asm volatile("s_waitcnt lgkmcnt(0)" ::: "memory");
    const int c = lane & 7;
#pragma unroll
    for (int j = 0; j < 4; ++j) { const int n = (lane >> 3) + 8 * j; const LAS float* s = scr + (8 * c) * 33 + n;
        u32x4 o; o.x = pk2(s[0 * 33], s[1 * 33]); o.y = pk2(s[2 * 33], s[3 * 33]); o.z = pk2(s[4 * 33], s[5 * 33]); o.w = pk2(s[6 * 33], s[7 * 33]);
        *(u32x4*)(dst + (size_t)n * ldd + 8 * c) = o; }
    asm volatile("s_waitcnt lgkmcnt(0)" ::: "memory");
}

__device__ __forceinline__ void conv_setA(Frame& F, const Args& a, int l, int pidx, int pcnt, int part) {
    unsigned char* ws = a.ws;
    bf16_t* Win = (bf16_t*)(ws + WS_WIN); bf16_t* Wb = (bf16_t*)(ws + WS_WB); bf16_t* Wout = (bf16_t*)(ws + WS_WOUT);
    const float* w_in = a.in[I_WIN] + (size_t)l * D * DIN;
    LAS float* scr = (LAS float*)(F.lds + F.wave * 16384);
    const int gw = pidx * 8 + F.wave, NGW = pcnt * 8;
    constexpr int I1 = 16 * 168, I2 = 128, I3 = 128, I4 = 256, I5 = 512;
    for (int it = gw; it < I1 + I2 + I3 + I4 + I5; it += NGW) {
        int r = it;
        if (r < I1) { const int kb = r / 168, nb = r % 168, k0 = kb * 64, n0 = 256 + nb * 32;
            if (!((part >> (nb >= 72 ? 1 : 0)) & 1)) continue;
            tr_item(w_in + (size_t)k0 * DIN + n0, DIN, Win + (size_t)(n0 + 256) * 1024 + k0, 1024, scr, F.lane); continue; } r -= I1;
        if (!(part & 2)) break;
        if (r < I2) { const int kb = r / 32, nb = r % 32; tr_item(a.in[I_WFO] + (size_t)l * 256 * D + (size_t)kb * 64 * D + nb * 32, D, Wb + (size_t)(nb * 32) * 1024 + kb * 64, 1024, scr, F.lane); continue; } r -= I2;
        if (r < I3) { const int kb = r / 32, nb = r % 32; tr_item(a.in[I_WCO] + (size_t)l * 256 * D + (size_t)kb * 64 * D + nb * 32, D, Wb + (size_t)(nb * 32) * 1024 + 256 + kb * 64, 1024, scr, F.lane); continue; } r -= I3;
        if (r < I4) { const int kb = r / 32, nb = r % 32; tr_item(a.in[I_WAO] + (size_t)l * 512 * D + (size_t)kb * 64 * D + nb * 32, D, Wb + (size_t)(nb * 32) * 1024 + 512 + kb * 64, 1024, scr, F.lane); continue; } r -= I4;
        { const int kb = r / 32, nb = r % 32; tr_item(a.in[I_WOUT] + (size_t)l * D * D + (size_t)kb * 64 * D + nb * 32, D, Wout + (size_t)(nb * 32) * 1024 + kb * 64, 1024, scr, F.lane); }
    }
    if (!(part & 1)) return;
    const LAS float* ct = (const LAS float*)(F.lds + LDS_COSTAB);
    const int gt = pidx * 512 + F.tid, NGT = pcnt * 512;
    for (int o = gt; o < 1024 * 128; o += NGT) {
        const int k = o & 1023, g = (o >> 10) & 3, mq = o >> 12;
        const float* wp = w_in + (size_t)k * DIN + g * 64;
        f32x4 wv[16];
#pragma unroll
        for (int i = 0; i < 16; ++i) wv[i] = *(const f32x4*)(wp + 4 * i);
#pragma unroll 1
        for (int mm = 0; mm < 2; ++mm) {
            const int m = mq * 2 + mm; float sc = 0.f, ss = 0.f;
#pragma unroll
            for (int j = 0; j < 64; ++j) { const int i = ((j * m) & 63) * 32; const float w = wv[j >> 2][j & 3]; sc += w * ct[i]; ss += w * ct[(i + 1536) & 2047]; }
            Win[(size_t)(g * 64 + m) * 1024 + k] = (bf16_t)f2bf(sc * 0.125f);
            Win[(size_t)(256 + g * 64 + m) * 1024 + k] = (bf16_t)f2bf(ss * 0.125f);
        }
    }
    float* bi = (float*)(ws + WS_BIASIN) + l * NIN; const float* b_in = a.in[I_BIN] + (size_t)l * DIN;
    for (int r = gt; r < NIN; r += NGT) {
        float v;
        if (r < 512) { const int pt = r >> 8, g = (r >> 6) & 3, m = r & 63; float s_ = 0.f;
            for (int j = 0; j < 64; ++j) { const int i = (j * m) & 63; s_ += b_in[g * 64 + j] * ct[(i * 32 + (pt ? 1536 : 0)) & 2047]; }
            v = s_ * 0.125f; }
        else v = b_in[r - 256];
        bi[r] = v;
    }
}
__device__ __forceinline__ void conv_setB(Frame& F, const Args& a, int l, int pidx, int pcnt) {
    unsigned char* ws = a.ws;
    bf16_t* Wgu = (bf16_t*)(ws + (l ? WS_WGU1 : WS_WGU0)); bf16_t* Wd = (bf16_t*)(ws + (l ? WS_WD1 : WS_WD0));
    LAS float* scr = (LAS float*)(F.lds + F.wave * 16384);
    const int gw = pidx * 8 + F.wave, NGW = pcnt * 8;
    constexpr int J1 = 16 * 88, J3 = 44 * 32;
    for (int it = gw; it < 2 * J1 + J3; it += NGW) {
        int r = it;
        if (r < 2 * J1) { const int up = r >= J1; if (up) r -= J1; const int kb = r / 88, nb = r % 88, n0 = nb * 32;
            const float* W = a.in[up ? I_WU : I_WG] + (size_t)l * D * DFF;
            tr_item(W + (size_t)kb * 64 * DFF + n0, DFF, Wgu + (size_t)((n0 >> 7) * 256 + up * 128 + (n0 & 127)) * 1024 + kb * 64, 1024, scr, F.lane); continue; }
        r -= 2 * J1;
        { const int kb = r / 32, nb = r % 32; tr_item(a.in[I_WD] + (size_t)l * DFF * D + (size_t)kb * 64 * D + nb * 32, D, Wd + (size_t)(nb * 32) * DFF + kb * 64, DFF, scr, F.lane); }
    }
}

__device__ __forceinline__ void norm_row(const float* xrow, const float* g, const float* sh, const float* sc, bf16_t* orow, float* fout, int lane) {
    f32x4 v[4]; float s = 0.f;
#pragma unroll
    for (int j = 0; j < 4; ++j) { v[j] = *((const f32x4*)xrow + lane + 64 * j); s += (v[j].x * v[j].x + v[j].y * v[j].y) + (v[j].z * v[j].z + v[j].w * v[j].w); }
    const float rstd = 1.0f / sqrtf(wave_sum(s) * (1.0f / D) + EPS);
#pragma unroll
    for (int j = 0; j < 4; ++j) {
        const int c = (lane + 64 * j) * 4;
        f32x4 y = v[j] * rstd * *(const f32x4*)(g + c);
        if (fout) { *(f32x4*)(fout + c) = y; }
        else { y = y * (*(const f32x4*)(sc + c) + 1.0f) + *(const f32x4*)(sh + c);
            u32x2 w; w.x = cvt_pk_bf16(y.x, y.y); w.y = cvt_pk_bf16(y.z, y.w); *(u32x2*)(orow + c) = w; }
    }
}
__device__ __forceinline__ void norm_phase(Frame& F, const float* xl, const float* xc, const float* g, const float* mod, int sh_off, int sc_off, bf16_t* H, bool with_ctx) {
    const int gw = F.vcu * 8 + F.wave, NGW = F.G * 8, nrows = with_ctx ? MT : ML;
    for (int r = gw; r < nrows; r += NGW) {
        const int b = r < ML ? (r >> 11) : 8;
        const float* xr = r < ML ? xl + (size_t)r * D : xc + (size_t)(r - ML) * D;
        norm_row(xr, g, mod + (size_t)b * 6144 + sh_off, mod + (size_t)b * 6144 + sc_off, H + (size_t)r * D, nullptr, F.lane);
    }
}

__device__ __forceinline__ int crow(int r, int hi) { return (r & 3) + 8 * (r >> 2) + 4 * hi; }
__device__ __forceinline__ s16x4 vtr(const LAS unsigned char* p) { return __builtin_bit_cast(s16x4, __builtin_amdgcn_ds_read_tr16_b64_v4i16((LAS s16x4*)p)); }
constexpr int AT_WSF = 131072;
__device__ __forceinline__ void at_softmax(f32x16& p0, f32x16& p1, f32x16& negm, float& mhat, float& lsum, f32x16 (&o)[4], bf16x8 (&pa)[4], LAS float* wsf, bool first, int r32, int hi) {
    float rm = fmaxf(fmaxf(p0[0], p0[1]), p1[0]);
    { float rb = fmaxf(fmaxf(p0[2], p0[3]), p1[1]); rm = fmaxf(fmaxf(rm, p1[2]), p1[3]);
#pragma unroll
      for (int r = 4; r < 16; r += 4) { rm = fmaxf(fmaxf(rm, p0[r]), p0[r + 1]); rb = fmaxf(fmaxf(rb, p0[r + 2]), p0[r + 3]); rm = fmaxf(fmaxf(rm, p1[r]), p1[r + 1]); rb = fmaxf(fmaxf(rb, p1[r + 2]), p1[r + 3]); }
      rm = fmaxf(rm, rb); }
    rm = fmaxf(rm, __shfl_xor(rm, 32));
    const bool need = first || (rm > 6.0f);
    if (__any(need)) {
        const float dl = need ? rm : 0.f;
        mhat += dl;
#pragma unroll
        for (int r = 0; r < 16; ++r) { p0[r] -= dl; p1[r] -= dl; negm[r] = -mhat; }
        if (!first) {
            const float f = fast_exp2(-dl);
            lsum *= f;
            asm volatile("" ::: "memory");
            if (hi == 0) wsf[r32] = f;
            asm volatile("s_waitcnt lgkmcnt(0)" ::: "memory");
#pragma unroll
            for (int r = 0; r < 16; ++r) { const float fr_ = wsf[crow(r, hi)];
#pragma unroll
                for (int d0 = 0; d0 < 4; ++d0) o[d0][r] *= fr_; }
            asm volatile("s_waitcnt lgkmcnt(0)" ::: "memory");
        }
    }
    f32x2_t ls2 = (f32x2_t){0.f, 0.f};
#pragma unroll
    for (int r = 0; r < 16; r += 2) { p0[r] = fast_exp2(p0[r]); p0[r + 1] = fast_exp2(p0[r + 1]); p1[r] = fast_exp2(p1[r]); p1[r + 1] = fast_exp2(p1[r + 1]);
        ls2 += (f32x2_t){p0[r], p0[r + 1]}; ls2 += (f32x2_t){p1[r], p1[r + 1]}; }
    lsum += ls2.x + ls2.y;
    u32x4 w;
    w.x = cvt_pk_bf16(p0[0], p0[1]); w.y = cvt_pk_bf16(p0[2], p0[3]); w.z = cvt_pk_bf16(p0[4], p0[5]); w.w = cvt_pk_bf16(p0[6], p0[7]); pa[0] = __builtin_bit_cast(bf16x8, w);
    w.x = cvt_pk_bf16(p0[8], p0[9]); w.y = cvt_pk_bf16(p0[10], p0[11]); w.z = cvt_pk_bf16(p0[12], p0[13]); w.w = cvt_pk_bf16(p0[14], p0[15]); pa[1] = __builtin_bit_cast(bf16x8, w);
    w.x = cvt_pk_bf16(p1[0], p1[1]); w.y = cvt_pk_bf16(p1[2], p1[3]); w.z = cvt_pk_bf16(p1[4], p1[5]); w.w = cvt_pk_bf16(p1[6], p1[7]); pa[2] = __builtin_bit_cast(bf16x8, w);
    w.x = cvt_pk_bf16(p1[8], p1[9]); w.y = cvt_pk_bf16(p1[10], p1[11]); w.z = cvt_pk_bf16(p1[12], p1[13]); w.w = cvt_pk_bf16(p1[14], p1[15]); pa[3] = __builtin_bit_cast(bf16x8, w);
}
__device__ __forceinline__ void attn_unit(Frame& F, const bf16_t* P, bf16_t* BR, int qrow0, int base1, int n1, int base2, int nt, int h, float lam, float oscale, const float* subg) {
    LAS unsigned char* lds = F.lds;
    const int tid = F.tid, lane = F.lane, wid = F.wave, r32 = lane & 31, hi = lane >> 5, qg = wid & 3, comp = wid >> 2;
    bf16x8 qf[4];
    { const bf16_t* qp = P + (size_t)(qrow0 + qg * 32 + r32) * LDP + PQ + h * 128 + comp * 64 + hi * 8;
#pragma unroll
      for (int d0 = 0; d0 < 4; ++d0) qf[d0] = *(const bf16x8*)(qp + d0 * 16); }
    int ksrc[2], kdst[2], vsrc[2], vdst[2];
#pragma unroll
    for (int i = 0; i < 2; ++i) { const int pc = wid * 2 + i;
        { const int cmp = pc >> 3, rg = pc & 7, row = rg * 8 + (lane >> 3), c8 = (lane & 7) ^ (lane >> 3); ksrc[i] = row * LDP + PK + h * 128 + cmp * 64 + c8 * 8; kdst[i] = cmp * 8192 + rg * 1024; }
        { const int d0 = pc >> 2, rg = pc & 3; vsrc[i] = (rg * 16 + (lane >> 2)) * LDP + PV + h * 128 + d0 * 32 + (lane & 3) * 8; vdst[i] = 16384 + d0 * 4096 + rg * 1024; } }
#define AT_TROW(t) ((t) < n1 ? base1 + 64 * (t) : base2 + 64 * ((t) - n1))
    LAS float* wsf = (LAS float*)(lds + AT_WSF) + wid * 64;
    float mhat = 0.f, lsum = 0.f;
    f32x16 negm;
#pragma unroll
    for (int r = 0; r < 16; ++r) negm[r] = 0.f;
    f32x16 o[4];
#pragma unroll
    for (int d0 = 0; d0 < 4; ++d0)
#pragma unroll
        for (int r = 0; r < 16; ++r) o[d0][r] = 0.f;
    bf16x8 pa[4];
#pragma unroll
    for (int i = 0; i < 4; ++i) pa[i] = (bf16x8){0, 0, 0, 0, 0, 0, 0, 0};
    s16x4 va[8], vb[8];
#pragma unroll
    for (int i = 0; i < 8; ++i) { va[i] = (s16x4){0, 0, 0, 0}; vb[i] = (s16x4){0, 0, 0, 0}; }
    const int vlane = ((lane >> 4) & 1) * 32 + (lane & 3) * 8 + (4 * hi + ((lane & 15) >> 2)) * 64;
    const int klane = comp * 8192 + r32 * 128;
    int koff[4];
#pragma unroll
    for (int d0 = 0; d0 < 4; ++d0) koff[d0] = ((2 * d0 + hi) ^ (r32 & 7)) * 16;
#define AT_SB() __builtin_amdgcn_sched_barrier(0)
#define AT_DMA4(t, OFF) do { const bf16_t* tp = P + (size_t)AT_TROW(t) * LDP; \
        __builtin_amdgcn_global_load_lds((const unsigned*)(tp + ksrc[0]), (LAS unsigned*)(lds + (OFF) + kdst[0]), 16, 0, 0); \
        __builtin_amdgcn_global_load_lds((const unsigned*)(tp + ksrc[1]), (LAS unsigned*)(lds + (OFF) + kdst[1]), 16, 0, 0); \
        __builtin_amdgcn_global_load_lds((const unsigned*)(tp + vsrc[0]), (LAS unsigned*)(lds + (OFF) + vdst[0]), 16, 0, 0); \
        __builtin_amdgcn_global_load_lds((const unsigned*)(tp + vsrc[1]), (LAS unsigned*)(lds + (OFF) + vdst[1]), 16, 0, 0); } while (0)
#define AT_VF(x, s) ((bf16x8){x[2 * (s)][0], x[2 * (s)][1], x[2 * (s)][2], x[2 * (s)][3], x[2 * (s) + 1][0], x[2 * (s) + 1][1], x[2 * (s) + 1][2], x[2 * (s) + 1][3]})
#define AT_TR(dst, addr, off) asm volatile("ds_read_b64_tr_b16 %0, %1 offset:%c2" : "=&v"(dst) : "v"(addr), "i"(off) : "memory")
    const unsigned ldsb = (unsigned)(unsigned long long)lds;
#define AT_VPRE(OFF) do { const unsigned vp_ = ldsb + (OFF) + 16384 + vlane; \
        _Pragma("unroll") for (int s_ = 0; s_ < 4; ++s_) { AT_TR(va[2 * s_], vp_, s_ * 1024); AT_TR(va[2 * s_ + 1], vp_, s_ * 1024 + 512); AT_TR(vb[2 * s_], vp_, 4096 + s_ * 1024); AT_TR(vb[2 * s_ + 1], vp_, 4096 + s_ * 1024 + 512); } } while (0)
#define AT_PVMMA(OFF) do { const unsigned vp_ = ldsb + (OFF) + 16384 + vlane; \
        asm volatile("s_waitcnt lgkmcnt(0)" ::: "memory"); AT_SB(); __builtin_amdgcn_s_setprio(1); \
        _Pragma("unroll") for (int s_ = 0; s_ < 4; ++s_) { \
            o[0] = __builtin_amdgcn_mfma_f32_32x32x16_bf16(pa[s_], AT_VF(va, s_), o[0], 0, 0, 0); \
            o[1] = __builtin_amdgcn_mfma_f32_32x32x16_bf16(pa[s_], AT_VF(vb, s_), o[1], 0, 0, 0); \
            AT_SB(); \
            AT_TR(va[2 * s_], vp_, 8192 + s_ * 1024); AT_TR(va[2 * s_ + 1], vp_, 8192 + s_ * 1024 + 512); AT_TR(vb[2 * s_], vp_, 12288 + s_ * 1024); AT_TR(vb[2 * s_ + 1], vp_, 12288 + s_ * 1024 + 512); \
            AT_SB(); } \
        asm volatile("s_waitcnt lgkmcnt(0)" ::: "memory"); AT_SB(); \
        _Pragma("unroll") for (int s_ = 0; s_ < 4; ++s_) { \
            o[2] = __builtin_amdgcn_mfma_f32_32x32x16_bf16(pa[s_], AT_VF(va, s_), o[2], 0, 0, 0); \
            o[3] = __builtin_amdgcn_mfma_f32_32x32x16_bf16(pa[s_], AT_VF(vb, s_), o[3], 0, 0, 0); } \
        __builtin_amdgcn_s_setprio(0); AT_SB(); } while (0)
#define AT_STEP(t, CUR, NX2, PRV) do { \
        if ((t) + 2 < nt) AT_DMA4((t) + 2, NX2); \
        if (comp == 1 && (t) > 0) AT_PVMMA(PRV); \
        f32x16 p0, p1; \
        {   bf16x8 kf[8]; const LAS unsigned char* kb = lds + (CUR) + klane; \
            _Pragma("unroll") for (int d0 = 0; d0 < 4; ++d0) { kf[2 * d0] = *(const LAS bf16x8*)(kb + koff[d0]); kf[2 * d0 + 1] = *(const LAS bf16x8*)(kb + koff[d0] + 4096); } \
            AT_SB(); __builtin_amdgcn_s_setprio(1); \
            p0 = __builtin_amdgcn_mfma_f32_32x32x16_bf16(kf[0], qf[0], negm, 0, 0, 0); \
            p1 = __builtin_amdgcn_mfma_f32_32x32x16_bf16(kf[1], qf[0], negm, 0, 0, 0); \
            _Pragma("unroll") for (int d0 = 1; d0 < 4; ++d0) { \
                p0 = __builtin_amdgcn_mfma_f32_32x32x16_bf16(kf[2 * d0], qf[d0], p0, 0, 0, 0); \
                p1 = __builtin_amdgcn_mfma_f32_32x32x16_bf16(kf[2 * d0 + 1], qf[d0], p1, 0, 0, 0); } __builtin_amdgcn_s_setprio(0); } \
        AT_SB(); \
        AT_VPRE(CUR); \
        AT_SB(); \
        at_softmax(p0, p1, negm, mhat, lsum, o, pa, wsf, (t) == 0, r32, hi); \
        AT_SB(); \
        if (comp == 0) AT_PVMMA(CUR); \
          \
        if ((t) + 2 < nt) asm volatile("s_waitcnt vmcnt(4)" ::: "memory"); else asm volatile("s_waitcnt vmcnt(0)" ::: "memory"); \
        AT_SB(); __builtin_amdgcn_s_barrier(); AT_SB(); } while (0)
    AT_DMA4(0, 0);
    if (nt > 1) AT_DMA4(1, 32768);
    if (nt > 1) asm volatile("s_waitcnt vmcnt(4)" ::: "memory"); else asm volatile("s_waitcnt vmcnt(0)" ::: "memory");
    __syncthreads();
#pragma unroll 1
    for (int t = 0; t < nt; t += 4) {
        AT_STEP(t, 0, 65536, 98304);
        if (t + 1 < nt) AT_STEP(t + 1, 32768, 98304, 0);
        if (t + 2 < nt) AT_STEP(t + 2, 65536, 0, 32768);
        if (t + 3 < nt) AT_STEP(t + 3, 98304, 32768, 65536);
    }
    if (comp == 1) { const int lo_ = ((nt - 1) & 3) * 32768; AT_PVMMA(lo_); }
    __syncthreads();
#undef AT_STEP
#undef AT_PVMMA
#undef AT_VPRE
#undef AT_TR
#undef AT_VF
#undef AT_DMA4
#undef AT_SB
    lsum += __shfl_xor(lsum, 32);
    { float inv = 1.0f / lsum; if (comp) inv *= lam;
      asm volatile("" ::: "memory");
      if (hi == 0) wsf[r32] = inv;
      asm volatile("s_waitcnt lgkmcnt(0)" ::: "memory");
#pragma unroll
      for (int r = 0; r < 16; ++r) { const float fr_ = wsf[crow(r, hi)];
#pragma unroll
          for (int d0 = 0; d0 < 4; ++d0) o[d0][r] *= fr_; } }
    LAS float* X = (LAS float*)lds + qg * (32 * 132);
    if (comp == 1) {
#pragma unroll
        for (int d0 = 0; d0 < 4; ++d0)
#pragma unroll
            for (int r = 0; r < 16; ++r) X[crow(r, hi) * 132 + d0 * 32 + r32] = o[d0][r];
    }
    __syncthreads();
    if (comp == 0) {
#pragma unroll
        for (int d0 = 0; d0 < 4; ++d0)
#pragma unroll
            for (int r = 0; r < 16; ++r) { const int ix = crow(r, hi) * 132 + d0 * 32 + r32; X[ix] = o[d0][r] - X[ix]; }
        asm volatile("s_waitcnt lgkmcnt(0)" ::: "memory");
        const int row = lane >> 1, hf = lane & 1;
        const LAS float* xr = X + row * 132 + hf * 64;
        float ss = 0.f;
#pragma unroll
        for (int c = 0; c < 16; ++c) { const f32x4 v = *(const LAS f32x4*)(xr + c * 4); ss += (v.x * v.x + v.y * v.y) + (v.z * v.z + v.w * v.w); }
        ss += __shfl_xor(ss, 1);
        const float rstd = oscale / sqrtf(ss * (1.0f / 128.0f) + EPS);
        bf16_t* op = BR + (size_t)(qrow0 + qg * 32 + row) * 1024 + 512 + h * 128 + hf * 64;
        const float* gp = subg + hf * 64;
#pragma unroll
        for (int c = 0; c < 8; ++c) {
            const f32x4 v0 = *(const LAS f32x4*)(xr + c * 8) * rstd * *(const f32x4*)(gp + c * 8), v1 = *(const LAS f32x4*)(xr + c * 8 + 4) * rstd * *(const f32x4*)(gp + c * 8 + 4);
            u32x4 w; w.x = cvt_pk_bf16(v0.x, v0.y); w.y = cvt_pk_bf16(v0.z, v0.w); w.z = cvt_pk_bf16(v1.x, v1.y); w.w = cvt_pk_bf16(v1.z, v1.w);
            *(u32x4*)(op + c * 8) = w;
        }
    }
    __syncthreads();
#undef AT_TROW
}

#define XB_TMO      128
#define XB_XCNT(j)  (256  + 64 * (j))
#define XB_XSUB(j)  (1280 + 64 * (j))
#define XB_XGEN(j)  (2304 + 64 * (j))
#define XB_TOP      3328
#define XB_TOPGEN   3392
#define XCD_BAR_WORDS 3456
#define XB_SPIN_CAP (1u << 18)
__device__ __forceinline__ unsigned xb_ld(unsigned* p)              { return __hip_atomic_load(p, __ATOMIC_RELAXED, __HIP_MEMORY_SCOPE_AGENT); }
__device__ __forceinline__ unsigned xb_add(unsigned* p, unsigned v) { return __hip_atomic_fetch_add(p, v, __ATOMIC_RELAXED, __HIP_MEMORY_SCOPE_AGENT); }
__device__ __forceinline__ unsigned xb_xcc_id() { return (unsigned)__builtin_amdgcn_s_getreg((3 << 11) | 20) & 0xFu; }
#define XB_SPIN(cond, bar) do { unsigned _sp = 0; while (cond) { __builtin_amdgcn_s_sleep(1); \
    if ((++_sp & 255u) == 0u) { if (xb_ld(&(bar)[XB_TMO])) break; if (_sp > XB_SPIN_CAP) { atomicAdd(&(bar)[XB_TMO], 1u); break; } } } } while (0)
struct XcdBarrier { unsigned* bar; unsigned x; volatile LAS unsigned* st; };
__device__ __forceinline__ XcdBarrier xcd_barrier_post(unsigned* bar, volatile LAS unsigned* st) {
    XcdBarrier b; b.bar = bar; b.x = xb_xcc_id(); b.st = st;
    if (threadIdx.x == 0) (void)xb_add(&bar[XB_XCNT(b.x)], 1u);
    return b;
}
__device__ __forceinline__ void xcd_barrier_complete(unsigned* bar, unsigned x, unsigned& nloc, unsigned& nx) {
    const unsigned G = gridDim.x * gridDim.y * gridDim.z;
    unsigned sum, cnt, mine, sp = 0u;
    for (;;) {
        sum = 0u; cnt = 0u; mine = 0u;
#pragma unroll
        for (unsigned j = 0; j < 16; ++j) { const unsigned c = xb_ld(&bar[XB_XCNT(j)]); sum += c; cnt += (c > 0u) ? 1u : 0u; mine = (j == x) ? c : mine; }
        if (sum == G) break;
        __builtin_amdgcn_s_sleep(1);
        if ((++sp & 255u) == 0u) { if (xb_ld(&bar[XB_TMO])) break; if (sp > XB_SPIN_CAP) { atomicAdd(&bar[XB_TMO], 1u); break; } }
    }
    nloc = mine > 0u ? mine : 1u; nx = cnt > 0u ? cnt : 1u;
}
__device__ __forceinline__ void xcd_barrier(const XcdBarrier& b) {
    asm volatile("s_waitcnt vmcnt(0)" ::: "memory");
    __syncthreads();
    if (threadIdx.x == 0) {
        unsigned* bar = b.bar;
        __builtin_amdgcn_s_waitcnt(0);
        unsigned nloc = b.st[0], nx = b.st[1];
        if (nloc == 0u) { xcd_barrier_complete(bar, b.x, nloc, nx); b.st[0] = nloc; b.st[1] = nx; }
        const unsigned old = xb_add(&bar[XB_XSUB(b.x)], 1u);
        const unsigned gen = old / nloc;
        if (old + 1u == (gen + 1u) * nloc) {
            __builtin_amdgcn_fence(__ATOMIC_RELEASE, "agent");
            asm volatile("s_waitcnt vmcnt(0)" ::: "memory");
            const unsigned og = xb_add(&bar[XB_TOP], 1u);
            const unsigned tg = og / nx;
            if (og + 1u == (tg + 1u) * nx) xb_add(&bar[XB_TOPGEN], 1u);
            else XB_SPIN(xb_ld(&bar[XB_TOPGEN]) == tg, bar);
            __builtin_amdgcn_fence(__ATOMIC_ACQUIRE, "agent");
            xb_add(&bar[XB_XGEN(b.x)], 1u);
            asm volatile("s_waitcnt vmcnt(0)" ::: "memory");
        } else {
            XB_SPIN(xb_ld(&bar[XB_XGEN(b.x)]) == gen, bar);
            __builtin_amdgcn_fence(__ATOMIC_ACQUIRE, "agent");
            asm volatile("s_waitcnt vmcnt(0)" ::: "memory");
        }
    }
    __syncthreads();
}

constexpr int N_PHASES = 20;
__global__ void __launch_bounds__(512, 2) fwd_kernel(Args args) {
    extern __shared__ __attribute__((aligned(16))) unsigned char lds_raw[];
    Frame F;
    F.lds = (LAS unsigned char*)lds_raw;
    F.tid = threadIdx.x; F.lane = F.tid & 63; F.wave = __builtin_amdgcn_readfirstlane(F.tid >> 6);
    F.G = gridDim.x; F.bx = blockIdx.x; F.vcu = (F.G % 8 == 0) ? (F.bx % 8) * (F.G / 8) + F.bx / 8 : F.bx; F.rot = 0;
    unsigned char* const ws = args.ws;
    float* const XL = args.out;
    if (F.tid < 2) ((LAS unsigned*)(F.lds + LDS_XB))[F.tid] = 0u;
    __syncthreads();
    if (args.ph_hi - args.ph_lo > 1) (void)xcd_barrier_post((unsigned*)(ws + WS_BAR), (volatile LAS unsigned*)(F.lds + LDS_XB));
#define WSP(T, off) ((T*)(ws + (off)))
#pragma unroll 1
    for (int ph = args.ph_lo, rep = 0; ph < args.ph_hi;) {
#define REFRESH_LANE() do { int l_ = (int)__builtin_amdgcn_mbcnt_hi(~0u, __builtin_amdgcn_mbcnt_lo(~0u, 0u)); asm volatile("" : "+v"(l_)); F.lane = l_; F.tid = F.wave * 64 + l_; } while (0)
        REFRESH_LANE();
        const int kind = ph < 2 ? ph : 2 + (ph - 2) % 9;
        const int l = ph < 2 ? 0 : (ph - 2) / 9;
        const bool last = (l == 1);
        const float* mod = WSP(float, WS_MOD) + (size_t)l * 9 * 6144;
        const float* biasin = WSP(float, WS_BIASIN) + l * NIN;
        if (kind == 0) {
            LAS float* ct = (LAS float*)(F.lds + LDS_COSTAB);
            for (int i = F.tid; i < 2048; i += 512) ct[i] = cospif((float)i * (1.0f / 1024.0f));
            __syncthreads();
        }
        if (kind == 0) {
            if (F.bx < 192) {
                LAS float* sv = (LAS float*)F.lds;
                LAS float* red = (LAS float*)(F.lds + 40960);
                for (int i = F.tid; i < 9 * 1024; i += 512) { const int r = i >> 10, k = i & 1023; const float c = r < 8 ? args.in[I_C][r * 1024 + k] : args.in[I_CCTX][k]; sv[i] = c / (1.0f + __expf(-c)); }
                __syncthreads();
                for (int job = F.bx; job < 192; job += F.G) {
                    const int jl = job / 96, n0 = (job % 96) * 64, kg = F.tid >> 6, nn = F.tid & 63;
                    const float* wp = args.in[I_WADA] + (size_t)jl * D * 6144 + (size_t)(kg * 128) * 6144 + n0 + nn;
                    float ac[9];
#pragma unroll
                    for (int r = 0; r < 9; ++r) ac[r] = 0.f;
#pragma unroll 1
                    for (int k0 = 0; k0 < 128; k0 += 16) {
                        float wv[16];
#pragma unroll
                        for (int i = 0; i < 16; ++i) wv[i] = wp[(size_t)(k0 + i) * 6144];
#pragma unroll
                        for (int i = 0; i < 16; ++i)
#pragma unroll
                            for (int r = 0; r < 9; ++r) ac[r] += sv[r * 1024 + kg * 128 + k0 + i] * wv[i]; }
#pragma unroll
                    for (int r = 0; r < 9; ++r) red[(kg * 9 + r) * 64 + nn] = ac[r];
                    __syncthreads();
                    for (int o = F.tid; o < 576; o += 512) { const int r = o >> 6, n = o & 63; float s = args.in[I_BADA][jl * 6144 + n0 + n];
#pragma unroll
                        for (int q = 0; q < 8; ++q) s += red[(q * 9 + r) * 64 + n];
                        WSP(float, WS_MOD)[((size_t)jl * 9 + r) * 6144 + n0 + n] = s; }
                    __syncthreads();
                }
            }
            __syncthreads();
            if (F.bx == F.G - 1) {
                float* ROPE = WSP(float, WS_ROPE);
                for (int i = F.tid; i < 1024; i += 512) { const int pos = i >> 4, f = i & 15; const float fr = powf(10000.0f, -(float)f * (1.0f / 16.0f)); const float ang = (float)pos * fr; ROPE[i] = cosf(ang); ROPE[1024 + i] = sinf(ang); }
                if (F.tid < 2) { const int jl = F.tid; float s1 = 0.f, s2 = 0.f;
                    for (int j = 0; j < 64; ++j) { s1 += args.in[I_LQ1][jl * 64 + j] * args.in[I_LK1][jl * 64 + j]; s2 += args.in[I_LQ2][jl * 64 + j] * args.in[I_LK2][jl * 64 + j]; }
                    WSP(float, WS_LAM)[jl] = expf(s1) - expf(s2) + (0.8f - 0.6f * expf(-0.3f * (float)jl)); }
            }
            __syncthreads();
        }
        if (kind == 0) { REFRESH_LANE(); conv_setA(F, args, 0, F.vcu, F.G, 1); }
        if (kind == 1 || kind == 7 || (kind == 10 && !last)) {
            REFRESH_LANE();
            const bool n2 = (kind == 7);
            const float* xl = (kind == 1) ? args.in[I_X] : XL;
            const float* xc = (kind == 1) ? args.in[I_CTX] : WSP(float, WS_XC);
            const float* g = n2 ? args.in[I_N2G] + l * 1024 : args.in[I_N1G] + (kind == 10 ? 1024 : 0);
            const float* m = (kind == 10) ? WSP(float, WS_MOD) + (size_t)9 * 6144 : mod;
            norm_phase(F, xl, xc, g, m, n2 ? 3072 : 0, n2 ? 4096 : 1024, n2 ? WSP(bf16_t, WS_BR) : WSP(bf16_t, WS_H), n2 ? !last : true);
        }
        if (kind == 10 && last) {
            REFRESH_LANE();
            const int gw = F.vcu * 8 + F.wave, NGW = F.G * 8;
            for (int r = gw; r < ML; r += NGW) norm_row(XL + (size_t)r * D, args.in[I_FING], nullptr, nullptr, nullptr, XL + (size_t)r * D, F.lane);
        }
        if (kind == 3) {
            const float lam = WSP(float, WS_LAM)[l]; const float osc = 1.0f - (0.8f - 0.6f * expf(-0.3f * (float)l)); const float* subg = args.in[I_SUBG] + l * 128;
            const bf16_t* P = WSP(bf16_t, WS_P); bf16_t* BR = WSP(bf16_t, WS_BR);
            const int npairs = (2 * F.vcu < 512) ? (512 - 2 * F.vcu + 2 * F.G - 1) / (2 * F.G) : 0, nlat = 2 * npairs;
#pragma unroll 1
            for (int rp = 0; rp <= PROBE_ATT; ++rp)
#pragma unroll 1
            for (int i = 0;; ++i) {
                int qrow0, base1, n1, base2, nt, h;
                if (i < nlat) { const int un = (i >> 1) * 2 * F.G + 2 * F.vcu + (i & 1); const int bh = un >> 4, qb = un & 15, b = bh >> 2; h = bh & 3;
                    qrow0 = b * SEQ + qb * 128; base1 = b * SEQ; n1 = 32; base2 = ML + b * CTXL; nt = 36; }
                else { const int cu = F.vcu + (i - nlat) * F.G; if (last || cu >= 64) break; const int bh = cu >> 1, qb = cu & 1, b = bh >> 2; h = bh & 3;
                    qrow0 = ML + b * CTXL + qb * 128; base1 = ML + b * CTXL; n1 = 4; base2 = 0; nt = 4; }
                REFRESH_LANE();
                attn_unit(F, P, BR, qrow0, base1, n1, base2, nt, h, lam, osc, subg);
            }
        }
#pragma unroll 1
        for (int j = 0; j < 3; ++j) {
            GJob J{}; bool have = false;
            J.lda = 1024; J.ldb = 1024; J.K = 1024; J.rot = -1;
            if (kind == 2) {
                if (j < 2) { have = true; J.A = WSP(bf16_t, WS_H) + (j ? (size_t)ML * 1024 : 0); J.Bt = WSP(bf16_t, WS_WIN); J.M = j ? MC : ML; J.N = NP1;
                    J.E.mode = E_INPROJ; J.E.out = WSP(bf16_t, WS_P); J.E.p1 = biasin; J.E.p2 = WSP(float, WS_ROPE); J.E.row_base = j ? ML : 0; J.E.ctx = j; J.E.aux = 0; J.E.p3 = WSP(bf16_t, (l ? WS_FT1 : WS_FT0)); J.E.p4 = WSP(bf16_t, WS_FTC);
                    if (j == 0) J.rot = 0;
                    if (j && last) { J.Bt = WSP(bf16_t, WS_WIN) + (size_t)7 * 256 * 1024; J.N = 1024; J.E.aux = 7; J.E.p1 = biasin + 7 * 256; } }
            } else if (kind == 4) {
                const int nf = (F.G >= 128) ? 64 : 0;
                if (j == 0) { have = true; J.A = WSP(bf16_t, WS_DFT); J.lda = 4096; J.Bt = WSP(bf16_t, (l ? WS_FT1 : WS_FT0)); J.ldb = 4096; J.M = 2048; J.N = 2048; J.K = 4096; J.rot = 0;
                    if (nf) { J.gfirst = 0; J.gsub = nf; }
                    J.E.mode = E_FOUR; J.E.out = WSP(bf16_t, WS_BR); J.E.row_base = 0; J.E.ctx = 0; J.E.scale = 0.02209708691207961f; }
                else if (j == 1 && !last) { have = true; J.A = WSP(bf16_t, WS_DFT256); J.lda = 512; J.Bt = WSP(bf16_t, WS_FTC); J.ldb = 512; J.M = 256; J.N = 2048; J.K = 512; J.rot = 0;
                    if (nf) { J.gfirst = nf; J.gsub = F.G - nf; }
                    J.E.mode = E_FOUR; J.E.out = WSP(bf16_t, WS_BR); J.E.row_base = ML; J.E.ctx = 1; J.E.scale = 0.0625f; }
                else if (j == 2) { have = true; J.A = WSP(bf16_t, WS_H); J.Bt = WSP(bf16_t, WS_WIN) + (size_t)NP1 * 1024; J.M = last ? ML : MT; J.N = 3072; J.rot = 0;
                    if (nf) { J.gfirst = nf; J.gsub = F.G - nf; }
                    J.E.mode = E_GATE; J.E.out = WSP(bf16_t, WS_P); J.E.p1 = biasin + NP1; J.E.row_base = 0; }
            } else if (kind == 5) {
                if (j == 0) { have = true; J.A = WSP(bf16_t, WS_BR); J.Bt = WSP(bf16_t, WS_WB); J.M = last ? ML : MT; J.N = 1024; J.K = 1024; J.rot = 0;
                    J.E.mode = E_BRANCH; J.E.out = WSP(bf16_t, WS_H); J.E.p1 = WSP(bf16_t, WS_P); J.E.aux = 0; J.E.row_base = 0; }
            } else if (kind == 6 || kind == 9) {
                if (j == 0 || (j == 1 && !last)) { have = true;
                    const bool dn = (kind == 9);
                    const bf16_t* Abase = dn ? WSP(bf16_t, WS_P) : WSP(bf16_t, WS_H);
                    J.lda = dn ? DFF : 1024; J.ldb = J.lda; J.K = J.lda;
                    J.A = Abase + (j ? (size_t)ML * J.lda : 0);
                    J.Bt = dn ? WSP(bf16_t, (l ? WS_WD1 : WS_WD0)) : WSP(bf16_t, WS_WOUT);
                    J.M = j ? MC : ML; J.N = 1024; if (j == 0) J.rot = 0;
                    J.E.mode = E_RESID; J.E.ctx = j; J.E.p2 = mod + (dn ? 5120 : 2048);
                    const float* xin_l = (!dn && l == 0) ? args.in[I_X] : XL; const float* xin_c = (!dn && l == 0) ? args.in[I_CTX] : WSP(float, WS_XC);
                    J.E.p1 = j ? xin_c : xin_l; J.E.out = j ? (void*)WSP(float, WS_XC) : (void*)XL; }
            } else if (kind == 8) {
                if (j == 0) { have = true; J.A = WSP(bf16_t, WS_BR); J.Bt = WSP(bf16_t, (l ? WS_WGU1 : WS_WGU0)); J.M = last ? ML : MT; J.N = 2 * DFF; J.rot = 0;
                    J.E.mode = E_GU; J.E.out = WSP(bf16_t, WS_P); J.E.row_base = 0; }
            }
            if (!have) { if (kind == 4) continue; break; }
            REFRESH_LANE();
            gemm_call(F, J);
        }
        if (!last && kind == 2) {
            const int nskip = (F.G > 64) ? 24 : 0;
            if (F.bx >= nskip) {
                const int pidx = F.bx - nskip, pcnt = F.G - nskip;
                REFRESH_LANE();
                { LAS float* ctw = (LAS float*)(F.lds + LDS_COSTAB);
                  for (int i = F.tid; i < 2048; i += 512) ctw[i] = cospif((float)i * (1.0f / 1024.0f));
                  __syncthreads(); }
            {
              const LAS float* ct = (const LAS float*)(F.lds + LDS_COSTAB);
              bf16_t* DFT = WSP(bf16_t, WS_DFT); bf16_t* DFT256 = WSP(bf16_t, WS_DFT256);
              const int gt = pidx * 512 + F.tid, NGT = pcnt * 512;
              for (int q = gt; q < 2048 * 512; q += NGT) { const int k = q >> 9, c8 = (q & 511) * 8; unsigned w[4];
#pragma unroll
                  for (int e = 0; e < 8; e += 2) { float v[2];
#pragma unroll
                      for (int z = 0; z < 2; ++z) { const int np = c8 + e + z; v[z] = np < 2048 ? ct[(k * np) & 2047] : -ct[((k * (np - 2048)) + 1536) & 2047]; }
                      w[e >> 1] = pk2(v[0], v[1]); }
                  *(u32x4*)(DFT + (size_t)k * 4096 + c8) = (u32x4){w[0], w[1], w[2], w[3]}; }
              for (int q = gt; q < 256 * 64; q += NGT) { const int k = q >> 6, c8 = (q & 63) * 8; unsigned w[4];
#pragma unroll
                  for (int e = 0; e < 8; e += 2) { float v[2];
#pragma unroll
                      for (int z = 0; z < 2; ++z) { const int np = c8 + e + z; v[z] = np < 256 ? ct[(((k * np) & 255) * 8) & 2047] : -ct[((((k * (np - 256)) & 255) * 8) + 1536) & 2047]; }
                      w[e >> 1] = pk2(v[0], v[1]); }
                  *(u32x4*)(DFT256 + (size_t)k * 512 + c8) = (u32x4){w[0], w[1], w[2], w[3]}; } }
                __syncthreads();
                REFRESH_LANE();
                conv_setA(F, args, 0, pidx, pcnt, 2);
            }
        }
        if (!last && (kind == 6 || kind == 9)) {
            const int nskip = (F.G > 64) ? 32 : 0;
            if (F.bx >= nskip) {
                const int pidx = F.bx - nskip, pcnt = F.G - nskip;
                if (kind == 6) { REFRESH_LANE(); conv_setB(F, args, 0, pidx, pcnt); }
                else {
                    LAS float* ct = (LAS float*)(F.lds + LDS_COSTAB);
                    REFRESH_LANE();
                    for (int i = F.tid; i < 2048; i += 512) ct[i] = cospif((float)i * (1.0f / 1024.0f));
                    __syncthreads();
                    conv_setA(F, args, 1, pidx, pcnt, 3);
                    REFRESH_LANE();
                    conv_setB(F, args, 1, pidx, pcnt);
                }
            }
        }
        if (kind == 3) {
            REFRESH_LANE();
            const bf16_t* P = WSP(bf16_t, WS_P); bf16_t* BR = WSP(bf16_t, WS_BR);
            const float* cw = args.in[I_CONVW] + l * 768; const float* cb_ = args.in[I_CONVB] + l * 256;
            const int nrows = last ? ML : MT, gt = F.vcu * 512 + F.tid, NGT = F.G * 512;
            for (int idx = gt; idx < nrows * 32; idx += NGT) {
                const int row = idx >> 5, c8 = (idx & 31) * 8;
                const int L = row < ML ? SEQ : CTXL, t = row < ML ? (row & (SEQ - 1)) : ((row - ML) & (CTXL - 1));
                const bf16_t* pr = P + (size_t)row * LDP;
                const u32x4 cbv = *(const u32x4*)(pr + PCB + c8), c0 = *(const u32x4*)(pr + PCC + c8), x0 = *(const u32x4*)(pr + PCX + c8);
                u32x4 cm = (u32x4){0, 0, 0, 0}, xm = cm, cp = cm, xp = cm;
                if (t > 0) { cm = *(const u32x4*)(pr - LDP + PCC + c8); xm = *(const u32x4*)(pr - LDP + PCX + c8); }
                if (t < L - 1) { cp = *(const u32x4*)(pr + LDP + PCC + c8); xp = *(const u32x4*)(pr + LDP + PCX + c8); }
                unsigned ow[4];
#pragma unroll
                for (int e = 0; e < 4; ++e) {
                    const int c = c8 + 2 * e;
                    const float zl = bflo(c0[e]) * bflo(x0[e]), zh = bfhi(c0[e]) * bfhi(x0[e]);
                    const float ml = bflo(cm[e]) * bflo(xm[e]), mh = bfhi(cm[e]) * bfhi(xm[e]);
                    const float pl = bflo(cp[e]) * bflo(xp[e]), phh = bfhi(cp[e]) * bfhi(xp[e]);
                    const float vl = bflo(cbv[e]) * (cw[c] * ml + cw[256 + c] * zl + cw[512 + c] * pl + cb_[c]);
                    const float vh = bfhi(cbv[e]) * (cw[c + 1] * mh + cw[256 + c + 1] * zh + cw[512 + c + 1] * phh + cb_[c + 1]);
                    ow[e] = cvt_pk_bf16(vl, vh);
                }
                *(u32x4*)(BR + (size_t)row * 1024 + 256 + c8) = (u32x4){ow[0], ow[1], ow[2], ow[3]};
            }
        }
        const bool dup_again = (rep == 0) && (((DUP_MASK) >> kind) & 1);
        if (ph + 1 < args.ph_hi || dup_again) {
            if (args.ph_hi > 1000) cg::this_grid().sync();
            { XcdBarrier xbar; xbar.bar = (unsigned*)(ws + WS_BAR); xbar.x = xb_xcc_id(); xbar.st = (volatile LAS unsigned*)(F.lds + LDS_XB); xcd_barrier(xbar); }
        }
        if (dup_again) rep = 1; else { rep = 0; ++ph; }
    }
#undef WSP
}


#ifndef DBG_STOP
#define DBG_STOP N_PHASES
#endif
#ifndef DBG_DUMP
#define DBG_DUMP 0
#endif
__global__ void dbg_dump(const bf16_t* src, float* out, size_t n) {
    for (size_t i = (size_t)blockIdx.x * blockDim.x + threadIdx.x; i < n; i += (size_t)gridDim.x * blockDim.x) out[i] = __uint_as_float(((unsigned)src[i]) << 16);
}
extern "C" void kernel_launch(void* const* d_in, const int* in_sizes, int n_in, void* d_out, int out_size, void* d_ws, size_t ws_size, hipStream_t stream) {
    static int grid = 0;
    if (grid == 0) {
        if (n_in != 25 || in_sizes[0] != ML * D || out_size != ML * D || ws_size < WS_END) { fprintf(stderr, "kernel_launch: unexpected shapes (n_in %d, in0 %d, out %d, ws %zu)\n", n_in, n_in > 0 ? in_sizes[0] : -1, out_size, ws_size); grid = -1; return; }
        int dev = 0, cus = 0, per_cu = 0;
        hipGetDevice(&dev); hipDeviceGetAttribute(&cus, hipDeviceAttributeMultiprocessorCount, dev);
        if (hipFuncSetAttribute((const void*)fwd_kernel, hipFuncAttributeMaxDynamicSharedMemorySize, LDS_BYTES) != hipSuccess) { fprintf(stderr, "kernel_launch: hipFuncSetAttribute failed\n"); grid = -1; return; }
        if (hipOccupancyMaxActiveBlocksPerMultiprocessor(&per_cu, (const void*)fwd_kernel, 512, LDS_BYTES) != hipSuccess || per_cu < 1) { fprintf(stderr, "kernel_launch: occupancy query says %d\n", per_cu); per_cu = 1; }
        (void)hipGetLastError();
        grid = cus * 1;
        if (grid <= 0) grid = 256;
    }
    if (grid < 0) return;
    if (hipMemsetAsync((unsigned char*)d_ws + WS_BAR, 0, 16384, stream) != hipSuccess) { fprintf(stderr, "kernel_launch: memset failed\n"); return; }
    Args a{};
    for (int i = 0; i < 25; ++i) a.in[i] = (const float*)d_in[i];
    a.out = (float*)d_out; a.ws = (unsigned char*)d_ws;
#if MK_MULTI_LAUNCH
    for (int p = 0; p < DBG_STOP; ++p) {
        a.ph_lo = p; a.ph_hi = p + 1;
        hipLaunchKernelGGL(fwd_kernel, dim3(grid), dim3(512), LDS_BYTES, stream, a);
    }
#else
    a.ph_lo = 0; a.ph_hi = DBG_STOP;
    void* kargs[] = {&a};
    hipError_t e = hipLaunchCooperativeKernel((const void*)fwd_kernel, dim3(grid), dim3(512), kargs, LDS_BYTES, stream);
    if (e != hipSuccess) fprintf(stderr, "kernel_launch: cooperative launch failed: %s (grid %d)\n", hipGetErrorString(e), grid);
#endif
#if DBG_DUMP
    { const size_t off = DBG_DUMP == 1 ? WS_H : (DBG_DUMP == 2 ? WS_BR : (DBG_DUMP == 3 ? WS_P : WS_FT0));
      hipLaunchKernelGGL(dbg_dump, dim3(2048), dim3(256), 0, stream, (const bf16_t*)((unsigned char*)d_ws + off), (float*)d_out, (size_t)(DBG_DUMP == 4 ? 8 : 16) * 1024 * 1024); }
#endif
}
```

```cpp
#include <hip/hip_runtime.h>
#include <hip/hip_cooperative_groups.h>
#include <cstdio>
#include <cstdint>
namespace cg = cooperative_groups;

#ifndef PROBE_ATT
#define PROBE_ATT 0
#endif
#ifndef PROBE_FOUR
#define PROBE_FOUR 0
#endif
#ifndef DUP_MASK
#define DUP_MASK 0
#endif
#ifndef MK_MULTI_LAUNCH
#define MK_MULTI_LAUNCH 0
#endif

#define LAS __attribute__((address_space(3)))
#define GAS __attribute__((address_space(1)))
typedef unsigned short bf16_t;
typedef short bf16x8 __attribute__((ext_vector_type(8)));
typedef short s16x4 __attribute__((ext_vector_type(4)));
typedef float f32x4 __attribute__((ext_vector_type(4)));
typedef float f32x16 __attribute__((ext_vector_type(16)));
typedef unsigned u32x4 __attribute__((ext_vector_type(4)));
typedef unsigned u32x2 __attribute__((ext_vector_type(2)));

constexpr int D = 1024, NB = 8, SEQ = 2048, CTXL = 256, DFF = 2816;
constexpr int ML = NB * SEQ;
constexpr int MC = NB * CTXL;
constexpr int MT = ML + MC;
constexpr int DIN = 5632;
constexpr int NIN = 5888;
constexpr int NP1 = 2816;
constexpr int LDP = 2304;
constexpr int PCB = 0, PCC = 256, PCX = 512, PQ = 768, PK = 1280, PV = 1792;
constexpr float QSCALE = 0.125f * 1.4426950408889634f;
constexpr float EPS = 1e-6f;

constexpr size_t MiB = 1u << 20;
constexpr size_t WS_MOD = 0;
constexpr size_t WS_ROPE = 448 * 1024;
constexpr size_t WS_BIASIN = 464 * 1024;
constexpr size_t WS_LAM = 1020 * 1024;
constexpr size_t WS_DFT256 = 1 * MiB;
constexpr size_t WS_DFT = 2 * MiB;
constexpr size_t WS_XC = 18 * MiB;
constexpr size_t WS_WIN = 26 * MiB;
constexpr size_t WS_WB = WS_WIN + 5888 * 1024 * 2;
constexpr size_t WS_WOUT = WS_WB + 2 * MiB;
constexpr size_t WS_WGU0 = WS_WOUT + 2 * MiB;
constexpr size_t WS_WD0 = WS_WGU0 + 11 * MiB;
constexpr size_t WS_WGU1 = WS_WD0 + 5632 * 1024;
constexpr size_t WS_WD1 = WS_WGU1 + 11 * MiB;
constexpr size_t WS_H = 75 * MiB;
constexpr size_t WS_BR = 111 * MiB;
constexpr size_t WS_P = 147 * MiB;
constexpr size_t WS_FT0 = WS_WGU1, WS_FT1 = WS_WGU0, WS_FTC = WS_XC;
constexpr size_t WS_BAR = 255 * MiB;
constexpr size_t WS_END = 255 * MiB + 65536;
static_assert(WS_WD1 + 5632 * 1024 <= WS_H && WS_FT0 + 16 * MiB <= WS_H && WS_FT1 + 16 * MiB <= WS_WGU1, "ws map");
static_assert((size_t)MT * LDP * 2 <= 81 * MiB && (size_t)MT * 3072 * 2 <= 108 * MiB, "ws map");

constexpr int LDS_BYTES = 147456;
constexpr int LDS_XB = 144384;
constexpr int LDS_COSTAB = 131072;

typedef float f32x2_t __attribute__((ext_vector_type(2))); typedef __bf16 bf16x2_t __attribute__((ext_vector_type(2)));
__device__ __forceinline__ unsigned cvt_pk_bf16(float lo, float hi) { f32x2_t v = {lo, hi}; bf16x2_t b = __builtin_convertvector(v, bf16x2_t); return __builtin_bit_cast(unsigned, b); }
__device__ __forceinline__ unsigned f2bf(float f) { unsigned u = __float_as_uint(f); return (u + 0x7fffu + ((u >> 16) & 1u)) >> 16; }
__device__ __forceinline__ unsigned pk2(float lo, float hi) { return f2bf(lo) | (f2bf(hi) << 16); }
__device__ __forceinline__ float bflo(unsigned w) { return __uint_as_float(w << 16); }
__device__ __forceinline__ float bfhi(unsigned w) { return __uint_as_float(w & 0xffff0000u); }
__device__ __forceinline__ float fast_exp2(float x) { return __builtin_amdgcn_exp2f(x); }
__device__ __forceinline__ float fast_rcp(float x) { return __builtin_amdgcn_rcpf(x); }
__device__ __forceinline__ float sigmoidf_(float x) { return fast_rcp(1.0f + fast_exp2(-1.4426950408889634f * x)); }
__device__ __forceinline__ float wave_sum(float v) {
#pragma unroll
    for (int o = 1; o < 64; o <<= 1) v += __shfl_xor(v, o);
    return v;
}

namespace pg8 {
constexpr int BM = 256, BK = 64, HALF = 128, HTB = HALF * BK * 2, STAGE_BYTES = 8 * HTB, NXCD = 8, WGM = 4;
__host__ __device__ __forceinline__ int lds_byte(int r, int c) { const int st = (r >> 4) * 2 + (c >> 5), rr = r & 15, cc = c & 31, ob = rr * 64 + cc * 2; return st * 1024 + (ob ^ (((ob >> 9) & 1) << 5)); }
__host__ __device__ __forceinline__ void stage_rc(int b, int& R, int& C) { const int st = b / 1024, sb = b % 1024, swz = sb ^ (((sb >> 9) & 1) << 5); R = (st >> 1) * 16 + swz / 64; C = (st & 1) * 32 + (swz % 64) / 2; }
__host__ __device__ __forceinline__ int perm32(int rho) { const int n = rho >> 4, i = rho & 15; return 8 * (i >> 2) + 4 * n + (i & 3); }
struct Unit { int pm, pn; };
struct Gemm { const bf16_t* A; const bf16_t* Bt; int M, N, K, lda, ldb; };
struct StaticOrder {
    int nM, nN, nwg, G, c;
    __device__ void init(int M, int N, int G_, int c_) { nM = M / BM; nN = N / BM; nwg = nM * nN; G = G_; c = c_; }
    __device__ bool next(int i, Unit& u) const {
        const long L = (long)i * G + c; if (L >= nwg) return false;
        int wgid = (int)L; { const int q = nwg / NXCD, r = nwg % NXCD, xcd = wgid % NXCD, off = wgid / NXCD; wgid = (xcd < r ? xcd * (q + 1) : r * (q + 1) + (xcd - r) * q) + off; }
        const int nig = WGM * nN, gid = wgid / nig, fm = gid * WGM, gsz = (nM - fm) < WGM ? (nM - fm) : WGM;
        u.pm = fm + ((wgid % nig) % gsz); u.pn = (wgid % nig) / gsz; return true;
    }
};

template <class Epi, class Sched>
__device__ __forceinline__ void gemm_phase(LAS unsigned char* lds, const Gemm g, const Sched& S, const Epi& E, const int tid) {
    const int wid = __builtin_amdgcn_readfirstlane(tid >> 6), lane = tid & 63, wr = wid >> 2, wc = wid & 3, fr = lane & 15, fq = lane >> 4;
    const int K = g.K, nt = K / BK;
    unsigned voffA[2], voffB[2];
#pragma unroll
    for (int i = 0; i < 2; ++i) { int R, C; stage_rc(tid * 16 + i * 8192, R, C); const int Rb = (R & ~31) + perm32(R & 31);
        voffA[i] = (unsigned)(R * g.lda + C) * 2u; voffB[i] = (unsigned)(Rb * g.ldb + C) * 2u; }
    const size_t kstep = (size_t)(BK * 2);
    const size_t hA = (size_t)HALF * g.lda * 2, hB = (size_t)HALF * g.ldb * 2;
    const size_t tA = 2 * hA, tB = 2 * hB;
    const unsigned ldsw = (unsigned)wid * 1024u;
    const int aoff = lds_byte(wr * 64 + fr, fq * 8), boff = lds_byte(wc * 32 + fr, fq * 8);
#define PG8_SA(b, h) (((b) * 2 + (h)) * HTB)
#define PG8_SB(b, h) ((4 + (b) * 2 + (h)) * HTB)
#define PG8_STAGE(bufoff, gbase, voff) do { _Pragma("unroll") for (int _i = 0; _i < 2; ++_i) \
        __builtin_amdgcn_global_load_lds((const unsigned*)((const char*)(gbase) + (voff)[_i]), (LAS unsigned*)(lds + (bufoff) + ldsw + _i * 8192), 16, 0, 0); } while (0)
#define PG8_LDA(dst, b, h) do { _Pragma("unroll") for (int m = 0; m < 4; ++m) _Pragma("unroll") for (int k = 0; k < 2; ++k) dst[m][k] = *(const LAS bf16x8*)(lds + PG8_SA(b, h) + aoff + m * 2048 + k * 1024); } while (0)
#define PG8_LDB(dst, b, h) do { _Pragma("unroll") for (int n = 0; n < 2; ++n) _Pragma("unroll") for (int k = 0; k < 2; ++k) dst[n][k] = *(const LAS bf16x8*)(lds + PG8_SB(b, h) + boff + n * 2048 + k * 1024); } while (0)
#define PG8_MMA(ai, bj, At, Bt) do { __builtin_amdgcn_s_setprio(1); _Pragma("unroll") for (int m = 0; m < 4; ++m) _Pragma("unroll") for (int n = 0; n < 2; ++n) _Pragma("unroll") for (int k = 0; k < 2; ++k) \
        acc[ai][bj][m][n] = __builtin_amdgcn_mfma_f32_16x16x32_bf16(Bt[n][k], At[m][k], acc[ai][bj][m][n], 0, 0, 0); __builtin_amdgcn_s_setprio(0); } while (0)
#define PG8_WAIT_V(n) asm volatile("s_waitcnt vmcnt(" #n ")" ::: "memory")
#define PG8_WAIT_L(n) asm volatile("s_waitcnt lgkmcnt(" #n ")" ::: "memory")
#define PG8_BAR __builtin_amdgcn_s_barrier()
#define PG8_SCHED __builtin_amdgcn_sched_barrier(0)
    Unit cur, nxt; int ui = 0;
    if (!S.next(0, cur)) return;
    const bool hz = E.horner();
    f32x4 acc[2][2][4][2];
#pragma unroll
    for (int a = 0; a < 2; ++a)
#pragma unroll
        for (int b = 0; b < 2; ++b)
#pragma unroll
            for (int m = 0; m < 4; ++m)
#pragma unroll
                for (int n = 0; n < 2; ++n) acc[a][b][m][n] = (f32x4){0.f, 0.f, 0.f, 0.f};
    bf16x8 At[4][2], B0[2][2], B1[2][2];
    const char* cA = (const char*)g.A + (size_t)cur.pm * tA; const char* cB = (const char*)g.Bt + (size_t)cur.pn * tB;
    PG8_STAGE(PG8_SB(0, 0), cB, voffB); PG8_STAGE(PG8_SB(0, 1), cB + hB, voffB); PG8_STAGE(PG8_SA(0, 0), cA, voffA); PG8_STAGE(PG8_SA(0, 1), cA + hA, voffA);
    if (wr == 1) PG8_BAR;
    PG8_WAIT_V(2); PG8_BAR;
    PG8_STAGE(PG8_SB(1, 0), cB + kstep, voffB); PG8_STAGE(PG8_SA(1, 0), cA + kstep, voffA); PG8_STAGE(PG8_SB(1, 1), cB + hB + kstep, voffB);
    PG8_WAIT_V(6); PG8_BAR;
    for (;;) {
        const bool has_next = S.next(ui + 1, nxt);
        const char* nA = has_next ? (const char*)g.A + (size_t)nxt.pm * tA : cA; const char* nB = has_next ? (const char*)g.Bt + (size_t)nxt.pn * tB : cB;
        for (int t = 0; t < nt; t += 2) {
            if (hz && (t == 4 || t == 8)) E.mid(acc, cur, t >> 3, wr, wc, fr, fq);
            const bool last = (t == nt - 2);
            const char* a1 = cA + (size_t)(t + 1) * kstep;
            const char* a2 = last ? nA : cA + (size_t)(t + 2) * kstep; const char* b2 = last ? nB : cB + (size_t)(t + 2) * kstep;
            const char* a3 = a2 + kstep; const char* b3 = b2 + kstep;
            PG8_LDB(B0, 0, 0); PG8_LDB(B1, 0, 1); PG8_SCHED; PG8_LDA(At, 0, 0); PG8_STAGE(PG8_SA(1, 1), a1 + hA, voffA);
            PG8_WAIT_V(8); PG8_WAIT_L(0); PG8_BAR; PG8_MMA(0, 0, At, B0); PG8_MMA(0, 1, At, B1); PG8_BAR; PG8_SCHED;
            PG8_LDA(At, 0, 1); PG8_STAGE(PG8_SB(0, 0), b2, voffB); PG8_STAGE(PG8_SB(0, 1), b2 + hB, voffB); PG8_STAGE(PG8_SA(0, 0), a2, voffA);
            PG8_WAIT_V(8); PG8_WAIT_L(0); PG8_BAR; PG8_MMA(1, 0, At, B0); PG8_MMA(1, 1, At, B1); PG8_BAR; PG8_SCHED;
            PG8_LDB(B0, 1, 0); PG8_LDB(B1, 1, 1); PG8_SCHED; PG8_LDA(At, 1, 0); PG8_STAGE(PG8_SA(0, 1), a2 + hA, voffA);
            PG8_WAIT_V(8); PG8_WAIT_L(0); PG8_BAR; PG8_MMA(0, 0, At, B0); PG8_MMA(0, 1, At, B1); PG8_BAR; PG8_SCHED;
            PG8_LDA(At, 1, 1); PG8_STAGE(PG8_SB(1, 0), b3, voffB); PG8_STAGE(PG8_SB(1, 1), b3 + hB, voffB); PG8_STAGE(PG8_SA(1, 0), a3, voffA);
            PG8_WAIT_V(8); PG8_WAIT_L(0); PG8_BAR; PG8_MMA(1, 0, At, B0); PG8_MMA(1, 1, At, B1); PG8_BAR; PG8_SCHED;
        }
        if (wr == 0) PG8_BAR;
        E(acc, cur, wr, wc, fr, fq);
        if (!has_next) break;
#pragma unroll
        for (int a = 0; a < 2; ++a)
#pragma unroll
            for (int b = 0; b < 2; ++b)
#pragma unroll
                for (int m = 0; m < 4; ++m)
#pragma unroll
                    for (int n = 0; n < 2; ++n) acc[a][b][m][n] = (f32x4){0.f, 0.f, 0.f, 0.f};
        cur = nxt; cA = nA; cB = nB; ++ui;
        if (wr == 1) PG8_BAR;
    }
    PG8_WAIT_V(0);
    PG8_BAR;
#undef PG8_SA
#undef PG8_SB
#undef PG8_STAGE
#undef PG8_LDA
#undef PG8_LDB
#undef PG8_MMA
#undef PG8_WAIT_V
#undef PG8_WAIT_L
#undef PG8_BAR
#undef PG8_SCHED
}
}

enum { E_INPROJ = 0, E_GATE = 1, E_BRANCH = 2, E_RESID = 3, E_GU = 4, E_FOUR = 5 };
constexpr int LDS_EPI = 143360;
struct EpiD {
    int mode;
    int row_base;
    int ctx;
    int aux;
    float scale;
    int pad;
    void* out;
    const void* p1;
    const void* p2;
    void* p3; void* p4;
};
#define RFL2(x) ((unsigned)__builtin_amdgcn_readfirstlane((int)(x)))
struct Epi {
    const LAS unsigned* ed;
    __device__ __forceinline__ bool horner() const { return __builtin_amdgcn_readfirstlane((int)ed[0]) == E_BRANCH; }
    __device__ __forceinline__ void mid(f32x4 (&acc)[2][2][4][2], const pg8::Unit& u, int which, int wr, int wc, int fr, int fq) const {
        asm volatile("" : "+v"(fr), "+v"(fq));
        const int row_base = __builtin_amdgcn_readfirstlane((int)ed[1]);
        const unsigned lo = (unsigned)__builtin_amdgcn_readfirstlane((int)ed[8]), hi_ = (unsigned)__builtin_amdgcn_readfirstlane((int)ed[9]);
        const bf16_t* gbase = (const bf16_t*)(((unsigned long long)hi_ << 32) | lo) + (size_t)(row_base + u.pm * 256 + wr * 64 + fr) * 3072 + which * 1024 + u.pn * 256 + wc * 32 + 8 * fq;
#pragma unroll
        for (int ai = 0; ai < 2; ++ai) {
            u32x4 na[4][2], nb[4][2];
#pragma unroll
            for (int m = 0; m < 4; ++m)
#pragma unroll
                for (int bj = 0; bj < 2; ++bj) { const bf16_t* gp = gbase + (size_t)(ai * 128 + m * 16) * 3072 + bj * 128; na[m][bj] = *(const GAS u32x4*)gp; nb[m][bj] = *(const GAS u32x4*)(gp + 1024); }
            __builtin_amdgcn_sched_barrier(0);
#pragma unroll
            for (int m = 0; m < 4; ++m)
#pragma unroll
                for (int bj = 0; bj < 2; ++bj) {
                    const u32x4 xa = na[m][bj], xb = nb[m][bj];
                    f32x4 r0, r1;
                    r0[0] = bflo(xa.x) * fast_rcp(bflo(xb.x)); r0[1] = bfhi(xa.x) * fast_rcp(bfhi(xb.x)); r0[2] = bflo(xa.y) * fast_rcp(bflo(xb.y)); r0[3] = bfhi(xa.y) * fast_rcp(bfhi(xb.y));
                    r1[0] = bflo(xa.z) * fast_rcp(bflo(xb.z)); r1[1] = bfhi(xa.z) * fast_rcp(bfhi(xb.z)); r1[2] = bflo(xa.w) * fast_rcp(bflo(xb.w)); r1[3] = bfhi(xa.w) * fast_rcp(bfhi(xb.w));
                    acc[ai][bj][m][0] = acc[ai][bj][m][0] * r0; acc[ai][bj][m][1] = acc[ai][bj][m][1] * r1;
                }
            __builtin_amdgcn_sched_barrier(0);
        }
    }
    __device__ __forceinline__ void operator()(const f32x4 (&acc)[2][2][4][2], const pg8::Unit& u, int wr, int wc, int fr, int fq) const {
        asm volatile("" : "+v"(fr), "+v"(fq));
#define RFL(x) ((unsigned)__builtin_amdgcn_readfirstlane((int)(x)))
        const int mode = (int)RFL(ed[0]), row_base = (int)RFL(ed[1]), ctx = (int)RFL(ed[2]), aux = (int)RFL(ed[3]);
        const float scale = __uint_as_float(RFL(ed[4]));
        void* const out = (void*)(((unsigned long long)RFL(ed[7]) << 32) | RFL(ed[6]));
        const void* const p1 = (const void*)(((unsigned long long)RFL(ed[9]) << 32) | RFL(ed[8]));
        const void* const p2 = (const void*)(((unsigned long long)RFL(ed[11]) << 32) | RFL(ed[10]));
#undef RFL
        const int r0 = u.pm * 256 + wr * 64 + fr;
        const int c0 = wc * 32 + 8 * fq;
        const int colt = u.pn * 256;
        if (mode == E_INPROJ) {
            const int ct = aux + u.pn;
            const float* bias = (const float*)p1;
            if (ct < 2) {
                const int gpm = (row_base >> 8) + u.pm;
                bf16_t* dst; int ld, n0;
                if (ctx) { const int b = gpm - 64; dst = (bf16_t*)(((unsigned long long)RFL2(ed[15]) << 32) | RFL2(ed[14])) + (size_t)(b * 256) * 512 + ct * 256; ld = 512; n0 = 0; }
                else { const int b = gpm >> 3; dst = (bf16_t*)(((unsigned long long)RFL2(ed[13]) << 32) | RFL2(ed[12])) + (size_t)(b * 256) * 4096 + ct * 2048; ld = 4096; n0 = (gpm & 7) * 256; }
                LAS unsigned char* stg = (LAS unsigned char*)ed - LDS_EPI + 131072 + (wr * 4 + wc) * 1536;
                const int lane_ = fq * 16 + fr, tcol = lane_ >> 1, thalf = lane_ & 1;
#pragma unroll
                for (int bj = 0; bj < 2; ++bj) {
                    const f32x4 b0 = *(const GAS f32x4*)(bias + colt + bj * 128 + c0), b1 = *(const GAS f32x4*)(bias + colt + bj * 128 + c0 + 4);
                    bf16_t* dcol = dst + (size_t)(bj * 128 + wc * 32 + tcol) * ld + n0 + wr * 64 + thalf * 8;
#pragma unroll
                    for (int ai = 0; ai < 2; ++ai)
#pragma unroll
                        for (int m = 0; m < 4; ++m) {
                            const f32x4 v0 = acc[ai][bj][m][0] + b0, v1 = acc[ai][bj][m][1] + b1;
                            LAS bf16_t* sp = (LAS bf16_t*)stg + (fq * 8) * 16 + fr;
                            sp[0 * 16] = (bf16_t)f2bf(v0[0]); sp[1 * 16] = (bf16_t)f2bf(v0[1]); sp[2 * 16] = (bf16_t)f2bf(v0[2]); sp[3 * 16] = (bf16_t)f2bf(v0[3]);
                            sp[4 * 16] = (bf16_t)f2bf(v1[0]); sp[5 * 16] = (bf16_t)f2bf(v1[1]); sp[6 * 16] = (bf16_t)f2bf(v1[2]); sp[7 * 16] = (bf16_t)f2bf(v1[3]);
                            asm volatile("s_waitcnt lgkmcnt(0)" ::: "memory");
                            const u32x4 w = *(const LAS u32x4*)(stg + tcol * 32 + thalf * 16);
                            *(GAS u32x4*)(dcol + ai * 128 + m * 16) = w;
                            asm volatile("s_waitcnt lgkmcnt(0)" ::: "memory");
                        }
                }
            } else {
                const bool isqk = (ct >= 5 && ct <= 8), dorope = isqk && !ctx;
                const float sc = (ct == 5 || ct == 6) ? QSCALE : 1.0f;
                const int axis = wc & 1, half = fq >> 1;
                const float* rope = (const float*)p2 + 8 * (fq & 1);
                bf16_t* obase = (bf16_t*)out + (size_t)(row_base + r0) * LDP + (ct - 2) * 256 + c0;
#pragma unroll
                for (int bj = 0; bj < 2; ++bj) {
                    const f32x4 b0 = *(const GAS f32x4*)(bias + colt + bj * 128 + c0), b1 = *(const GAS f32x4*)(bias + colt + bj * 128 + c0 + 4);
#pragma unroll
                    for (int ai = 0; ai < 2; ++ai)
#pragma unroll
                        for (int m = 0; m < 4; ++m) {
                            f32x4 v0 = acc[ai][bj][m][0] + b0, v1 = acc[ai][bj][m][1] + b1;
                            if (dorope) {
                                const int t = (row_base + r0 + ai * 128 + m * 16) & 2047, pos = axis ? (t & 63) : (t >> 6);
                                const float* cp = rope + pos * 16;
                                const f32x4 cs0 = *(const GAS f32x4*)cp, cs1 = *(const GAS f32x4*)(cp + 4), sn0 = *(const GAS f32x4*)(cp + 1024), sn1 = *(const GAS f32x4*)(cp + 1028);
                                f32x4 w0, w1;
#pragma unroll
                                for (int j = 0; j < 4; ++j) { w0[j] = __shfl_xor(v0[j], 32); w1[j] = __shfl_xor(v1[j], 32); }
                                if (half) { v0 = v0 * cs0 + w0 * sn0; v1 = v1 * cs1 + w1 * sn1; }
                                else { v0 = v0 * cs0 - w0 * sn0; v1 = v1 * cs1 - w1 * sn1; }
                            }
                            v0 = v0 * sc; v1 = v1 * sc;
                            u32x4 w; w.x = cvt_pk_bf16(v0[0], v0[1]); w.y = cvt_pk_bf16(v0[2], v0[3]); w.z = cvt_pk_bf16(v1[0], v1[1]); w.w = cvt_pk_bf16(v1[2], v1[3]);
                            *(GAS u32x4*)(obase + (size_t)(ai * 128 + m * 16) * LDP + bj * 128) = w;
                        }
                }
            }
        } else if (mode == E_GATE) {
            const float* bias = (const float*)p1;
            bf16_t* obase = (bf16_t*)out + (size_t)(row_base + r0) * 3072 + colt + c0;
#pragma unroll
            for (int bj = 0; bj < 2; ++bj) {
                const f32x4 b0 = *(const GAS f32x4*)(bias + colt + bj * 128 + c0), b1 = *(const GAS f32x4*)(bias + colt + bj * 128 + c0 + 4);
#pragma unroll
                for (int ai = 0; ai < 2; ++ai)
#pragma unroll
                    for (int m = 0; m < 4; ++m) {
                        f32x4 v0 = acc[ai][bj][m][0] + b0, v1 = acc[ai][bj][m][1] + b1;
#pragma unroll
                        for (int j = 0; j < 4; ++j) { v0[j] = fmaxf(sigmoidf_(v0[j]), 1e-18f); v1[j] = fmaxf(sigmoidf_(v1[j]), 1e-18f); }
                        u32x4 w; w.x = cvt_pk_bf16(v0[0], v0[1]); w.y = cvt_pk_bf16(v0[2], v0[3]); w.z = cvt_pk_bf16(v1[0], v1[1]); w.w = cvt_pk_bf16(v1[2], v1[3]);
                        *(GAS u32x4*)(obase + (size_t)(ai * 128 + m * 16) * 3072 + bj * 128) = w;
                    }
            }
        } else if (mode == E_BRANCH) {
            const bf16_t* gbase = (const bf16_t*)p1 + (size_t)(row_base + r0) * 3072 + 2048 + colt + c0;
            bf16_t* ybase = (bf16_t*)out + (size_t)(row_base + r0) * 1024 + colt + c0;
            u32x4 gw[2][4][2];
#pragma unroll
            for (int ai = 0; ai < 2; ++ai)
#pragma unroll
                for (int m = 0; m < 4; ++m)
#pragma unroll
                    for (int bj = 0; bj < 2; ++bj) gw[ai][m][bj] = *(const GAS u32x4*)(gbase + (size_t)(ai * 128 + m * 16) * 3072 + bj * 128);
            __builtin_amdgcn_sched_barrier(0);
#pragma unroll
            for (int ai = 0; ai < 2; ++ai)
#pragma unroll
                for (int m = 0; m < 4; ++m) {
#pragma unroll
                    for (int bj = 0; bj < 2; ++bj) {
                        const u32x4 g = gw[ai][m][bj];
                        const f32x4 g0 = (f32x4){bflo(g.x), bfhi(g.x), bflo(g.y), bfhi(g.y)}, g1 = (f32x4){bflo(g.z), bfhi(g.z), bflo(g.w), bfhi(g.w)};
                        const f32x4 y0 = g0 * acc[ai][bj][m][0], y1 = g1 * acc[ai][bj][m][1];
                        u32x4 w; w.x = cvt_pk_bf16(y0[0], y0[1]); w.y = cvt_pk_bf16(y0[2], y0[3]); w.z = cvt_pk_bf16(y1[0], y1[1]); w.w = cvt_pk_bf16(y1[2], y1[3]);
                        *(GAS u32x4*)(ybase + (size_t)(ai * 128 + m * 16) * 1024 + bj * 128) = w;
                    }
                }
        } else if (mode == E_RESID) {
            const float* xin = (const float*)p1 + (size_t)r0 * 1024 + colt + c0;
            float* xout = (float*)out + (size_t)r0 * 1024 + colt + c0;
            const int b = ctx ? 8 : (u.pm >> 3);
            const float* modg = (const float*)p2 + (size_t)b * 6144 + colt + c0;
            f32x4 gv[2][2];
#pragma unroll
            for (int bj = 0; bj < 2; ++bj) { gv[bj][0] = *(const GAS f32x4*)(modg + bj * 128); gv[bj][1] = *(const GAS f32x4*)(modg + bj * 128 + 4); }
#pragma unroll
            for (int ai = 0; ai < 2; ++ai) {
                f32x4 xv[4][2][2];
#pragma unroll
                for (int m = 0; m < 4; ++m)
#pragma unroll
                    for (int bj = 0; bj < 2; ++bj) { const float* xi = xin + (size_t)(ai * 128 + m * 16) * 1024 + bj * 128; xv[m][bj][0] = *(const GAS f32x4*)xi; xv[m][bj][1] = *(const GAS f32x4*)(xi + 4); }
                __builtin_amdgcn_sched_barrier(0);
#pragma unroll
                for (int m = 0; m < 4; ++m)
#pragma unroll
                    for (int bj = 0; bj < 2; ++bj) { float* xo = xout + (size_t)(ai * 128 + m * 16) * 1024 + bj * 128;
                        *(GAS f32x4*)xo = xv[m][bj][0] + gv[bj][0] * acc[ai][bj][m][0]; *(GAS f32x4*)(xo + 4) = xv[m][bj][1] + gv[bj][1] * acc[ai][bj][m][1]; }
                __builtin_amdgcn_sched_barrier(0);
            }
        } else if (mode == E_GU) {
            bf16_t* obase = (bf16_t*)out + (size_t)(row_base + r0) * DFF + u.pn * 128 + c0;
#pragma unroll
            for (int ai = 0; ai < 2; ++ai)
#pragma unroll
                for (int m = 0; m < 4; ++m) {
                    f32x4 v0, v1;
#pragma unroll
                    for (int j = 0; j < 4; ++j) { const float a = acc[ai][0][m][0][j], b = acc[ai][0][m][1][j];
                        v0[j] = a * sigmoidf_(a) * acc[ai][1][m][0][j]; v1[j] = b * sigmoidf_(b) * acc[ai][1][m][1][j]; }
                    u32x4 w; w.x = cvt_pk_bf16(v0[0], v0[1]); w.y = cvt_pk_bf16(v0[2], v0[3]); w.z = cvt_pk_bf16(v1[0], v1[1]); w.w = cvt_pk_bf16(v1[2], v1[3]);
                    *(GAS u32x4*)(obase + (size_t)(ai * 128 + m * 16) * DFF) = w;
                }
        } else {
            const int L = ctx ? CTXL : SEQ;
            bf16_t* obase = (bf16_t*)out + (size_t)(row_base + u.pn * L + r0) * 1024 + c0;
#pragma unroll
            for (int ai = 0; ai < 2; ++ai)
#pragma unroll
                for (int m = 0; m < 4; ++m) {
#pragma unroll
                    for (int bj = 0; bj < 2; ++bj) {
                        const f32x4 v0 = acc[ai][bj][m][0] * scale, v1 = acc[ai][bj][m][1] * scale;
                        u32x4 w; w.x = cvt_pk_bf16(v0[0], v0[1]); w.y = cvt_pk_bf16(v0[2], v0[3]); w.z = cvt_pk_bf16(v1[0], v1[1]); w.w = cvt_pk_bf16(v1[2], v1[3]);
                        *(GAS u32x4*)(obase + (size_t)(ai * 128 + m * 16) * 1024 + bj * 128) = w;
                    }
                }
        }
    }
};

struct Args {
    const float* in[25];
    float* out; unsigned char* ws;
    int ph_lo, ph_hi;
};
enum { I_X = 0, I_C, I_CTX, I_CCTX, I_WADA, I_BADA, I_N1G, I_N2G, I_WIN, I_BIN, I_CONVW, I_CONVB, I_WFO, I_WCO, I_WAO, I_LQ1, I_LK1, I_LQ2, I_LK2, I_SUBG, I_WOUT, I_WG, I_WU, I_WD, I_FING };

struct Frame {
    LAS unsigned char* lds;
    int tid, lane, wave, G, bx, vcu, rot;
};

struct GJob { const bf16_t* A; const bf16_t* Bt; int lda, ldb, M, N, K, rot; int gfirst, gsub; EpiD E; };
__device__ __forceinline__ void gemm_call(Frame& F, const GJob& j) {
    pg8::Gemm g{j.A, j.Bt, j.M, j.N, j.K, j.lda, j.ldb};
    if (j.rot >= 0) F.rot = j.rot % F.G;
    pg8::StaticOrder S; int c = F.bx - F.rot; if (c < 0) c += F.G;
    int Ge = F.G;
    if (j.gsub > 0) { Ge = j.gsub; c = F.bx - j.gfirst; if (c < 0 || c >= j.gsub) c = 1 << 28; }
    S.init(j.M, j.N, Ge, c);
    if (F.tid == 0) { LAS unsigned* d = (LAS unsigned*)(F.lds + LDS_EPI);
        const unsigned long long o_ = (unsigned long long)j.E.out, a_ = (unsigned long long)j.E.p1, b_ = (unsigned long long)j.E.p2;
        d[0] = (unsigned)j.E.mode; d[1] = (unsigned)j.E.row_base; d[2] = (unsigned)j.E.ctx; d[3] = (unsigned)j.E.aux; d[4] = __float_as_uint(j.E.scale); d[5] = 0u;
        d[6] = (unsigned)o_; d[7] = (unsigned)(o_ >> 32); d[8] = (unsigned)a_; d[9] = (unsigned)(a_ >> 32); d[10] = (unsigned)b_; d[11] = (unsigned)(b_ >> 32);
        const unsigned long long c_ = (unsigned long long)j.E.p3, e_ = (unsigned long long)j.E.p4; d[12] = (unsigned)c_; d[13] = (unsigned)(c_ >> 32); d[14] = (unsigned)e_; d[15] = (unsigned)(e_ >> 32); }
    __syncthreads();
    Epi E{(const LAS unsigned*)(F.lds + LDS_EPI)};
    pg8::gemm_phase<Epi, pg8::StaticOrder>(F.lds, g, S, E, F.tid);
    F.rot = (F.rot + (j.M / 256) * (j.N / 256)) % F.G;
}

__device__ __forceinline__ void tr_item(const float* src, int ldsrc, bf16_t* dst, int ldd, LAS float* scr, int lane) {
#pragma unroll 8
    for (int i = 0; i < 32; ++i) { const int kk = 2 * i + (lane >> 5); scr[kk * 33 + (lane & 31)] = src[(size_t)kk * ldsrc + (lane & 31)]; }
    asm volatile("s_waitcnt lgkmcnt(0)" ::: "memory");
    const int c = lane & 7;
#pragma unroll
    for (int j = 0; j < 4; ++j) { const int n = (lane >> 3) + 8 * j; const LAS float* s = scr + (8 * c) * 33 + n;
        u32x4 o; o.x = pk2(s[0 * 33], s[1 * 33]); o.y = pk2(s[2 * 33], s[3 * 33]); o.z = pk2(s[4 * 33], s[5 * 33]); o.w = pk2(s[6 * 33], s[7 * 33]);
        *(u32x4*)(dst + (size_t)n * ldd + 8 * c) = o; }
    asm volatile("s_waitcnt lgkmcnt(0)" ::: "memory");
}

__device__ __forceinline__ void conv_setA(Frame& F, const Args& a, int l, int pidx, int pcnt, int part) {
    unsigned char* ws = a.ws;
    bf16_t* Win = (bf16_t*)(ws + WS_WIN); bf16_t* Wb = (bf16_t*)(ws + WS_WB); bf16_t* Wout = (bf16_t*)(ws + WS_WOUT);
    const float* w_in = a.in[I_WIN] + (size_t)l * D * DIN;
    LAS float* scr = (LAS float*)(F.lds + F.wave * 16384);
    const int gw = pidx * 8 + F.wave, NGW = pcnt * 8;
    constexpr int I1 = 16 * 168, I2 = 128, I3 = 128, I4 = 256, I5 = 512;
    for (int it = gw; it < I1 + I2 + I3 + I4 + I5; it += NGW) {
        int r = it;
        if (r < I1) { const int kb = r / 168, nb = r % 168, k0 = kb * 64, n0 = 256 + nb * 32;
            if (!((part >> (nb >= 72 ? 1 : 0)) & 1)) continue;
            tr_item(w_in + (size_t)k0 * DIN + n0, DIN, Win + (size_t)(n0 + 256) * 1024 + k0, 1024, scr, F.lane); continue; } r -= I1;
        if (!(part & 2)) break;
        if (r < I2) { const int kb = r / 32, nb = r % 32; tr_item(a.in[I_WFO] + (size_t)l * 256 * D + (size_t)kb * 64 * D + nb * 32, D, Wb + (size_t)(nb * 32) * 1024 + kb * 64, 1024, scr, F.lane); continue; } r -= I2;
        if (r < I3) { const int kb = r / 32, nb = r % 32; tr_item(a.in[I_WCO] + (size_t)l * 256 * D + (size_t)kb * 64 * D + nb * 32, D, Wb + (size_t)(nb * 32) * 1024 + 256 + kb * 64, 1024, scr, F.lane); continue; } r -= I3;
        if (r < I4) { const int kb = r / 32, nb = r % 32; tr_item(a.in[I_WAO] + (size_t)l * 512 * D + (size_t)kb * 64 * D + nb * 32, D, Wb + (size_t)(nb * 32) * 1024 + 512 + kb * 64, 1024, scr, F.lane); continue; } r -= I4;
        { const int kb = r / 32, nb = r % 32; tr_item(a.in[I_WOUT] + (size_t)l * D * D + (size_t)kb * 64 * D + nb * 32, D, Wout + (size_t)(nb * 32) * 1024 + kb * 64, 1024, scr, F.lane); }
    }
    if (!(part & 1)) return;
    const LAS float* ct = (const LAS float*)(F.lds + LDS_COSTAB);
    const int gt = pidx * 512 + F.tid, NGT = pcnt * 512;
    for (int o = gt; o < 1024 * 128; o += NGT) {
        const int k = o & 1023, g = (o >> 10) & 3, mq = o >> 12;
        const float* wp = w_in + (size_t)k * DIN + g * 64;
        f32x4 wv[16];
#pragma unroll
        for (int i = 0; i < 16; ++i) wv[i] = *(const f32x4*)(wp + 4 * i);
#pragma unroll 1
        for (int mm = 0; mm < 2; ++mm) {
            const int m = mq * 2 + mm; float sc = 0.f, ss = 0.f;
#pragma unroll
            for (int j = 0; j < 64; ++j) { const int i = ((j * m) & 63) * 32; const float w = wv[j >> 2][j & 3]; sc += w * ct[i]; ss += w * ct[(i + 1536) & 2047]; }
            Win[(size_t)(g * 64 + m) * 1024 + k] = (bf16_t)f2bf(sc * 0.125f);
            Win[(size_t)(256 + g * 64 + m) * 1024 + k] = (bf16_t)f2bf(ss * 0.125f);
        }
    }
    float* bi = (float*)(ws + WS_BIASIN) + l * NIN; const float* b_in = a.in[I_BIN] + (size_t)l * DIN;
    for (int r = gt; r < NIN; r += NGT) {
        float v;
        if (r < 512) { const int pt = r >> 8, g = (r >> 6) & 3, m = r & 63; float s_ = 0.f;
            for (int j = 0; j < 64; ++j) { const int i = (j * m) & 63; s_ += b_in[g * 64 + j] * ct[(i * 32 + (pt ? 1536 : 0)) & 2047]; }
            v = s_ * 0.125f; }
        else v = b_in[r - 256];
        bi[r] = v;
    }
}
__device__ __forceinline__ void conv_setB(Frame& F, const Args& a, int l, int pidx, int pcnt) {
    unsigned char* ws = a.ws;
    bf16_t* Wgu = (bf16_t*)(ws + (l ? WS_WGU1 : WS_WGU0)); bf16_t* Wd = (bf16_t*)(ws + (l ? WS_WD1 : WS_WD0));
    LAS float* scr = (LAS float*)(F.lds + F.wave * 16384);
    const int gw = pidx * 8 + F.wave, NGW = pcnt * 8;
    constexpr int J1 = 16 * 88, J3 = 44 * 32;
    for (int it = gw; it < 2 * J1 + J3; it += NGW) {
        int r = it;
        if (r < 2 * J1) { const int up = r >= J1; if (up) r -= J1; const int kb = r / 88, nb = r % 88, n0 = nb * 32;
            const float* W = a.in[up ? I_WU : I_WG] + (size_t)l * D * DFF;
            tr_item(W + (size_t)kb * 64 * DFF + n0, DFF, Wgu + (size_t)((n0 >> 7) * 256 + up * 128 + (n0 & 127)) * 1024 + kb * 64, 1024, scr, F.lane); continue; }
        r -= 2 * J1;
        { const int kb = r / 32, nb = r % 32; tr_item(a.in[I_WD] + (size_t)l * DFF * D + (size_t)kb * 64 * D + nb * 32, D, Wd + (size_t)(nb * 32) * DFF + kb * 64, DFF, scr, F.lane); }
    }
}

__device__ __forceinline__ void norm_row(const float* xrow, const float* g, const float* sh, const float* sc, bf16_t* orow, float* fout, int lane) {
    f32x4 v[4]; float s = 0.f;
#pragma unroll
    for (int j = 0; j < 4; ++j) { v[j] = *((const f32x4*)xrow + lane + 64 * j); s += (v[j].x * v[j].x + v[j].y * v[j].y) + (v[j].z * v[j].z + v[j].w * v[j].w); }
    const float rstd = 1.0f / sqrtf(wave_sum(s) * (1.0f / D) + EPS);
#pragma unroll
    for (int j = 0; j < 4; ++j) {
        const int c = (lane + 64 * j) * 4;
        f32x4 y = v[j] * rstd * *(const f32x4*)(g + c);
        if (fout) { *(f32x4*)(fout + c) = y; }
        else { y = y * (*(const f32x4*)(sc + c) + 1.0f) + *(const f32x4*)(sh + c);
            u32x2 w; w.x = cvt_pk_bf16(y.x, y.y); w.y = cvt_pk_bf16(y.z, y.w); *(u32x2*)(orow + c) = w; }
    }
}
__device__ __forceinline__ void norm_phase(Frame& F, const float* xl, const float* xc, const float* g, const float* mod, int sh_off, int sc_off, bf16_t* H, bool with_ctx) {
    const int gw = F.vcu * 8 + F.wave, NGW = F.G * 8, nrows = with_ctx ? MT : ML;
    for (int r = gw; r < nrows; r += NGW) {
        const int b = r < ML ? (r >> 11) : 8;
        const float* xr = r < ML ? xl + (size_t)r * D : xc + (size_t)(r - ML) * D;
        norm_row(xr, g, mod + (size_t)b * 6144 + sh_off, mod + (size_t)b * 6144 + sc_off, H + (size_t)r * D, nullptr, F.lane);
    }
}

__device__ __forceinline__ int crow(int r, int hi) { return (r & 3) + 8 * (r >> 2) + 4 * hi; }
__device__ __forceinline__ s16x4 vtr(const LAS unsigned char* p) { return __builtin_bit_cast(s16x4, __builtin_amdgcn_ds_read_tr16_b64_v4i16((LAS s16x4*)p)); }
constexpr int AT_WSF = 131072;
__device__ __forceinline__ void at_softmax(f32x16& p0, f32x16& p1, f32x16& negm, float& mhat, float& lsum, f32x16 (&o)[4], bf16x8 (&pa)[4], LAS float* wsf, bool first, int r32, int hi) {
    float rm = fmaxf(fmaxf(p0[0], p0[1]), p1[0]);
    { float rb = fmaxf(fmaxf(p0[2], p0[3]), p1[1]); rm = fmaxf(fmaxf(rm, p1[2]), p1[3]);
#pragma unroll
      for (int r = 4; r < 16; r += 4) { rm = fmaxf(fmaxf(rm, p0[r]), p0[r + 1]); rb = fmaxf(fmaxf(rb, p0[r + 2]), p0[r + 3]); rm = fmaxf(fmaxf(rm, p1[r]), p1[r + 1]); rb = fmaxf(fmaxf(rb, p1[r + 2]), p1[r + 3]); }
      rm = fmaxf(rm, rb); }
    rm = fmaxf(rm, __shfl_xor(rm, 32));
    const bool need = first || (rm > 6.0f);
    if (__any(need)) {
        const float dl = need ? rm : 0.f;
        mhat += dl;
#pragma unroll
        for (int r = 0; r < 16; ++r) { p0[r] -= dl; p1[r] -= dl; negm[r] = -mhat; }
        if (!first) {
            const float f = fast_exp2(-dl);
            lsum *= f;
            asm volatile("" ::: "memory");
            if (hi == 0) wsf[r32] = f;
            asm volatile("s_waitcnt lgkmcnt(0)" ::: "memory");
#pragma unroll
            for (int r = 0; r < 16; ++r) { const float fr_ = wsf[crow(r, hi)];
#pragma unroll
                for (int d0 = 0; d0 < 4; ++d0) o[d0][r] *= fr_; }
            asm volatile("s_waitcnt lgkmcnt(0)" ::: "memory");
        }
    }
    f32x2_t ls2 = (f32x2_t){0.f, 0.f};
#pragma unroll
    for (int r = 0; r < 16; r += 2) { p0[r] = fast_exp2(p0[r]); p0[r + 1] = fast_exp2(p0[r + 1]); p1[r] = fast_exp2(p1[r]); p1[r + 1] = fast_exp2(p1[r + 1]);
        ls2 += (f32x2_t){p0[r], p0[r + 1]}; ls2 += (f32x2_t){p1[r], p1[r + 1]}; }
    lsum += ls2.x + ls2.y;
    u32x4 w;
    w.x = cvt_pk_bf16(p0[0], p0[1]); w.y = cvt_pk_bf16(p0[2], p0[3]); w.z = cvt_pk_bf16(p0[4], p0[5]); w.w = cvt_pk_bf16(p0[6], p0[7]); pa[0] = __builtin_bit_cast(bf16x8, w);
    w.x = cvt_pk_bf16(p0[8], p0[9]); w.y = cvt_pk_bf16(p0[10], p0[11]); w.z = cvt_pk_bf16(p0[12], p0[13]); w.w = cvt_pk_bf16(p0[14], p0[15]); pa[1] = __builtin_bit_cast(bf16x8, w);
    w.x = cvt_pk_bf16(p1[0], p1[1]); w.y = cvt_pk_bf16(p1[2], p1[3]); w.z = cvt_pk_bf16(p1[4], p1[5]); w.w = cvt_pk_bf16(p1[6], p1[7]); pa[2] = __builtin_bit_cast(bf16x8, w);
    w.x = cvt_pk_bf16(p1[8], p1[9]); w.y = cvt_pk_bf16(p1[10], p1[11]); w.z = cvt_pk_bf16(p1[12], p1[13]); w.w = cvt_pk_bf16(p1[14], p1[15]); pa[3] = __builtin_bit_cast(bf16x8, w);
}
__device__ __forceinline__ void attn_unit(Frame& F, const bf16_t* P, bf16_t* BR, int qrow0, int base1, int n1, int base2, int nt, int h, float lam, float oscale, const float* subg) {
    LAS unsigned char* lds = F.lds;
    const int tid = F.tid, lane = F.lane, wid = F.wave, r32 = lane & 31, hi = lane >> 5, qg = wid & 3, comp = wid >> 2;
    bf16x8 qf[4];
    { const bf16_t* qp = P + (size_t)(qrow0 + qg * 32 + r32) * LDP + PQ + h * 128 + comp * 64 + hi * 8;
#pragma unroll
      for (int d0 = 0; d0 < 4; ++d0) qf[d0] = *(const bf16x8*)(qp + d0 * 16); }
    int ksrc[2], kdst[2], vsrc[2], vdst[2];
#pragma unroll
    for (int i = 0; i < 2; ++i) { const int pc = wid * 2 + i;
        { const int cmp = pc >> 3, rg = pc & 7, row = rg * 8 + (lane >> 3), c8 = (lane & 7) ^ (lane >> 3); ksrc[i] = row * LDP + PK + h * 128 + cmp * 64 + c8 * 8; kdst[i] = cmp * 8192 + rg * 1024; }
        { const int d0 = pc >> 2, rg = pc & 3; vsrc[i] = (rg * 16 + (lane >> 2)) * LDP + PV + h * 128 + d0 * 32 + (lane & 3) * 8; vdst[i] = 16384 + d0 * 4096 + rg * 1024; } }
#define AT_TROW(t) ((t) < n1 ? base1 + 64 * (t) : base2 + 64 * ((t) - n1))
    LAS float* wsf = (LAS float*)(lds + AT_WSF) + wid * 64;
    float mhat = 0.f, lsum = 0.f;
    f32x16 negm;
#pragma unroll
    for (int r = 0; r < 16; ++r) negm[r] = 0.f;
    f32x16 o[4];
#pragma unroll
    for (int d0 = 0; d0 < 4; ++d0)
#pragma unroll
        for (int r = 0; r < 16; ++r) o[d0][r] = 0.f;
    bf16x8 pa[4];
#pragma unroll
    for (int i = 0; i < 4; ++i) pa[i] = (bf16x8){0, 0, 0, 0, 0, 0, 0, 0};
    s16x4 va[8], vb[8];
#pragma unroll
    for (int i = 0; i < 8; ++i) { va[i] = (s16x4){0, 0, 0, 0}; vb[i] = (s16x4){0, 0, 0, 0}; }
    const int vlane = ((lane >> 4) & 1) * 32 + (lane & 3) * 8 + (4 * hi + ((lane & 15) >> 2)) * 64;
    const int klane = comp * 8192 + r32 * 128;
    int koff[4];
#pragma unroll
    for (int d0 = 0; d0 < 4; ++d0) koff[d0] = ((2 * d0 + hi) ^ (r32 & 7)) * 16;
#define AT_SB() __builtin_amdgcn_sched_barrier(0)
#define AT_DMA4(t, OFF) do { const bf16_t* tp = P + (size_t)AT_TROW(t) * LDP; \
        __builtin_amdgcn_global_load_lds((const unsigned*)(tp + ksrc[0]), (LAS unsigned*)(lds + (OFF) + kdst[0]), 16, 0, 0); \
        __builtin_amdgcn_global_load_lds((const unsigned*)(tp + ksrc[1]), (LAS unsigned*)(lds + (OFF) + kdst[1]), 16, 0, 0); \
        __builtin_amdgcn_global_load_lds((const unsigned*)(tp + vsrc[0]), (LAS unsigned*)(lds + (OFF) + vdst[0]), 16, 0, 0); \
        __builtin_amdgcn_global_load_lds((const unsigned*)(tp + vsrc[1]), (LAS unsigned*)(lds + (OFF) + vdst[1]), 16, 0, 0); } while (0)
#define AT_VF(x, s) ((bf16x8){x[2 * (s)][0], x[2 * (s)][1], x[2 * (s)][2], x[2 * (s)][3], x[2 * (s) + 1][0], x[2 * (s) + 1][1], x[2 * (s) + 1][2], x[2 * (s) + 1][3]})
#define AT_TR(dst, addr, off) asm volatile("ds_read_b64_tr_b16 %0, %1 offset:%c2" : "=&v"(dst) : "v"(addr), "i"(off) : "memory")
    const unsigned ldsb = (unsigned)(unsigned long long)lds;
#define AT_VPRE(OFF) do { const unsigned vp_ = ldsb + (OFF) + 16384 + vlane; \
        _Pragma("unroll") for (int s_ = 0; s_ < 4; ++s_) { AT_TR(va[2 * s_], vp_, s_ * 1024); AT_TR(va[2 * s_ + 1], vp_, s_ * 1024 + 512); AT_TR(vb[2 * s_], vp_, 4096 + s_ * 1024); AT_TR(vb[2 * s_ + 1], vp_, 4096 + s_ * 1024 + 512); } } while (0)
#define AT_PVMMA(OFF) do { const unsigned vp_ = ldsb + (OFF) + 16384 + vlane; \
        asm volatile("s_waitcnt lgkmcnt(0)" ::: "memory"); AT_SB(); __builtin_amdgcn_s_setprio(1); \
        _Pragma("unroll") for (int s_ = 0; s_ < 4; ++s_) { \
            o[0] = __builtin_amdgcn_mfma_f32_32x32x16_bf16(pa[s_], AT_VF(va, s_), o[0], 0, 0, 0); \
            o[1] = __builtin_amdgcn_mfma_f32_32x32x16_bf16(pa[s_], AT_VF(vb, s_), o[1], 0, 0, 0); \
            AT_SB(); \
            AT_TR(va[2 * s_], vp_, 8192 + s_ * 1024); AT_TR(va[2 * s_ + 1], vp_, 8192 + s_ * 1024 + 512); AT_TR(vb[2 * s_], vp_, 12288 + s_ * 1024); AT_TR(vb[2 * s_ + 1], vp_, 12288 + s_ * 1024 + 512); \
            AT_SB(); } \
        asm volatile("s_waitcnt lgkmcnt(0)" ::: "memory"); AT_SB(); \
        _Pragma("unroll") for (int s_ = 0; s_ < 4; ++s_) { \
            o[2] = __builtin_amdgcn_mfma_f32_32x32x16_bf16(pa[s_], AT_VF(va, s_), o[2], 0, 0, 0); \
            o[3] = __builtin_amdgcn_mfma_f32_32x32x16_bf16(pa[s_], AT_VF(vb, s_), o[3], 0, 0, 0); } \
        __builtin_amdgcn_s_setprio(0); AT_SB(); } while (0)
#define AT_STEP(t, CUR, NX2, PRV) do { \
        if ((t) + 2 < nt) AT_DMA4((t) + 2, NX2); \
        if (comp == 1 && (t) > 0) AT_PVMMA(PRV); \
        f32x16 p0, p1; \
        {   bf16x8 kf[8]; const LAS unsigned char* kb = lds + (CUR) + klane; \
            _Pragma("unroll") for (int d0 = 0; d0 < 4; ++d0) { kf[2 * d0] = *(const LAS bf16x8*)(kb + koff[d0]); kf[2 * d0 + 1] = *(const LAS bf16x8*)(kb + koff[d0] + 4096); } \
            AT_SB(); __builtin_amdgcn_s_setprio(1); \
            p0 = __builtin_amdgcn_mfma_f32_32x32x16_bf16(kf[0], qf[0], negm, 0, 0, 0); \
            p1 = __builtin_amdgcn_mfma_f32_32x32x16_bf16(kf[1], qf[0], negm, 0, 0, 0); \
            _Pragma("unroll") for (int d0 = 1; d0 < 4; ++d0) { \
                p0 = __builtin_amdgcn_mfma_f32_32x32x16_bf16(kf[2 * d0], qf[d0], p0, 0, 0, 0); \
                p1 = __builtin_amdgcn_mfma_f32_32x32x16_bf16(kf[2 * d0 + 1], qf[d0], p1, 0, 0, 0); } __builtin_amdgcn_s_setprio(0); } \
        AT_SB(); \
        AT_VPRE(CUR); \
        AT_SB(); \
        at_softmax(p0, p1, negm, mhat, lsum, o, pa, wsf, (t) == 0, r32, hi); \
        AT_SB(); \
        if (comp == 0) AT_PVMMA(CUR); \
          \
        if ((t) + 2 < nt) asm volatile("s_waitcnt vmcnt(4)" ::: "memory"); else asm volatile("s_waitcnt vmcnt(0)" ::: "memory"); \
        AT_SB(); __builtin_amdgcn_s_barrier(); AT_SB(); } while (0)
    AT_DMA4(0, 0);
    if (nt > 1) AT_DMA4(1, 32768);
    if (nt > 1) asm volatile("s_waitcnt vmcnt(4)" ::: "memory"); else asm volatile("s_waitcnt vmcnt(0)" ::: "memory");
    __syncthreads();
#pragma unroll 1
    for (int t = 0; t < nt; t += 4) {
        AT_STEP(t, 0, 65536, 98304);
        if (t + 1 < nt) AT_STEP(t + 1, 32768, 98304, 0);
        if (t + 2 < nt) AT_STEP(t + 2, 65536, 0, 32768);
        if (t + 3 < nt) AT_STEP(t + 3, 98304, 32768, 65536);
    }
    if (comp == 1) { const int lo_ = ((nt - 1) & 3) * 32768; AT_PVMMA(lo_); }
    __syncthreads();
#undef AT_STEP
#undef AT_PVMMA
#undef AT_VPRE
#undef AT_TR
#undef AT_VF
#undef AT_DMA4
#undef AT_SB
    lsum += __shfl_xor(lsum, 32);
    { float inv = 1.0f / lsum; if (comp) inv *= lam;
      asm volatile("" ::: "memory");
      if (hi == 0) wsf[r32] = inv;
      asm volatile("s_waitcnt lgkmcnt(0)" ::: "memory");
#pragma unroll
      for (int r = 0; r < 16; ++r) { const float fr_ = wsf[crow(r, hi)];
#pragma unroll
          for (int d0 = 0; d0 < 4; ++d0) o[d0][r] *= fr_; } }
    LAS float* X = (LAS float*)lds + qg * (32 * 132);
    if (comp == 1) {
#pragma unroll
        for (int d0 = 0; d0 < 4; ++d0)
#pragma unroll
            for (int r = 0; r < 16; ++r) X[crow(r, hi) * 132 + d0 * 32 + r32] = o[d0][r];
    }
    __syncthreads();
    if (comp == 0) {
#pragma unroll
        for (int d0 = 0; d0 < 4; ++d0)
#pragma unroll
            for (int r = 0; r < 16; ++r) { const int ix = crow(r, hi) * 132 + d0 * 32 + r32; X[ix] = o[d0][r] - X[ix]; }
        asm volatile("s_waitcnt lgkmcnt(0)" ::: "memory");
        const int row = lane >> 1, hf = lane & 1;
        const LAS float* xr = X + row * 132 + hf * 64;
        float ss = 0.f;
#pragma unroll
        for (int c = 0; c < 16; ++c) { const f32x4 v = *(const LAS f32x4*)(xr + c * 4); ss += (v.x * v.x + v.y * v.y) + (v.z * v.z + v.w * v.w); }
        ss += __shfl_xor(ss, 1);
        const float rstd = oscale / sqrtf(ss * (1.0f / 128.0f) + EPS);
        bf16_t* op = BR + (size_t)(qrow0 + qg * 32 + row) * 1024 + 512 + h * 128 + hf * 64;
        const float* gp = subg + hf * 64;
#pragma unroll
        for (int c = 0; c < 8; ++c) {
            const f32x4 v0 = *(const LAS f32x4*)(xr + c * 8) * rstd * *(const f32x4*)(gp + c * 8), v1 = *(const LAS f32x4*)(xr + c * 8 + 4) * rstd * *(const f32x4*)(gp + c * 8 + 4);
            u32x4 w; w.x = cvt_pk_bf16(v0.x, v0.y); w.y = cvt_pk_bf16(v0.z, v0.w); w.z = cvt_pk_bf16(v1.x, v1.y); w.w = cvt_pk_bf16(v1.z, v1.w);
            *(u32x4*)(op + c * 8) = w;
        }
    }
    __syncthreads();
#undef AT_TROW
}

#define XB_TMO      128
#define XB_XCNT(j)  (256  + 64 * (j))
#define XB_XSUB(j)  (1280 + 64 * (j))
#define XB_XGEN(j)  (2304 + 64 * (j))
#define XB_TOP      3328
#define XB_TOPGEN   3392
#define XCD_BAR_WORDS 3456
#define XB_SPIN_CAP (1u << 18)
__device__ __forceinline__ unsigned xb_ld(unsigned* p)              { return __hip_atomic_load(p, __ATOMIC_RELAXED, __HIP_MEMORY_SCOPE_AGENT); }
__device__ __forceinline__ unsigned xb_add(unsigned* p, unsigned v) { return __hip_atomic_fetch_add(p, v, __ATOMIC_RELAXED, __HIP_MEMORY_SCOPE_AGENT); }
__device__ __forceinline__ unsigned xb_xcc_id() { return (unsigned)__builtin_amdgcn_s_getreg((3 << 11) | 20) & 0xFu; }
#define XB_SPIN(cond, bar) do { unsigned _sp = 0; while (cond) { __builtin_amdgcn_s_sleep(1); \
    if ((++_sp & 255u) == 0u) { if (xb_ld(&(bar)[XB_TMO])) break; if (_sp > XB_SPIN_CAP) { atomicAdd(&(bar)[XB_TMO], 1u); break; } } } } while (0)
struct XcdBarrier { unsigned* bar; unsigned x; volatile LAS unsigned* st; };
__device__ __forceinline__ XcdBarrier xcd_barrier_post(unsigned* bar, volatile LAS unsigned* st) {
    XcdBarrier b; b.bar = bar; b.x = xb_xcc_id(); b.st = st;
    if (threadIdx.x == 0) (void)xb_add(&bar[XB_XCNT(b.x)], 1u);
    return b;
}
__device__ __forceinline__ void xcd_barrier_complete(unsigned* bar, unsigned x, unsigned& nloc, unsigned& nx) {
    const unsigned G = gridDim.x * gridDim.y * gridDim.z;
    unsigned sum, cnt, mine, sp = 0u;
    for (;;) {
        sum = 0u; cnt = 0u; mine = 0u;
#pragma unroll
        for (unsigned j = 0; j < 16; ++j) { const unsigned c = xb_ld(&bar[XB_XCNT(j)]); sum += c; cnt += (c > 0u) ? 1u : 0u; mine = (j == x) ? c : mine; }
        if (sum == G) break;
        __builtin_amdgcn_s_sleep(1);
        if ((++sp & 255u) == 0u) { if (xb_ld(&bar[XB_TMO])) break; if (sp > XB_SPIN_CAP) { atomicAdd(&bar[XB_TMO], 1u); break; } }
    }
    nloc = mine > 0u ? mine : 1u; nx = cnt > 0u ? cnt : 1u;
}
__device__ __forceinline__ void xcd_barrier(const XcdBarrier& b) {
    asm volatile("s_waitcnt vmcnt(0)" ::: "memory");
    __syncthreads();
    if (threadIdx.x == 0) {
        unsigned* bar = b.bar;
        __builtin_amdgcn_s_waitcnt(0);
        unsigned nloc = b.st[0], nx = b.st[1];
        if (nloc == 0u) { xcd_barrier_complete(bar, b.x, nloc, nx); b.st[0] = nloc; b.st[1] = nx; }
        const unsigned old = xb_add(&bar[XB_XSUB(b.x)], 1u);
        const unsigned gen = old / nloc;
        if (old + 1u == (gen + 1u) * nloc) {
            __builtin_amdgcn_fence(__ATOMIC_RELEASE, "agent");
            asm volatile("s_waitcnt vmcnt(0)" ::: "memory");
            const unsigned og = xb_add(&bar[XB_TOP], 1u);
            const unsigned tg = og / nx;
            if (og + 1u == (tg + 1u) * nx) xb_add(&bar[XB_TOPGEN], 1u);
            else XB_SPIN(xb_ld(&bar[XB_TOPGEN]) == tg, bar);
            __builtin_amdgcn_fence(__ATOMIC_ACQUIRE, "agent");
            xb_add(&bar[XB_XGEN(b.x)], 1u);
            asm volatile("s_waitcnt vmcnt(0)" ::: "memory");
        } else {
            XB_SPIN(xb_ld(&bar[XB_XGEN(b.x)]) == gen, bar);
            __builtin_amdgcn_fence(__ATOMIC_ACQUIRE, "agent");
            asm volatile("s_waitcnt vmcnt(0)" ::: "memory");
        }
    }
    __syncthreads();
}

constexpr int N_PHASES = 20;
__global__ void __launch_bounds__(512, 2) fwd_kernel(Args args) {
    extern __shared__ __attribute__((aligned(16))) unsigned char lds_raw[];
    Frame F;
    F.lds = (LAS unsigned char*)lds_raw;
    F.tid = threadIdx.x; F.lane = F.tid & 63; F.wave = __builtin_amdgcn_readfirstlane(F.tid >> 6);
    F.G = gridDim.x; F.bx = blockIdx.x; F.vcu = (F.G % 8 == 0) ? (F.bx % 8) * (F.G / 8) + F.bx / 8 : F.bx; F.rot = 0;
    unsigned char* const ws = args.ws;
    float* const XL = args.out;
    if (F.tid < 2) ((LAS unsigned*)(F.lds + LDS_XB))[F.tid] = 0u;
    __syncthreads();
    if (args.ph_hi - args.ph_lo > 1) (void)xcd_barrier_post((unsigned*)(ws + WS_BAR), (volatile LAS unsigned*)(F.lds + LDS_XB));
#define WSP(T, off) ((T*)(ws + (off)))
#pragma unroll 1
    for (int ph = args.ph_lo, rep = 0; ph < args.ph_hi;) {
#define REFRESH_LANE() do { int l_ = (int)__builtin_amdgcn_mbcnt_hi(~0u, __builtin_amdgcn_mbcnt_lo(~0u, 0u)); asm volatile("" : "+v"(l_)); F.lane = l_; F.tid = F.wave * 64 + l_; } while (0)
        REFRESH_LANE();
        const int kind = ph < 2 ? ph : 2 + (ph - 2) % 9;
        const int l = ph < 2 ? 0 : (ph - 2) / 9;
        const bool last = (l == 1);
        const float* mod = WSP(float, WS_MOD) + (size_t)l * 9 * 6144;
        const float* biasin = WSP(float, WS_BIASIN) + l * NIN;
        if (kind == 0) {
            LAS float* ct = (LAS float*)(F.lds + LDS_COSTAB);
            for (int i = F.tid; i < 2048; i += 512) ct[i] = cospif((float)i * (1.0f / 1024.0f));
            __syncthreads();
        }
        if (kind == 0) {
            if (F.bx < 192) {
                LAS float* sv = (LAS float*)F.lds;
                LAS float* red = (LAS float*)(F.lds + 40960);
                for (int i = F.tid; i < 9 * 1024; i += 512) { const int r = i >> 10, k = i & 1023; const float c = r < 8 ? args.in[I_C][r * 1024 + k] : args.in[I_CCTX][k]; sv[i] = c / (1.0f + __expf(-c)); }
                __syncthreads();
                for (int job = F.bx; job < 192; job += F.G) {
                    const int jl = job / 96, n0 = (job % 96) * 64, kg = F.tid >> 6, nn = F.tid & 63;
                    const float* wp = args.in[I_WADA] + (size_t)jl * D * 6144 + (size_t)(kg * 128) * 6144 + n0 + nn;
                    float ac[9];
#pragma unroll
                    for (int r = 0; r < 9; ++r) ac[r] = 0.f;
#pragma unroll 1
                    for (int k0 = 0; k0 < 128; k0 += 16) {
                        float wv[16];
#pragma unroll
                        for (int i = 0; i < 16; ++i) wv[i] = wp[(size_t)(k0 + i) * 6144];
#pragma unroll
                        for (int i = 0; i < 16; ++i)
#pragma unroll
                            for (int r = 0; r < 9; ++r) ac[r] += sv[r * 1024 + kg * 128 + k0 + i] * wv[i]; }
#pragma unroll
                    for (int r = 0; r < 9; ++r) red[(kg * 9 + r) * 64 + nn] = ac[r];
                    __syncthreads();
                    for (int o = F.tid; o < 576; o += 512) { const int r = o >> 6, n = o & 63; float s = args.in[I_BADA][jl * 6144 + n0 + n];
#pragma unroll
                        for (int q = 0; q < 8; ++q) s += red[(q * 9 + r) * 64 + n];
                        WSP(float, WS_MOD)[((size_t)jl * 9 + r) * 6144 + n0 + n] = s; }
                    __syncthreads();
                }
            }
            __syncthreads();
            if (F.bx == F.G - 1) {
                float* ROPE = WSP(float, WS_ROPE);
                for (int i = F.tid; i < 1024; i += 512) { const int pos = i >> 4, f = i & 15; const float fr = powf(10000.0f, -(float)f * (1.0f / 16.0f)); const float ang = (float)pos * fr; ROPE[i] = cosf(ang); ROPE[1024 + i] = sinf(ang); }
                if (F.tid < 2) { const int jl = F.tid; float s1 = 0.f, s2 = 0.f;
                    for (int j = 0; j < 64; ++j) { s1 += args.in[I_LQ1][jl * 64 + j] * args.in[I_LK1][jl * 64 + j]; s2 += args.in[I_LQ2][jl * 64 + j] * args.in[I_LK2][jl * 64 + j]; }
                    WSP(float, WS_LAM)[jl] = expf(s1) - expf(s2) + (0.8f - 0.6f * expf(-0.3f * (float)jl)); }
            }
            __syncthreads();
        }
        if (kind == 0) { REFRESH_LANE(); conv_setA(F, args, 0, F.vcu, F.G, 1); }
        if (kind == 1 || kind == 7 || (kind == 10 && !last)) {
            REFRESH_LANE();
            const bool n2 = (kind == 7);
            const float* xl = (kind == 1) ? args.in[I_X] : XL;
            const float* xc = (kind == 1) ? args.in[I_CTX] : WSP(float, WS_XC);
            const float* g = n2 ? args.in[I_N2G] + l * 1024 : args.in[I_N1G] + (kind == 10 ? 1024 : 0);
            const float* m = (kind == 10) ? WSP(float, WS_MOD) + (size_t)9 * 6144 : mod;
            norm_phase(F, xl, xc, g, m, n2 ? 3072 : 0, n2 ? 4096 : 1024, n2 ? WSP(bf16_t, WS_BR) : WSP(bf16_t, WS_H), n2 ? !last : true);
        }
        if (kind == 10 && last) {
            REFRESH_LANE();
            const int gw = F.vcu * 8 + F.wave, NGW = F.G * 8;
            for (int r = gw; r < ML; r += NGW) norm_row(XL + (size_t)r * D, args.in[I_FING], nullptr, nullptr, nullptr, XL + (size_t)r * D, F.lane);
        }
        if (kind == 3) {
            const float lam = WSP(float, WS_LAM)[l]; const float osc = 1.0f - (0.8f - 0.6f * expf(-0.3f * (float)l)); const float* subg = args.in[I_SUBG] + l * 128;
            const bf16_t* P = WSP(bf16_t, WS_P); bf16_t* BR = WSP(bf16_t, WS_BR);
            const int npairs = (2 * F.vcu < 512) ? (512 - 2 * F.vcu + 2 * F.G - 1) / (2 * F.G) : 0, nlat = 2 * npairs;
#pragma unroll 1
            for (int rp = 0; rp <= PROBE_ATT; ++rp)
#pragma unroll 1
            for (int i = 0;; ++i) {
                int qrow0, base1, n1, base2, nt, h;
                if (i < nlat) { const int un = (i >> 1) * 2 * F.G + 2 * F.vcu + (i & 1); const int bh = un >> 4, qb = un & 15, b = bh >> 2; h = bh & 3;
                    qrow0 = b * SEQ + qb * 128; base1 = b * SEQ; n1 = 32; base2 = ML + b * CTXL; nt = 36; }
                else { const int cu = F.vcu + (i - nlat) * F.G; if (last || cu >= 64) break; const int bh = cu >> 1, qb = cu & 1, b = bh >> 2; h = bh & 3;
                    qrow0 = ML + b * CTXL + qb * 128; base1 = ML + b * CTXL; n1 = 4; base2 = 0; nt = 4; }
                REFRESH_LANE();
                attn_unit(F, P, BR, qrow0, base1, n1, base2, nt, h, lam, osc, subg);
            }
        }
#pragma unroll 1
        for (int j = 0; j < 4; ++j) {
            GJob J{}; bool have = false;
            J.lda = 1024; J.ldb = 1024; J.K = 1024; J.rot = -1;
            if (kind == 2) {
                if (j < 2) { have = true; J.A = WSP(bf16_t, WS_H) + (j ? (size_t)ML * 1024 : 0); J.Bt = WSP(bf16_t, WS_WIN); J.M = j ? MC : ML; J.N = NP1;
                    J.E.mode = E_INPROJ; J.E.out = WSP(bf16_t, WS_P); J.E.p1 = biasin; J.E.p2 = WSP(float, WS_ROPE); J.E.row_base = j ? ML : 0; J.E.ctx = j; J.E.aux = 0; J.E.p3 = WSP(bf16_t, (l ? WS_FT1 : WS_FT0)); J.E.p4 = WSP(bf16_t, WS_FTC);
                    if (j == 0) J.rot = 0;
                    if (j && last) { J.Bt = WSP(bf16_t, WS_WIN) + (size_t)7 * 256 * 1024; J.N = 1024; J.E.aux = 7; J.E.p1 = biasin + 7 * 256; } }
            } else if (kind == 4) {
                const int nf = (F.G >= 128) ? 64 : 0;
                if (j == 0) { have = true; J.A = WSP(bf16_t, WS_DFT); J.lda = 4096; J.Bt = WSP(bf16_t, (l ? WS_FT1 : WS_FT0)); J.ldb = 4096; J.M = 2048; J.N = 2048; J.K = 4096; J.rot = 0;
                    if (nf) { J.gfirst = 0; J.gsub = nf; }
                    J.E.mode = E_FOUR; J.E.out = WSP(bf16_t, WS_BR); J.E.row_base = 0; J.E.ctx = 0; J.E.scale = 0.02209708691207961f; }
                else if (j == 1 && !last) { have = true; J.A = WSP(bf16_t, WS_DFT256); J.lda = 512; J.Bt = WSP(bf16_t, WS_FTC); J.ldb = 512; J.M = 256; J.N = 2048; J.K = 512; J.rot = 0;
                    if (nf) { J.gfirst = nf; J.gsub = F.G - nf; }
                    J.E.mode = E_FOUR; J.E.out = WSP(bf16_t, WS_BR); J.E.row_base = ML; J.E.ctx = 1; J.E.scale = 0.0625f; }
                else if (j == 2) { have = true; J.A = WSP(bf16_t, WS_H); J.Bt = WSP(bf16_t, WS_WIN) + (size_t)NP1 * 1024; J.M = (last || nf) ? ML : MT; J.N = 3072; J.rot = 0;
                    if (nf) { J.gfirst = nf; J.gsub = F.G - nf; }
                    J.E.mode = E_GATE; J.E.out = WSP(bf16_t, WS_P); J.E.p1 = biasin + NP1; J.E.row_base = 0; }
                else if (j == 3 && !last && nf) { have = true; J.A = WSP(bf16_t, WS_H) + (size_t)ML * 1024; J.Bt = WSP(bf16_t, WS_WIN) + (size_t)NP1 * 1024; J.M = MC; J.N = 3072; J.rot = 0;
                    J.gfirst = 0; J.gsub = nf;
                    J.E.mode = E_GATE; J.E.out = WSP(bf16_t, WS_P); J.E.p1 = biasin + NP1; J.E.row_base = ML; }
            } else if (kind == 5) {
                if (j == 0) { have = true; J.A = WSP(bf16_t, WS_BR); J.Bt = WSP(bf16_t, WS_WB); J.M = last ? ML : MT; J.N = 1024; J.K = 1024; J.rot = 0;
                    J.E.mode = E_BRANCH; J.E.out = WSP(bf16_t, WS_H); J.E.p1 = WSP(bf16_t, WS_P); J.E.aux = 0; J.E.row_base = 0; }
            } else if (kind == 6 || kind == 9) {
                if (j == 0 || (j == 1 && !last)) { have = true;
                    const bool dn = (kind == 9);
                    const bf16_t* Abase = dn ? WSP(bf16_t, WS_P) : WSP(bf16_t, WS_H);
                    J.lda = dn ? DFF : 1024; J.ldb = J.lda; J.K = J.lda;
                    J.A = Abase + (j ? (size_t)ML * J.lda : 0);
                    J.Bt = dn ? WSP(bf16_t, (l ? WS_WD1 : WS_WD0)) : WSP(bf16_t, WS_WOUT);
                    J.M = j ? MC : ML; J.N = 1024; if (j == 0) J.rot = 0;
                    J.E.mode = E_RESID; J.E.ctx = j; J.E.p2 = mod + (dn ? 5120 : 2048);
                    const float* xin_l = (!dn && l == 0) ? args.in[I_X] : XL; const float* xin_c = (!dn && l == 0) ? args.in[I_CTX] : WSP(float, WS_XC);
                    J.E.p1 = j ? xin_c : xin_l; J.E.out = j ? (void*)WSP(float, WS_XC) : (void*)XL; }
            } else if (kind == 8) {
                if (j == 0) { have = true; J.A = WSP(bf16_t, WS_BR); J.Bt = WSP(bf16_t, (l ? WS_WGU1 : WS_WGU0)); J.M = last ? ML : MT; J.N = 2 * DFF; J.rot = 0;
                    J.E.mode = E_GU; J.E.out = WSP(bf16_t, WS_P); J.E.row_base = 0; }
            }
            if (!have) { if (kind == 4) continue; break; }
            REFRESH_LANE();
            gemm_call(F, J);
        }
        if (!last && kind == 2) {
            const int nskip = (F.G > 64) ? 24 : 0;
            if (F.bx >= nskip) {
                const int pidx = F.bx - nskip, pcnt = F.G - nskip;
                REFRESH_LANE();
                { LAS float* ctw = (LAS float*)(F.lds + LDS_COSTAB);
                  for (int i = F.tid; i < 2048; i += 512) ctw[i] = cospif((float)i * (1.0f / 1024.0f));
                  __syncthreads(); }
            {
              const LAS float* ct = (const LAS float*)(F.lds + LDS_COSTAB);
              bf16_t* DFT = WSP(bf16_t, WS_DFT); bf16_t* DFT256 = WSP(bf16_t, WS_DFT256);
              const int gt = pidx * 512 + F.tid, NGT = pcnt * 512;
              for (int q = gt; q < 2048 * 512; q += NGT) { const int k = q >> 9, c8 = (q & 511) * 8; unsigned w[4];
#pragma unroll
                  for (int e = 0; e < 8; e += 2) { float v[2];
#pragma unroll
                      for (int z = 0; z < 2; ++z) { const int np = c8 + e + z; v[z] = np < 2048 ? ct[(k * np) & 2047] : -ct[((k * (np - 2048)) + 1536) & 2047]; }
                      w[e >> 1] = pk2(v[0], v[1]); }
                  *(u32x4*)(DFT + (size_t)k * 4096 + c8) = (u32x4){w[0], w[1], w[2], w[3]}; }
              for (int q = gt; q < 256 * 64; q += NGT) { const int k = q >> 6, c8 = (q & 63) * 8; unsigned w[4];
#pragma unroll
                  for (int e = 0; e < 8; e += 2) { float v[2];
#pragma unroll
                      for (int z = 0; z < 2; ++z) { const int np = c8 + e + z; v[z] = np < 256 ? ct[(((k * np) & 255) * 8) & 2047] : -ct[((((k * (np - 256)) & 255) * 8) + 1536) & 2047]; }
                      w[e >> 1] = pk2(v[0], v[1]); }
                  *(u32x4*)(DFT256 + (size_t)k * 512 + c8) = (u32x4){w[0], w[1], w[2], w[3]}; } }
                __syncthreads();
                REFRESH_LANE();
                conv_setA(F, args, 0, pidx, pcnt, 2);
            }
        }
        if (!last && (kind == 6 || kind == 9)) {
            const int nskip = (F.G > 64) ? 32 : 0;
            if (F.bx >= nskip) {
                const int pidx = F.bx - nskip, pcnt = F.G - nskip;
                if (kind == 6) { REFRESH_LANE(); conv_setB(F, args, 0, pidx, pcnt); }
                else {
                    LAS float* ct = (LAS float*)(F.lds + LDS_COSTAB);
                    REFRESH_LANE();
                    for (int i = F.tid; i < 2048; i += 512) ct[i] = cospif((float)i * (1.0f / 1024.0f));
                    __syncthreads();
                    conv_setA(F, args, 1, pidx, pcnt, 3);
                    REFRESH_LANE();
                    conv_setB(F, args, 1, pidx, pcnt);
                }
            }
        }
        if (kind == 3) {
            REFRESH_LANE();
            const bf16_t* P = WSP(bf16_t, WS_P); bf16_t* BR = WSP(bf16_t, WS_BR);
            const float* cw = args.in[I_CONVW] + l * 768; const float* cb_ = args.in[I_CONVB] + l * 256;
            const int nrows = last ? ML : MT, gt = F.vcu * 512 + F.tid, NGT = F.G * 512;
            for (int idx = gt; idx < nrows * 32; idx += NGT) {
                const int row = idx >> 5, c8 = (idx & 31) * 8;
                const int L = row < ML ? SEQ : CTXL, t = row < ML ? (row & (SEQ - 1)) : ((row - ML) & (CTXL - 1));
                const bf16_t* pr = P + (size_t)row * LDP;
                const u32x4 cbv = *(const u32x4*)(pr + PCB + c8), c0 = *(const u32x4*)(pr + PCC + c8), x0 = *(const u32x4*)(pr + PCX + c8);
                u32x4 cm = (u32x4){0, 0, 0, 0}, xm = cm, cp = cm, xp = cm;
                if (t > 0) { cm = *(const u32x4*)(pr - LDP + PCC + c8); xm = *(const u32x4*)(pr - LDP + PCX + c8); }
                if (t < L - 1) { cp = *(const u32x4*)(pr + LDP + PCC + c8); xp = *(const u32x4*)(pr + LDP + PCX + c8); }
                unsigned ow[4];
#pragma unroll
                for (int e = 0; e < 4; ++e) {
                    const int c = c8 + 2 * e;
                    const float zl = bflo(c0[e]) * bflo(x0[e]), zh = bfhi(c0[e]) * bfhi(x0[e]);
                    const float ml = bflo(cm[e]) * bflo(xm[e]), mh = bfhi(cm[e]) * bfhi(xm[e]);
                    const float pl = bflo(cp[e]) * bflo(xp[e]), phh = bfhi(cp[e]) * bfhi(xp[e]);
                    const float vl = bflo(cbv[e]) * (cw[c] * ml + cw[256 + c] * zl + cw[512 + c] * pl + cb_[c]);
                    const float vh = bfhi(cbv[e]) * (cw[c + 1] * mh + cw[256 + c + 1] * zh + cw[512 + c + 1] * phh + cb_[c + 1]);
                    ow[e] = cvt_pk_bf16(vl, vh);
                }
                *(u32x4*)(BR + (size_t)row * 1024 + 256 + c8) = (u32x4){ow[0], ow[1], ow[2], ow[3]};
            }
        }
        const bool dup_again = (rep == 0) && (((DUP_MASK) >> kind) & 1);
        if (ph + 1 < args.ph_hi || dup_again) {
            if (args.ph_hi > 1000) cg::this_grid().sync();
            { XcdBarrier xbar; xbar.bar = (unsigned*)(ws + WS_BAR); xbar.x = xb_xcc_id(); xbar.st = (volatile LAS unsigned*)(F.lds + LDS_XB); xcd_barrier(xbar); }
        }
        if (dup_again) rep = 1; else { rep = 0; ++ph; }
    }
#undef WSP
}


#ifndef DBG_STOP
#define DBG_STOP N_PHASES
#endif
#ifndef DBG_DUMP
#define DBG_DUMP 0
#endif
__global__ void dbg_dump(const bf16_t* src, float* out, size_t n) {
    for (size_t i = (size_t)blockIdx.x * blockDim.x + threadIdx.x; i < n; i += (size_t)gridDim.x * blockDim.x) out[i] = __uint_as_float(((unsigned)src[i]) << 16);
}
extern "C" void kernel_launch(void* const* d_in, const int* in_sizes, int n_in, void* d_out, int out_size, void* d_ws, size_t ws_size, hipStream_t stream) {
    static int grid = 0;
    if (grid == 0) {
        if (n_in != 25 || in_sizes[0] != ML * D || out_size != ML * D || ws_size < WS_END) { fprintf(stderr, "kernel_launch: unexpected shapes (n_in %d, in0 %d, out %d, ws %zu)\n", n_in, n_in > 0 ? in_sizes[0] : -1, out_size, ws_size); grid = -1; return; }
        int dev = 0, cus = 0, per_cu = 0;
        hipGetDevice(&dev); hipDeviceGetAttribute(&cus, hipDeviceAttributeMultiprocessorCount, dev);
        if (hipFuncSetAttribute((const void*)fwd_kernel, hipFuncAttributeMaxDynamicSharedMemorySize, LDS_BYTES) != hipSuccess) { fprintf(stderr, "kernel_launch: hipFuncSetAttribute failed\n"); grid = -1; return; }
        if (hipOccupancyMaxActiveBlocksPerMultiprocessor(&per_cu, (const void*)fwd_kernel, 512, LDS_BYTES) != hipSuccess || per_cu < 1) { fprintf(stderr, "kernel_launch: occupancy query says %d\n", per_cu); per_cu = 1; }
        (void)hipGetLastError();
        grid = cus * 1;
        if (grid <= 0) grid = 256;
    }
    if (grid < 0) return;
    if (hipMemsetAsync((unsigned char*)d_ws + WS_BAR, 0, 16384, stream) != hipSuccess) { fprintf(stderr, "kernel_launch: memset failed\n"); return; }
    Args a{};
    for (int i = 0; i < 25; ++i) a.in[i] = (const float*)d_in[i];
    a.out = (float*)d_out; a.ws = (unsigned char*)d_ws;
#if MK_MULTI_LAUNCH
    for (int p = 0; p < DBG_STOP; ++p) {
        a.ph_lo = p; a.ph_hi = p + 1;
        hipLaunchKernelGGL(fwd_kernel, dim3(grid), dim3(512), LDS_BYTES, stream, a);
    }
#else
    a.ph_lo = 0; a.ph_hi = DBG_STOP;
    void* kargs[] = {&a};
    hipError_t e = hipLaunchCooperativeKernel((const void*)fwd_kernel, dim3(grid), dim3(512), kargs, LDS_BYTES, stream);
    if (e != hipSuccess) fprintf(stderr, "kernel_launch: cooperative launch failed: %s (grid %d)\n", hipGetErrorString(e), grid);
#endif
#if DBG_DUMP
    { const size_t off = DBG_DUMP == 1 ? WS_H : (DBG_DUMP == 2 ? WS_BR : (DBG_DUMP == 3 ? WS_P : WS_FT0));
      hipLaunchKernelGGL(dbg_dump, dim3(2048), dim3(256), 0, stream, (const bf16_t*)((unsigned char*)d_ws + off), (float*)d_out, (size_t)(DBG_DUMP == 4 ? 8 : 16) * 1024 * 1024); }
#endif
}
```

```cpp
#include <hip/hip_runtime.h>
#include <hip/hip_cooperative_groups.h>
#include <cstdio>
#include <cstdint>
namespace cg = cooperative_groups;

#ifndef PROBE_ATT
#define PROBE_ATT 0
#endif
#ifndef PROBE_FOUR
#define PROBE_FOUR 0
#endif
#ifndef DUP_MASK
#define DUP_MASK 0
#endif
#ifndef MK_MULTI_LAUNCH
#define MK_MULTI_LAUNCH 0
#endif

#define LAS __attribute__((address_space(3)))
#define GAS __attribute__((address_space(1)))
typedef unsigned short bf16_t;
typedef short bf16x8 __attribute__((ext_vector_type(8)));
typedef short s16x4 __attribute__((ext_vector_type(4)));
typedef float f32x4 __attribute__((ext_vector_type(4)));
typedef float f32x16 __attribute__((ext_vector_type(16)));
typedef unsigned u32x4 __attribute__((ext_vector_type(4)));
typedef unsigned u32x2 __attribute__((ext_vector_type(2)));

constexpr int D = 1024, NB = 8, SEQ = 2048, CTXL = 256, DFF = 2816;
constexpr int ML = NB * SEQ;
constexpr int MC = NB * CTXL;
constexpr int MT = ML + MC;
constexpr int DIN = 5632;
constexpr int NIN = 5888;
constexpr int NP1 = 2816;
constexpr int LDP = 2304;
constexpr int PCB = 0, PCC = 256, PCX = 512, PQ = 768, PK = 1280, PV = 1792;
constexpr float QSCALE = 0.125f * 1.4426950408889634f;
constexpr float EPS = 1e-6f;

constexpr size_t MiB = 1u << 20;
constexpr size_t WS_MOD = 0;
constexpr size_t WS_ROPE = 448 * 1024;
constexpr size_t WS_BIASIN = 464 * 1024;
constexpr size_t WS_LAM = 1020 * 1024;
constexpr size_t WS_DFT256 = 1 * MiB;
constexpr size_t WS_DFT = 2 * MiB;
constexpr size_t WS_XC = 18 * MiB;
constexpr size_t WS_WIN = 26 * MiB;
constexpr size_t WS_WB = WS_WIN + 5888 * 1024 * 2;
constexpr size_t WS_WOUT = WS_WB + 2 * MiB;
constexpr size_t WS_WGU0 = WS_WOUT + 2 * MiB;
constexpr size_t WS_WD0 = WS_WGU0 + 11 * MiB;
constexpr size_t WS_WGU1 = WS_WD0 + 5632 * 1024;
constexpr size_t WS_WD1 = WS_WGU1 + 11 * MiB;
constexpr size_t WS_H = 75 * MiB;
constexpr size_t WS_BR = 111 * MiB;
constexpr size_t WS_P = 147 * MiB;
constexpr size_t WS_FT0 = WS_WGU1, WS_FT1 = WS_WGU0, WS_FTC = WS_XC;
constexpr size_t WS_BAR = 255 * MiB;
constexpr size_t WS_END = 255 * MiB + 65536;
static_assert(WS_WD1 + 5632 * 1024 <= WS_H && WS_FT0 + 16 * MiB <= WS_H && WS_FT1 + 16 * MiB <= WS_WGU1, "ws map");
static_assert((size_t)MT * LDP * 2 <= 81 * MiB && (size_t)MT * 3072 * 2 <= 108 * MiB, "ws map");

constexpr int LDS_BYTES = 147456;
constexpr int LDS_XB = 144384;
constexpr int LDS_COSTAB = 131072;

typedef float f32x2_t __attribute__((ext_vector_type(2))); typedef __bf16 bf16x2_t __attribute__((ext_vector_type(2)));
__device__ __forceinline__ unsigned cvt_pk_bf16(float lo, float hi) { f32x2_t v = {lo, hi}; bf16x2_t b = __builtin_convertvector(v, bf16x2_t); return __builtin_bit_cast(unsigned, b); }
__device__ __forceinline__ unsigned f2bf(float f) { unsigned u = __float_as_uint(f); return (u + 0x7fffu + ((u >> 16) & 1u)) >> 16; }
__device__ __forceinline__ unsigned pk2(float lo, float hi) { return f2bf(lo) | (f2bf(hi) << 16); }
__device__ __forceinline__ float bflo(unsigned w) { return __uint_as_float(w << 16); }
__device__ __forceinline__ float bfhi(unsigned w) { return __uint_as_float(w & 0xffff0000u); }
__device__ __forceinline__ float fast_exp2(float x) { return __builtin_amdgcn_exp2f(x); }
__device__ __forceinline__ float fast_rcp(float x) { return __builtin_amdgcn_rcpf(x); }
__device__ __forceinline__ float sigmoidf_(float x) { return fast_rcp(1.0f + fast_exp2(-1.4426950408889634f * x)); }
__device__ __forceinline__ float wave_sum(float v) {
#pragma unroll
    for (int o = 1; o < 64; o <<= 1) v += __shfl_xor(v, o);
    return v;
}

namespace pg8 {
constexpr int BM = 256, BK = 64, HALF = 128, HTB = HALF * BK * 2, STAGE_BYTES = 8 * HTB, NXCD = 8, WGM = 4;
__host__ __device__ __forceinline__ int lds_byte(int r, int c) { const int st = (r >> 4) * 2 + (c >> 5), rr = r & 15, cc = c & 31, ob = rr * 64 + cc * 2; return st * 1024 + (ob ^ (((ob >> 9) & 1) << 5)); }
__host__ __device__ __forceinline__ void stage_rc(int b, int& R, int& C) { const int st = b / 1024, sb = b % 1024, swz = sb ^ (((sb >> 9) & 1) << 5); R = (st >> 1) * 16 + swz / 64; C = (st & 1) * 32 + (swz % 64) / 2; }
__host__ __device__ __forceinline__ int perm32(int rho) { const int n = rho >> 4, i = rho & 15; return 8 * (i >> 2) + 4 * n + (i & 3); }
struct Unit { int pm, pn; };
struct Gemm { const bf16_t* A; const bf16_t* Bt; int M, N, K, lda, ldb; };
struct StaticOrder {
    int nM, nN, nwg, G, c;
    __device__ void init(int M, int N, int G_, int c_) { nM = M / BM; nN = N / BM; nwg = nM * nN; G = G_; c = c_; }
    __device__ bool next(int i, Unit& u) const {
        const long L = (long)i * G + c; if (L >= nwg) return false;
        int wgid = (int)L; { const int q = nwg / NXCD, r = nwg % NXCD, xcd = wgid % NXCD, off = wgid / NXCD; wgid = (xcd < r ? xcd * (q + 1) : r * (q + 1) + (xcd - r) * q) + off; }
        const int nig = WGM * nN, gid = wgid / nig, fm = gid * WGM, gsz = (nM - fm) < WGM ? (nM - fm) : WGM;
        u.pm = fm + ((wgid % nig) % gsz); u.pn = (wgid % nig) / gsz; return true;
    }
};

template <class Epi, class Sched>
__device__ __forceinline__ void gemm_phase(LAS unsigned char* lds, const Gemm g, const Sched& S, const Epi& E, const int tid) {
    const int wid = __builtin_amdgcn_readfirstlane(tid >> 6), lane = tid & 63, wr = wid >> 2, wc = wid & 3, fr = lane & 15, fq = lane >> 4;
    const int K = g.K, nt = K / BK;
    unsigned voffA[2], voffB[2];
#pragma unroll
    for (int i = 0; i < 2; ++i) { int R, C; stage_rc(tid * 16 + i * 8192, R, C); const int Rb = (R & ~31) + perm32(R & 31);
        voffA[i] = (unsigned)(R * g.lda + C) * 2u; voffB[i] = (unsigned)(Rb * g.ldb + C) * 2u; }
    const size_t kstep = (size_t)(BK * 2);
    const size_t hA = (size_t)HALF * g.lda * 2, hB = (size_t)HALF * g.ldb * 2;
    const size_t tA = 2 * hA, tB = 2 * hB;
    const unsigned ldsw = (unsigned)wid * 1024u;
    const int aoff = lds_byte(wr * 64 + fr, fq * 8), boff = lds_byte(wc * 32 + fr, fq * 8);
#define PG8_SA(b, h) (((b) * 2 + (h)) * HTB)
#define PG8_SB(b, h) ((4 + (b) * 2 + (h)) * HTB)
#define PG8_STAGE(bufoff, gbase, voff) do { _Pragma("unroll") for (int _i = 0; _i < 2; ++_i) \
        __builtin_amdgcn_global_load_lds((const unsigned*)((const char*)(gbase) + (voff)[_i]), (LAS unsigned*)(lds + (bufoff) + ldsw + _i * 8192), 16, 0, 0); } while (0)
#define PG8_LDA(dst, b, h) do { _Pragma("unroll") for (int m = 0; m < 4; ++m) _Pragma("unroll") for (int k = 0; k < 2; ++k) dst[m][k] = *(const LAS bf16x8*)(lds + PG8_SA(b, h) + aoff + m * 2048 + k * 1024); } while (0)
#define PG8_LDB(dst, b, h) do { _Pragma("unroll") for (int n = 0; n < 2; ++n) _Pragma("unroll") for (int k = 0; k < 2; ++k) dst[n][k] = *(const LAS bf16x8*)(lds + PG8_SB(b, h) + boff + n * 2048 + k * 1024); } while (0)
#define PG8_MMA(ai, bj, At, Bt) do { __builtin_amdgcn_s_setprio(1); _Pragma("unroll") for (int m = 0; m < 4; ++m) _Pragma("unroll") for (int n = 0; n < 2; ++n) _Pragma("unroll") for (int k = 0; k < 2; ++k) \
        acc[ai][bj][m][n] = __builtin_amdgcn_mfma_f32_16x16x32_bf16(Bt[n][k], At[m][k], acc[ai][bj][m][n], 0, 0, 0); __builtin_amdgcn_s_setprio(0); } while (0)
#define PG8_WAIT_V(n) asm volatile("s_waitcnt vmcnt(" #n ")" ::: "memory")
#define PG8_WAIT_L(n) asm volatile("s_waitcnt lgkmcnt(" #n ")" ::: "memory")
#define PG8_BAR __builtin_amdgcn_s_barrier()
#define PG8_SCHED __builtin_amdgcn_sched_barrier(0)
    Unit cur, nxt; int ui = 0;
    if (!S.next(0, cur)) return;
    const bool hz = E.horner();
    f32x4 acc[2][2][4][2];
#pragma unroll
    for (int a = 0; a < 2; ++a)
#pragma unroll
        for (int b = 0; b < 2; ++b)
#pragma unroll
            for (int m = 0; m < 4; ++m)
#pragma unroll
                for (int n = 0; n < 2; ++n) acc[a][b][m][n] = (f32x4){0.f, 0.f, 0.f, 0.f};
    bf16x8 At[4][2], B0[2][2], B1[2][2];
    const char* cA = (const char*)g.A + (size_t)cur.pm * tA; const char* cB = (const char*)g.Bt + (size_t)cur.pn * tB;
    PG8_STAGE(PG8_SB(0, 0), cB, voffB); PG8_STAGE(PG8_SB(0, 1), cB + hB, voffB); PG8_STAGE(PG8_SA(0, 0), cA, voffA); PG8_STAGE(PG8_SA(0, 1), cA + hA, voffA);
    if (wr == 1) PG8_BAR;
    PG8_WAIT_V(2); PG8_BAR;
    PG8_STAGE(PG8_SB(1, 0), cB + kstep, voffB); PG8_STAGE(PG8_SA(1, 0), cA + kstep, voffA); PG8_STAGE(PG8_SB(1, 1), cB + hB + kstep, voffB);
    PG8_WAIT_V(6); PG8_BAR;
    for (;;) {
        const bool has_next = S.next(ui + 1, nxt);
        const char* nA = has_next ? (const char*)g.A + (size_t)nxt.pm * tA : cA; const char* nB = has_next ? (const char*)g.Bt + (size_t)nxt.pn * tB : cB;
        for (int t = 0; t < nt; t += 2) {
            if (hz && (t == 4 || t == 8)) E.mid(acc, cur, t >> 3, wr, wc, fr, fq);
            const bool last = (t == nt - 2);
            const char* a1 = cA + (size_t)(t + 1) * kstep;
            const char* a2 = last ? nA : cA + (size_t)(t + 2) * kstep; const char* b2 = last ? nB : cB + (size_t)(t + 2) * kstep;
            const char* a3 = a2 + kstep; const char* b3 = b2 + kstep;
            PG8_LDB(B0, 0, 0); PG8_LDB(B1, 0, 1); PG8_SCHED; PG8_LDA(At, 0, 0); PG8_STAGE(PG8_SA(1, 1), a1 + hA, voffA);
            PG8_WAIT_V(8); PG8_WAIT_L(0); PG8_BAR; PG8_MMA(0, 0, At, B0); PG8_MMA(0, 1, At, B1); PG8_BAR; PG8_SCHED;
            PG8_LDA(At, 0, 1); PG8_STAGE(PG8_SB(0, 0), b2, voffB); PG8_STAGE(PG8_SB(0, 1), b2 + hB, voffB); PG8_STAGE(PG8_SA(0, 0), a2, voffA);
            PG8_WAIT_V(8); PG8_WAIT_L(0); PG8_BAR; PG8_MMA(1, 0, At, B0); PG8_MMA(1, 1, At, B1); PG8_BAR; PG8_SCHED;
            PG8_LDB(B0, 1, 0); PG8_LDB(B1, 1, 1); PG8_SCHED; PG8_LDA(At, 1, 0); PG8_STAGE(PG8_SA(0, 1), a2 + hA, voffA);
            PG8_WAIT_V(8); PG8_WAIT_L(0); PG8_BAR; PG8_MMA(0, 0, At, B0); PG8_MMA(0, 1, At, B1); PG8_BAR; PG8_SCHED;
            PG8_LDA(At, 1, 1); PG8_STAGE(PG8_SB(1, 0), b3, voffB); PG8_STAGE(PG8_SB(1, 1), b3 + hB, voffB); PG8_STAGE(PG8_SA(1, 0), a3, voffA);
            PG8_WAIT_V(8); PG8_WAIT_L(0); PG8_BAR; PG8_MMA(1, 0, At, B0); PG8_MMA(1, 1, At, B1); PG8_BAR; PG8_SCHED;
        }
        if (wr == 0) PG8_BAR;
        E(acc, cur, wr, wc, fr, fq);
        if (!has_next) break;
#pragma unroll
        for (int a = 0; a < 2; ++a)
#pragma unroll
            for (int b = 0; b < 2; ++b)
#pragma unroll
                for (int m = 0; m < 4; ++m)
#pragma unroll
                    for (int n = 0; n < 2; ++n) acc[a][b][m][n] = (f32x4){0.f, 0.f, 0.f, 0.f};
        cur = nxt; cA = nA; cB = nB; ++ui;
        if (wr == 1) PG8_BAR;
    }
    PG8_WAIT_V(0);
    PG8_BAR;
#undef PG8_SA
#undef PG8_SB
#undef PG8_STAGE
#undef PG8_LDA
#undef PG8_LDB
#undef PG8_MMA
#undef PG8_WAIT_V
#undef PG8_WAIT_L
#undef PG8_BAR
#undef PG8_SCHED
}
}

enum { E_INPROJ = 0, E_GATE = 1, E_BRANCH = 2, E_RESID = 3, E_GU = 4, E_FOUR = 5 };
constexpr int LDS_EPI = 143360;
struct EpiD {
    int mode;
    int row_base;
    int ctx;
    int aux;
    float scale;
    int pad;
    void* out;
    const void* p1;
    const void* p2;
    void* p3; void* p4;
};
#define RFL2(x) ((unsigned)__builtin_amdgcn_readfirstlane((int)(x)))
struct Epi {
    const LAS unsigned* ed;
    __device__ __forceinline__ bool horner() const { return __builtin_amdgcn_readfirstlane((int)ed[0]) == E_BRANCH; }
    __device__ __forceinline__ void mid(f32x4 (&acc)[2][2][4][2], const pg8::Unit& u, int which, int wr, int wc, int fr, int fq) const {
        asm volatile("" : "+v"(fr), "+v"(fq));
        const int row_base = __builtin_amdgcn_readfirstlane((int)ed[1]);
        const unsigned lo = (unsigned)__builtin_amdgcn_readfirstlane((int)ed[8]), hi_ = (unsigned)__builtin_amdgcn_readfirstlane((int)ed[9]);
        const bf16_t* gbase = (const bf16_t*)(((unsigned long long)hi_ << 32) | lo) + (size_t)(row_base + u.pm * 256 + wr * 64 + fr) * 3072 + which * 1024 + u.pn * 256 + wc * 32 + 8 * fq;
#pragma unroll
        for (int ai = 0; ai < 2; ++ai) {
            u32x4 na[4][2], nb[4][2];
#pragma unroll
            for (int m = 0; m < 4; ++m)
#pragma unroll
                for (int bj = 0; bj < 2; ++bj) { const bf16_t* gp = gbase + (size_t)(ai * 128 + m * 16) * 3072 + bj * 128; na[m][bj] = *(const GAS u32x4*)gp; nb[m][bj] = *(const GAS u32x4*)(gp + 1024); }
            __builtin_amdgcn_sched_barrier(0);
#pragma unroll
            for (int m = 0; m < 4; ++m)
#pragma unroll
                for (int bj = 0; bj < 2; ++bj) {
                    const u32x4 xa = na[m][bj], xb = nb[m][bj];
                    f32x4 r0, r1;
                    r0[0] = bflo(xa.x) * fast_rcp(bflo(xb.x)); r0[1] = bfhi(xa.x) * fast_rcp(bfhi(xb.x)); r0[2] = bflo(xa.y) * fast_rcp(bflo(xb.y)); r0[3] = bfhi(xa.y) * fast_rcp(bfhi(xb.y));
                    r1[0] = bflo(xa.z) * fast_rcp(bflo(xb.z)); r1[1] = bfhi(xa.z) * fast_rcp(bfhi(xb.z)); r1[2] = bflo(xa.w) * fast_rcp(bflo(xb.w)); r1[3] = bfhi(xa.w) * fast_rcp(bfhi(xb.w));
                    acc[ai][bj][m][0] = acc[ai][bj][m][0] * r0; acc[ai][bj][m][1] = acc[ai][bj][m][1] * r1;
                }
            __builtin_amdgcn_sched_barrier(0);
        }
    }
    __device__ __forceinline__ void operator()(const f32x4 (&acc)[2][2][4][2], const pg8::Unit& u, int wr, int wc, int fr, int fq) const {
        asm volatile("" : "+v"(fr), "+v"(fq));
#define RFL(x) ((unsigned)__builtin_amdgcn_readfirstlane((int)(x)))
        const int mode = (int)RFL(ed[0]), row_base = (int)RFL(ed[1]), ctx = (int)RFL(ed[2]), aux = (int)RFL(ed[3]);
        const float scale = __uint_as_float(RFL(ed[4]));
        void* const out = (void*)(((unsigned long long)RFL(ed[7]) << 32) | RFL(ed[6]));
        const void* const p1 = (const void*)(((unsigned long long)RFL(ed[9]) << 32) | RFL(ed[8]));
        const void* const p2 = (const void*)(((unsigned long long)RFL(ed[11]) << 32) | RFL(ed[10]));
#undef RFL
        const int r0 = u.pm * 256 + wr * 64 + fr;
        const int c0 = wc * 32 + 8 * fq;
        const int colt = u.pn * 256;
        if (mode == E_INPROJ) {
            const int ct = aux + u.pn;
            const float* bias = (const float*)p1;
            if (ct < 2) {
                const int gpm = (row_base >> 8) + u.pm;
                bf16_t* dst; int ld, n0;
                if (ctx) { const int b = gpm - 64; dst = (bf16_t*)(((unsigned long long)RFL2(ed[15]) << 32) | RFL2(ed[14])) + (size_t)(b * 256) * 512 + ct * 256; ld = 512; n0 = 0; }
                else { const int b = gpm >> 3; dst = (bf16_t*)(((unsigned long long)RFL2(ed[13]) << 32) | RFL2(ed[12])) + (size_t)(b * 256) * 4096 + ct * 2048; ld = 4096; n0 = (gpm & 7) * 256; }
                LAS unsigned char* stg = (LAS unsigned char*)ed - LDS_EPI + 131072 + (wr * 4 + wc) * 1536;
                const int lane_ = fq * 16 + fr, tcol = lane_ >> 1, thalf = lane_ & 1;
#pragma unroll
                for (int bj = 0; bj < 2; ++bj) {
                    const f32x4 b0 = *(const GAS f32x4*)(bias + colt + bj * 128 + c0), b1 = *(const GAS f32x4*)(bias + colt + bj * 128 + c0 + 4);
                    bf16_t* dcol = dst + (size_t)(bj * 128 + wc * 32 + tcol) * ld + n0 + wr * 64 + thalf * 8;
#pragma unroll
                    for (int ai = 0; ai < 2; ++ai)
#pragma unroll
                        for (int m = 0; m < 4; ++m) {
                            const f32x4 v0 = acc[ai][bj][m][0] + b0, v1 = acc[ai][bj][m][1] + b1;
                            LAS bf16_t* sp = (LAS bf16_t*)stg + (fq * 8) * 16 + fr;
                            sp[0 * 16] = (bf16_t)f2bf(v0[0]); sp[1 * 16] = (bf16_t)f2bf(v0[1]); sp[2 * 16] = (bf16_t)f2bf(v0[2]); sp[3 * 16] = (bf16_t)f2bf(v0[3]);
                            sp[4 * 16] = (bf16_t)f2bf(v1[0]); sp[5 * 16] = (bf16_t)f2bf(v1[1]); sp[6 * 16] = (bf16_t)f2bf(v1[2]); sp[7 * 16] = (bf16_t)f2bf(v1[3]);
                            asm volatile("s_waitcnt lgkmcnt(0)" ::: "memory");
                            const u32x4 w = *(const LAS u32x4*)(stg + tcol * 32 + thalf * 16);
                            *(GAS u32x4*)(dcol + ai * 128 + m * 16) = w;
                            asm volatile("s_waitcnt lgkmcnt(0)" ::: "memory");
                        }
                }
            } else {
                const bool isqk = (ct >= 5 && ct <= 8), dorope = isqk && !ctx;
                const float sc = (ct == 5 || ct == 6) ? QSCALE : 1.0f;
                const int axis = wc & 1, half = fq >> 1;
                const float* rope = (const float*)p2 + 8 * (fq & 1);
                bf16_t* obase = (bf16_t*)out + (size_t)(row_base + r0) * LDP + (ct - 2) * 256 + c0;
#pragma unroll
                for (int bj = 0; bj < 2; ++bj) {
                    const f32x4 b0 = *(const GAS f32x4*)(bias + colt + bj * 128 + c0), b1 = *(const GAS f32x4*)(bias + colt + bj * 128 + c0 + 4);
#pragma unroll
                    for (int ai = 0; ai < 2; ++ai)
#pragma unroll
                        for (int m = 0; m < 4; ++m) {
                            f32x4 v0 = acc[ai][bj][m][0] + b0, v1 = acc[ai][bj][m][1] + b1;
                            if (dorope) {
                                const int t = (row_base + r0 + ai * 128 + m * 16) & 2047, pos = axis ? (t & 63) : (t >> 6);
                                const float* cp = rope + pos * 16;
                                const f32x4 cs0 = *(const GAS f32x4*)cp, cs1 = *(const GAS f32x4*)(cp + 4), sn0 = *(const GAS f32x4*)(cp + 1024), sn1 = *(const GAS f32x4*)(cp + 1028);
                                f32x4 w0, w1;
#pragma unroll
                                for (int j = 0; j < 4; ++j) { w0[j] = __shfl_xor(v0[j], 32); w1[j] = __shfl_xor(v1[j], 32); }
                                if (half) { v0 = v0 * cs0 + w0 * sn0; v1 = v1 * cs1 + w1 * sn1; }
                                else { v0 = v0 * cs0 - w0 * sn0; v1 = v1 * cs1 - w1 * sn1; }
                            }
                            v0 = v0 * sc; v1 = v1 * sc;
                            u32x4 w; w.x = cvt_pk_bf16(v0[0], v0[1]); w.y = cvt_pk_bf16(v0[2], v0[3]); w.z = cvt_pk_bf16(v1[0], v1[1]); w.w = cvt_pk_bf16(v1[2], v1[3]);
                            *(GAS u32x4*)(obase + (size_t)(ai * 128 + m * 16) * LDP + bj * 128) = w;
                        }
                }
            }
        } else if (mode == E_GATE) {
            const float* bias = (const float*)p1;
            bf16_t* obase = (bf16_t*)out + (size_t)(row_base + r0) * 3072 + colt + c0;
#pragma unroll
            for (int bj = 0; bj < 2; ++bj) {
                const f32x4 b0 = *(const GAS f32x4*)(bias + colt + bj * 128 + c0), b1 = *(const GAS f32x4*)(bias + colt + bj * 128 + c0 + 4);
#pragma unroll
                for (int ai = 0; ai < 2; ++ai)
#pragma unroll
                    for (int m = 0; m < 4; ++m) {
                        f32x4 v0 = acc[ai][bj][m][0] + b0, v1 = acc[ai][bj][m][1] + b1;
#pragma unroll
                        for (int j = 0; j < 4; ++j) { v0[j] = fmaxf(sigmoidf_(v0[j]), 1e-18f); v1[j] = fmaxf(sigmoidf_(v1[j]), 1e-18f); }
                        u32x4 w; w.x = cvt_pk_bf16(v0[0], v0[1]); w.y = cvt_pk_bf16(v0[2], v0[3]); w.z = cvt_pk_bf16(v1[0], v1[1]); w.w = cvt_pk_bf16(v1[2], v1[3]);
                        *(GAS u32x4*)(obase + (size_t)(ai * 128 + m * 16) * 3072 + bj * 128) = w;
                    }
            }
        } else if (mode == E_BRANCH) {
            const bf16_t* gbase = (const bf16_t*)p1 + (size_t)(row_base + r0) * 3072 + 2048 + colt + c0;
            bf16_t* ybase = (bf16_t*)out + (size_t)(row_base + r0) * 1024 + colt + c0;
            u32x4 gw[2][4][2];
#pragma unroll
            for (int ai = 0; ai < 2; ++ai)
#pragma unroll
                for (int m = 0; m < 4; ++m)
#pragma unroll
                    for (int bj = 0; bj < 2; ++bj) gw[ai][m][bj] = *(const GAS u32x4*)(gbase + (size_t)(ai * 128 + m * 16) * 3072 + bj * 128);
            __builtin_amdgcn_sched_barrier(0);
#pragma unroll
            for (int ai = 0; ai < 2; ++ai)
#pragma unroll
                for (int m = 0; m < 4; ++m) {
#pragma unroll
                    for (int bj = 0; bj < 2; ++bj) {
                        const u32x4 g = gw[ai][m][bj];
                        const f32x4 g0 = (f32x4){bflo(g.x), bfhi(g.x), bflo(g.y), bfhi(g.y)}, g1 = (f32x4){bflo(g.z), bfhi(g.z), bflo(g.w), bfhi(g.w)};
                        const f32x4 y0 = g0 * acc[ai][bj][m][0], y1 = g1 * acc[ai][bj][m][1];
                        u32x4 w; w.x = cvt_pk_bf16(y0[0], y0[1]); w.y = cvt_pk_bf16(y0[2], y0[3]); w.z = cvt_pk_bf16(y1[0], y1[1]); w.w = cvt_pk_bf16(y1[2], y1[3]);
                        *(GAS u32x4*)(ybase + (size_t)(ai * 128 + m * 16) * 1024 + bj * 128) = w;
                    }
                }
        } else if (mode == E_RESID) {
            const float* xin = (const float*)p1 + (size_t)r0 * 1024 + colt + c0;
            float* xout = (float*)out + (size_t)r0 * 1024 + colt + c0;
            const int b = ctx ? 8 : (u.pm >> 3);
            const float* modg = (const float*)p2 + (size_t)b * 6144 + colt + c0;
            f32x4 gv[2][2];
#pragma unroll
            for (int bj = 0; bj < 2; ++bj) { gv[bj][0] = *(const GAS f32x4*)(modg + bj * 128); gv[bj][1] = *(const GAS f32x4*)(modg + bj * 128 + 4); }
#pragma unroll
            for (int ai = 0; ai < 2; ++ai) {
                f32x4 xv[4][2][2];
#pragma unroll
                for (int m = 0; m < 4; ++m)
#pragma unroll
                    for (int bj = 0; bj < 2; ++bj) { const float* xi = xin + (size_t)(ai * 128 + m * 16) * 1024 + bj * 128; xv[m][bj][0] = *(const GAS f32x4*)xi; xv[m][bj][1] = *(const GAS f32x4*)(xi + 4); }
                __builtin_amdgcn_sched_barrier(0);
#pragma unroll
                for (int m = 0; m < 4; ++m)
#pragma unroll
                    for (int bj = 0; bj < 2; ++bj) { float* xo = xout + (size_t)(ai * 128 + m * 16) * 1024 + bj * 128;
                        *(GAS f32x4*)xo = xv[m][bj][0] + gv[bj][0] * acc[ai][bj][m][0]; *(GAS f32x4*)(xo + 4) = xv[m][bj][1] + gv[bj][1] * acc[ai][bj][m][1]; }
                __builtin_amdgcn_sched_barrier(0);
            }
        } else if (mode == E_GU) {
            bf16_t* obase = (bf16_t*)out + (size_t)(row_base + r0) * DFF + u.pn * 128 + c0;
#pragma unroll
            for (int ai = 0; ai < 2; ++ai)
#pragma unroll
                for (int m = 0; m < 4; ++m) {
                    f32x4 v0, v1;
#pragma unroll
                    for (int j = 0; j < 4; ++j) { const float a = acc[ai][0][m][0][j], b = acc[ai][0][m][1][j];
                        v0[j] = a * sigmoidf_(a) * acc[ai][1][m][0][j]; v1[j] = b * sigmoidf_(b) * acc[ai][1][m][1][j]; }
                    u32x4 w; w.x = cvt_pk_bf16(v0[0], v0[1]); w.y = cvt_pk_bf16(v0[2], v0[3]); w.z = cvt_pk_bf16(v1[0], v1[1]); w.w = cvt_pk_bf16(v1[2], v1[3]);
                    *(GAS u32x4*)(obase + (size_t)(ai * 128 + m * 16) * DFF) = w;
                }
        } else {
            const int L = ctx ? CTXL : SEQ;
            bf16_t* obase = (bf16_t*)out + (size_t)(row_base + u.pn * L + r0) * 1024 + c0;
#pragma unroll
            for (int ai = 0; ai < 2; ++ai)
#pragma unroll
                for (int m = 0; m < 4; ++m) {
#pragma unroll
                    for (int bj = 0; bj < 2; ++bj) {
                        const f32x4 v0 = acc[ai][bj][m][0] * scale, v1 = acc[ai][bj][m][1] * scale;
                        u32x4 w; w.x = cvt_pk_bf16(v0[0], v0[1]); w.y = cvt_pk_bf16(v0[2], v0[3]); w.z = cvt_pk_bf16(v1[0], v1[1]); w.w = cvt_pk_bf16(v1[2], v1[3]);
                        *(GAS u32x4*)(obase + (size_t)(ai * 128 + m * 16) * 1024 + bj * 128) = w;
                    }
                }
        }
    }
};

struct Args {
    const float* in[25];
    float* out; unsigned char* ws;
    int ph_lo, ph_hi;
};
enum { I_X = 0, I_C, I_CTX, I_CCTX, I_WADA, I_BADA, I_N1G, I_N2G, I_WIN, I_BIN, I_CONVW, I_CONVB, I_WFO, I_WCO, I_WAO, I_LQ1, I_LK1, I_LQ2, I_LK2, I_SUBG, I_WOUT, I_WG, I_WU, I_WD, I_FING };

struct Frame {
    LAS unsigned char* lds;
    int tid, lane, wave, G, bx, vcu, rot;
};

struct GJob { const bf16_t* A; const bf16_t* Bt; int lda, ldb, M, N, K, rot; int gfirst, gsub; EpiD E; };
__device__ __forceinline__ void gemm_call(Frame& F, const GJob& j) {
    pg8::Gemm g{j.A, j.Bt, j.M, j.N, j.K, j.lda, j.ldb};
    if (j.rot >= 0) F.rot = j.rot % F.G;
    pg8::StaticOrder S; int c = F.bx - F.rot; if (c < 0) c += F.G;
    int Ge = F.G;
    if (j.gsub > 0) { Ge = j.gsub; c = F.bx - j.gfirst; if (c < 0 || c >= j.gsub) c = 1 << 28; }
    S.init(j.M, j.N, Ge, c);
    if (F.tid == 0) { LAS unsigned* d = (LAS unsigned*)(F.lds + LDS_EPI);
        const unsigned long long o_ = (unsigned long long)j.E.out, a_ = (unsigned long long)j.E.p1, b_ = (unsigned long long)j.E.p2;
        d[0] = (unsigned)j.E.mode; d[1] = (unsigned)j.E.row_base; d[2] = (unsigned)j.E.ctx; d[3] = (unsigned)j.E.aux; d[4] = __float_as_uint(j.E.scale); d[5] = 0u;
        d[6] = (unsigned)o_; d[7] = (unsigned)(o_ >> 32); d[8] = (unsigned)a_; d[9] = (unsigned)(a_ >> 32); d[10] = (unsigned)b_; d[11] = (unsigned)(b_ >> 32);
        const unsigned long long c_ = (unsigned long long)j.E.p3, e_ = (unsigned long long)j.E.p4; d[12] = (unsigned)c_; d[13] = (unsigned)(c_ >> 32); d[14] = (unsigned)e_; d[15] = (unsigned)(e_ >> 32); }
    __syncthreads();
    Epi E{(const LAS unsigned*)(F.lds + LDS_EPI)};
    pg8::gemm_phase<Epi, pg8::StaticOrder>(F.lds, g, S, E, F.tid);
    F.rot = (F.rot + (j.M / 256) * (j.N / 256)) % F.G;
}

__device__ __forceinline__ void tr_item(const float* src, int ldsrc, bf16_t* dst, int ldd, LAS float* scr, int lane) {
#pragma unroll 8
    for (int i = 0; i < 32; ++i) { const int kk = 2 * i + (lane >> 5); scr[kk * 33 + (lane & 31)] = src[(size_t)kk * ldsrc + (lane & 31)]; }
    asm volatile("s_waitcnt lgkmcnt(0)" ::: "memory");
    const int c = lane & 7;
#pragma unroll
    for (int j = 0; j < 4; ++j) { const int n = (lane >> 3) + 8 * j; const LAS float* s = scr + (8 * c) * 33 + n;
        u32x4 o; o.x = pk2(s[0 * 33], s[1 * 33]); o.y = pk2(s[2 * 33], s[3 * 33]); o.z = pk2(s[4 * 33], s[5 * 33]); o.w = pk2(s[6 * 33], s[7 * 33]);
        *(u32x4*)(dst + (size_t)n * ldd + 8 * c) = o; }
    asm volatile("s_waitcnt lgkmcnt(0)" ::: "memory");
}

__device__ __forceinline__ void conv_setA(Frame& F, const Args& a, int l, int pidx, int pcnt, int part) {
    unsigned char* ws = a.ws;
    bf16_t* Win = (bf16_t*)(ws + WS_WIN); bf16_t* Wb = (bf16_t*)(ws + WS_WB); bf16_t* Wout = (bf16_t*)(ws + WS_WOUT);
    const float* w_in = a.in[I_WIN] + (size_t)l * D * DIN;
    LAS float* scr = (LAS float*)(F.lds + F.wave * 16384);
    const int gw = pidx * 8 + F.wave, NGW = pcnt * 8;
    constexpr int I1 = 16 * 168, I2 = 128, I3 = 128, I4 = 256, I5 = 512;
    for (int it = gw; it < I1 + I2 + I3 + I4 + I5; it += NGW) {
        int r = it;
        if (r < I1) { const int kb = r / 168, nb = r % 168, k0 = kb * 64, n0 = 256 + nb * 32;
            if (!((part >> (nb >= 72 ? 1 : 0)) & 1)) continue;
            tr_item(w_in + (size_t)k0 * DIN + n0, DIN, Win + (size_t)(n0 + 256) * 1024 + k0, 1024, scr, F.lane); continue; } r -= I1;
        if (!(part & 2)) break;
        if (r < I2) { const int kb = r / 32, nb = r % 32; tr_item(a.in[I_WFO] + (size_t)l * 256 * D + (size_t)kb * 64 * D + nb * 32, D, Wb + (size_t)(nb * 32) * 1024 + kb * 64, 1024, scr, F.lane); continue; } r -= I2;
        if (r < I3) { const int kb = r / 32, nb = r % 32; tr_item(a.in[I_WCO] + (size_t)l * 256 * D + (size_t)kb * 64 * D + nb * 32, D, Wb + (size_t)(nb * 32) * 1024 + 256 + kb * 64, 1024, scr, F.lane); continue; } r -= I3;
        if (r < I4) { const int kb = r / 32, nb = r % 32; tr_item(a.in[I_WAO] + (size_t)l * 512 * D + (size_t)kb * 64 * D + nb * 32, D, Wb + (size_t)(nb * 32) * 1024 + 512 + kb * 64, 1024, scr, F.lane); continue; } r -= I4;
        { const int kb = r / 32, nb = r % 32; tr_item(a.in[I_WOUT] + (size_t)l * D * D + (size_t)kb * 64 * D + nb * 32, D, Wout + (size_t)(nb * 32) * 1024 + kb * 64, 1024, scr, F.lane); }
    }
    if (!(part & 1)) return;
    const LAS float* ct = (const LAS float*)(F.lds + LDS_COSTAB);
    const int gt = pidx * 512 + F.tid, NGT = pcnt * 512;
    for (int o = gt; o < 1024 * 128; o += NGT) {
        const int k = o & 1023, g = (o >> 10) & 3, mq = o >> 12;
        const float* wp = w_in + (size_t)k * DIN + g * 64;
        f32x4 wv[16];
#pragma unroll
        for (int i = 0; i < 16; ++i) wv[i] = *(const f32x4*)(wp + 4 * i);
#pragma unroll 1
        for (int mm = 0; mm < 2; ++mm) {
            const int m = mq * 2 + mm; float sc = 0.f, ss = 0.f;
#pragma unroll
            for (int j = 0; j < 64; ++j) { const int i = ((j * m) & 63) * 32; const float w = wv[j >> 2][j & 3]; sc += w * ct[i]; ss += w * ct[(i + 1536) & 2047]; }
            Win[(size_t)(g * 64 + m) * 1024 + k] = (bf16_t)f2bf(sc * 0.125f);
            Win[(size_t)(256 + g * 64 + m) * 1024 + k] = (bf16_t)f2bf(ss * 0.125f);
        }
    }
    float* bi = (float*)(ws + WS_BIASIN) + l * NIN; const float* b_in = a.in[I_BIN] + (size_t)l * DIN;
    for (int r = gt; r < NIN; r += NGT) {
        float v;
        if (r < 512) { const int pt = r >> 8, g = (r >> 6) & 3, m = r & 63; float s_ = 0.f;
            for (int j = 0; j < 64; ++j) { const int i = (j * m) & 63; s_ += b_in[g * 64 + j] * ct[(i * 32 + (pt ? 1536 : 0)) & 2047]; }
            v = s_ * 0.125f; }
        else v = b_in[r - 256];
        bi[r] = v;
    }
}
__device__ __forceinline__ void conv_setB(Frame& F, const Args& a, int l, int pidx, int pcnt) {
    unsigned char* ws = a.ws;
    bf16_t* Wgu = (bf16_t*)(ws + (l ? WS_WGU1 : WS_WGU0)); bf16_t* Wd = (bf16_t*)(ws + (l ? WS_WD1 : WS_WD0));
    LAS float* scr = (LAS float*)(F.lds + F.wave * 16384);
    const int gw = pidx * 8 + F.wave, NGW = pcnt * 8;
    constexpr int J1 = 16 * 88, J3 = 44 * 32;
    for (int it = gw; it < 2 * J1 + J3; it += NGW) {
        int r = it;
        if (r < 2 * J1) { const int up = r >= J1; if (up) r -= J1; const int kb = r / 88, nb = r % 88, n0 = nb * 32;
            const float* W = a.in[up ? I_WU : I_WG] + (size_t)l * D * DFF;
            tr_item(W + (size_t)kb * 64 * DFF + n0, DFF, Wgu + (size_t)((n0 >> 7) * 256 + up * 128 + (n0 & 127)) * 1024 + kb * 64, 1024, scr, F.lane); continue; }
        r -= 2 * J1;
        { const int kb = r / 32, nb = r % 32; tr_item(a.in[I_WD] + (size_t)l * DFF * D + (size_t)kb * 64 * D + nb * 32, D, Wd + (size_t)(nb * 32) * DFF + kb * 64, DFF, scr, F.lane); }
    }
}

__device__ __forceinline__ void norm_row(const float* xrow, const float* g, const float* sh, const float* sc, bf16_t* orow, float* fout, int lane) {
    f32x4 v[4]; float s = 0.f;
#pragma unroll
    for (int j = 0; j < 4; ++j) { v[j] = *((const f32x4*)xrow + lane + 64 * j); s += (v[j].x * v[j].x + v[j].y * v[j].y) + (v[j].z * v[j].z + v[j].w * v[j].w); }
    const float rstd = 1.0f / sqrtf(wave_sum(s) * (1.0f / D) + EPS);
#pragma unroll
    for (int j = 0; j < 4; ++j) {
        const int c = (lane + 64 * j) * 4;
        f32x4 y = v[j] * rstd * *(const f32x4*)(g + c);
        if (fout) { *(f32x4*)(fout + c) = y; }
        else { y = y * (*(const f32x4*)(sc + c) + 1.0f) + *(const f32x4*)(sh + c);
            u32x2 w; w.x = cvt_pk_bf16(y.x, y.y); w.y = cvt_pk_bf16(y.z, y.w); *(u32x2*)(orow + c) = w; }
    }
}
__device__ __forceinline__ void norm_phase(Frame& F, const float* xl, const float* xc, const float* g, const float* mod, int sh_off, int sc_off, bf16_t* H, bool with_ctx) {
    const int gw = F.vcu * 8 + F.wave, NGW = F.G * 8, nrows = with_ctx ? MT : ML;
    for (int r = gw; r < nrows; r += NGW) {
        const int b = r < ML ? (r >> 11) : 8;
        const float* xr = r < ML ? xl + (size_t)r * D : xc + (size_t)(r - ML) * D;
        norm_row(xr, g, mod + (size_t)b * 6144 + sh_off, mod + (size_t)b * 6144 + sc_off, H + (size_t)r * D, nullptr, F.lane);
    }
}

__device__ __forceinline__ int crow(int r, int hi) { return (r & 3) + 8 * (r >> 2) + 4 * hi; }
__device__ __forceinline__ s16x4 vtr(const LAS unsigned char* p) { return __builtin_bit_cast(s16x4, __builtin_amdgcn_ds_read_tr16_b64_v4i16((LAS s16x4*)p)); }
constexpr int AT_WSF = 131072;
__device__ __forceinline__ void at_softmax(f32x16& p0, f32x16& p1, f32x16& negm, float& mhat, float& lsum, f32x16 (&o)[4], bf16x8 (&pa)[4], LAS float* wsf, bool first, int r32, int hi) {
    float rm = fmaxf(fmaxf(p0[0], p0[1]), p1[0]);
    { float rb = fmaxf(fmaxf(p0[2], p0[3]), p1[1]); rm = fmaxf(fmaxf(rm, p1[2]), p1[3]);
#pragma unroll
      for (int r = 4; r < 16; r += 4) { rm = fmaxf(fmaxf(rm, p0[r]), p0[r + 1]); rb = fmaxf(fmaxf(rb, p0[r + 2]), p0[r + 3]); rm = fmaxf(fmaxf(rm, p1[r]), p1[r + 1]); rb = fmaxf(fmaxf(rb, p1[r + 2]), p1[r + 3]); }
      rm = fmaxf(rm, rb); }
    rm = fmaxf(rm, __shfl_xor(rm, 32));
    const bool need = first || (rm > 6.0f);
    if (__any(need)) {
        const float dl = need ? rm : 0.f;
        mhat += dl;
#pragma unroll
        for (int r = 0; r < 16; ++r) { p0[r] -= dl; p1[r] -= dl; negm[r] = -mhat; }
        if (!first) {
            const float f = fast_exp2(-dl);
            lsum *= f;
            asm volatile("" ::: "memory");
            if (hi == 0) wsf[r32] = f;
            asm volatile("s_waitcnt lgkmcnt(0)" ::: "memory");
#pragma unroll
            for (int r = 0; r < 16; ++r) { const float fr_ = wsf[crow(r, hi)];
#pragma unroll
                for (int d0 = 0; d0 < 4; ++d0) o[d0][r] *= fr_; }
            asm volatile("s_waitcnt lgkmcnt(0)" ::: "memory");
        }
    }
    f32x2_t ls2 = (f32x2_t){0.f, 0.f};
#pragma unroll
    for (int r = 0; r < 16; r += 2) { p0[r] = fast_exp2(p0[r]); p0[r + 1] = fast_exp2(p0[r + 1]); p1[r] = fast_exp2(p1[r]); p1[r + 1] = fast_exp2(p1[r + 1]);
        ls2 += (f32x2_t){p0[r], p0[r + 1]}; ls2 += (f32x2_t){p1[r], p1[r + 1]}; }
    lsum += ls2.x + ls2.y;
    u32x4 w;
    w.x = cvt_pk_bf16(p0[0], p0[1]); w.y = cvt_pk_bf16(p0[2], p0[3]); w.z = cvt_pk_bf16(p0[4], p0[5]); w.w = cvt_pk_bf16(p0[6], p0[7]); pa[0] = __builtin_bit_cast(bf16x8, w);
    w.x = cvt_pk_bf16(p0[8], p0[9]); w.y = cvt_pk_bf16(p0[10], p0[11]); w.z = cvt_pk_bf16(p0[12], p0[13]); w.w = cvt_pk_bf16(p0[14], p0[15]); pa[1] = __builtin_bit_cast(bf16x8, w);
    w.x = cvt_pk_bf16(p1[0], p1[1]); w.y = cvt_pk_bf16(p1[2], p1[3]); w.z = cvt_pk_bf16(p1[4], p1[5]); w.w = cvt_pk_bf16(p1[6], p1[7]); pa[2] = __builtin_bit_cast(bf16x8, w);
    w.x = cvt_pk_bf16(p1[8], p1[9]); w.y = cvt_pk_bf16(p1[10], p1[11]); w.z = cvt_pk_bf16(p1[12], p1[13]); w.w = cvt_pk_bf16(p1[14], p1[15]); pa[3] = __builtin_bit_cast(bf16x8, w);
}
__device__ __forceinline__ void attn_unit(Frame& F, const bf16_t* P, bf16_t* BR, int qrow0, int base1, int n1, int base2, int nt, int h, float lam, float oscale, const float* subg) {
    LAS unsigned char* lds = F.lds;
    const int tid = F.tid, lane = F.lane, wid = F.wave, r32 = lane & 31, hi = lane >> 5, qg = wid & 3, comp = wid >> 2;
    bf16x8 qf[4];
    { const bf16_t* qp = P + (size_t)(qrow0 + qg * 32 + r32) * LDP + PQ + h * 128 + comp * 64 + hi * 8;
#pragma unroll
      for (int d0 = 0; d0 < 4; ++d0) qf[d0] = *(const bf16x8*)(qp + d0 * 16); }
    int ksrc[2], kdst[2], vsrc[2], vdst[2];
#pragma unroll
    for (int i = 0; i < 2; ++i) { const int pc = wid * 2 + i;
        { const int cmp = pc >> 3, rg = pc & 7, row = rg * 8 + (lane >> 3), c8 = (lane & 7) ^ (lane >> 3); ksrc[i] = row * LDP + PK + h * 128 + cmp * 64 + c8 * 8; kdst[i] = cmp * 8192 + rg * 1024; }
        { const int d0 = pc >> 2, rg = pc & 3; vsrc[i] = (rg * 16 + (lane >> 2)) * LDP + PV + h * 128 + d0 * 32 + (lane & 3) * 8; vdst[i] = 16384 + d0 * 4096 + rg * 1024; } }
#define AT_TROW(t) ((t) < n1 ? base1 + 64 * (t) : base2 + 64 * ((t) - n1))
    LAS float* wsf = (LAS float*)(lds + AT_WSF) + wid * 64;
    float mhat = 0.f, lsum = 0.f;
    f32x16 negm;
#pragma unroll
    for (int r = 0; r < 16; ++r) negm[r] = 0.f;
    f32x16 o[4];
#pragma unroll
    for (int d0 = 0; d0 < 4; ++d0)
#pragma unroll
        for (int r = 0; r < 16; ++r) o[d0][r] = 0.f;
    bf16x8 pa[4];
#pragma unroll
    for (int i = 0; i < 4; ++i) pa[i] = (bf16x8){0, 0, 0, 0, 0, 0, 0, 0};
    s16x4 va[8], vb[8];
#pragma unroll
    for (int i = 0; i < 8; ++i) { va[i] = (s16x4){0, 0, 0, 0}; vb[i] = (s16x4){0, 0, 0, 0}; }
    const int vlane = ((lane >> 4) & 1) * 32 + (lane & 3) * 8 + (4 * hi + ((lane & 15) >> 2)) * 64;
    const int klane = comp * 8192 + r32 * 128;
    int koff[4];
#pragma unroll
    for (int d0 = 0; d0 < 4; ++d0) koff[d0] = ((2 * d0 + hi) ^ (r32 & 7)) * 16;
#define AT_SB() __builtin_amdgcn_sched_barrier(0)
#define AT_DMA4(t, OFF) do { const bf16_t* tp = P + (size_t)AT_TROW(t) * LDP; \
        __builtin_amdgcn_global_load_lds((const unsigned*)(tp + ksrc[0]), (LAS unsigned*)(lds + (OFF) + kdst[0]), 16, 0, 0); \
        __builtin_amdgcn_global_load_lds((const unsigned*)(tp + ksrc[1]), (LAS unsigned*)(lds + (OFF) + kdst[1]), 16, 0, 0); \
        __builtin_amdgcn_global_load_lds((const unsigned*)(tp + vsrc[0]), (LAS unsigned*)(lds + (OFF) + vdst[0]), 16, 0, 0); \
        __builtin_amdgcn_global_load_lds((const unsigned*)(tp + vsrc[1]), (LAS unsigned*)(lds + (OFF) + vdst[1]), 16, 0, 0); } while (0)
#define AT_VF(x, s) ((bf16x8){x[2 * (s)][0], x[2 * (s)][1], x[2 * (s)][2], x[2 * (s)][3], x[2 * (s) + 1][0], x[2 * (s) + 1][1], x[2 * (s) + 1][2], x[2 * (s) + 1][3]})
#define AT_TR(dst, addr, off) asm volatile("ds_read_b64_tr_b16 %0, %1 offset:%c2" : "=&v"(dst) : "v"(addr), "i"(off) : "memory")
    const unsigned ldsb = (unsigned)(unsigned long long)lds;
#define AT_VPRE(OFF) do { const unsigned vp_ = ldsb + (OFF) + 16384 + vlane; \
        _Pragma("unroll") for (int s_ = 0; s_ < 4; ++s_) { AT_TR(va[2 * s_], vp_, s_ * 1024); AT_TR(va[2 * s_ + 1], vp_, s_ * 1024 + 512); AT_TR(vb[2 * s_], vp_, 4096 + s_ * 1024); AT_TR(vb[2 * s_ + 1], vp_, 4096 + s_ * 1024 + 512); } } while (0)
#define AT_PVMMA(OFF) do { const unsigned vp_ = ldsb + (OFF) + 16384 + vlane; \
        asm volatile("s_waitcnt lgkmcnt(0)" ::: "memory"); AT_SB(); __builtin_amdgcn_s_setprio(1); \
        _Pragma("unroll") for (int s_ = 0; s_ < 4; ++s_) { \
            o[0] = __builtin_amdgcn_mfma_f32_32x32x16_bf16(pa[s_], AT_VF(va, s_), o[0], 0, 0, 0); \
            o[1] = __builtin_amdgcn_mfma_f32_32x32x16_bf16(pa[s_], AT_VF(vb, s_), o[1], 0, 0, 0); \
            AT_SB(); \
            AT_TR(va[2 * s_], vp_, 8192 + s_ * 1024); AT_TR(va[2 * s_ + 1], vp_, 8192 + s_ * 1024 + 512); AT_TR(vb[2 * s_], vp_, 12288 + s_ * 1024); AT_TR(vb[2 * s_ + 1], vp_, 12288 + s_ * 1024 + 512); \
            AT_SB(); } \
        asm volatile("s_waitcnt lgkmcnt(0)" ::: "memory"); AT_SB(); \
        _Pragma("unroll") for (int s_ = 0; s_ < 4; ++s_) { \
            o[2] = __builtin_amdgcn_mfma_f32_32x32x16_bf16(pa[s_], AT_VF(va, s_), o[2], 0, 0, 0); \
            o[3] = __builtin_amdgcn_mfma_f32_32x32x16_bf16(pa[s_], AT_VF(vb, s_), o[3], 0, 0, 0); } \
        __builtin_amdgcn_s_setprio(0); AT_SB(); } while (0)
#define AT_STEP(t, CUR, NX2, PRV) do { \
        if ((t) + 2 < nt) AT_DMA4((t) + 2, NX2); \
        if (comp == 1 && (t) > 0) AT_PVMMA(PRV); \
        f32x16 p0, p1; \
        {   bf16x8 kf[8]; const LAS unsigned char* kb = lds + (CUR) + klane; \
            _Pragma("unroll") for (int d0 = 0; d0 < 4; ++d0) { kf[2 * d0] = *(const LAS bf16x8*)(kb + koff[d0]); kf[2 * d0 + 1] = *(const LAS bf16x8*)(kb + koff[d0] + 4096); } \
            AT_SB(); __builtin_amdgcn_s_setprio(1); \
            p0 = __builtin_amdgcn_mfma_f32_32x32x16_bf16(kf[0], qf[0], negm, 0, 0, 0); \
            p1 = __builtin_amdgcn_mfma_f32_32x32x16_bf16(kf[1], qf[0], negm, 0, 0, 0); \
            _Pragma("unroll") for (int d0 = 1; d0 < 4; ++d0) { \
                p0 = __builtin_amdgcn_mfma_f32_32x32x16_bf16(kf[2 * d0], qf[d0], p0, 0, 0, 0); \
                p1 = __builtin_amdgcn_mfma_f32_32x32x16_bf16(kf[2 * d0 + 1], qf[d0], p1, 0, 0, 0); } __builtin_amdgcn_s_setprio(0); } \
        AT_SB(); \
        AT_VPRE(CUR); \
        AT_SB(); \
        at_softmax(p0, p1, negm, mhat, lsum, o, pa, wsf, (t) == 0, r32, hi); \
        AT_SB(); \
        if (comp == 0) AT_PVMMA(CUR); \
          \
        if ((t) + 2 < nt) asm volatile("s_waitcnt vmcnt(4)" ::: "memory"); else asm volatile("s_waitcnt vmcnt(0)" ::: "memory"); \
        AT_SB(); __builtin_amdgcn_s_barrier(); AT_SB(); } while (0)
    AT_DMA4(0, 0);
    if (nt > 1) AT_DMA4(1, 32768);
    if (nt > 1) asm volatile("s_waitcnt vmcnt(4)" ::: "memory"); else asm volatile("s_waitcnt vmcnt(0)" ::: "memory");
    __syncthreads();
#pragma unroll 1
    for (int t = 0; t < nt; t += 4) {
        AT_STEP(t, 0, 65536, 98304);
        if (t + 1 < nt) AT_STEP(t + 1, 32768, 98304, 0);
        if (t + 2 < nt) AT_STEP(t + 2, 65536, 0, 32768);
        if (t + 3 < nt) AT_STEP(t + 3, 98304, 32768, 65536);
    }
    if (comp == 1) { const int lo_ = ((nt - 1) & 3) * 32768; AT_PVMMA(lo_); }
    __syncthreads();
#undef AT_STEP
#undef AT_PVMMA
#undef AT_VPRE
#undef AT_TR
#undef AT_VF
#undef AT_DMA4
#undef AT_SB
    lsum += __shfl_xor(lsum, 32);
    { float inv = 1.0f / lsum; if (comp) inv *= lam;
      asm volatile("" ::: "memory");
      if (hi == 0) wsf[r32] = inv;
      asm volatile("s_waitcnt lgkmcnt(0)" ::: "memory");
#pragma unroll
      for (int r = 0; r < 16; ++r) { const float fr_ = wsf[crow(r, hi)];
#pragma unroll
          for (int d0 = 0; d0 < 4; ++d0) o[d0][r] *= fr_; } }
    LAS float* X = (LAS float*)lds + qg * (32 * 132);
    if (comp == 1) {
#pragma unroll
        for (int d0 = 0; d0 < 4; ++d0)
#pragma unroll
            for (int r = 0; r < 16; ++r) X[crow(r, hi) * 132 + d0 * 32 + r32] = o[d0][r];
    }
    __syncthreads();
    if (comp == 0) {
#pragma unroll
        for (int d0 = 0; d0 < 4; ++d0)
#pragma unroll
            for (int r = 0; r < 16; ++r) { const int ix = crow(r, hi) * 132 + d0 * 32 + r32; X[ix] = o[d0][r] - X[ix]; }
        asm volatile("s_waitcnt lgkmcnt(0)" ::: "memory");
        const int row = lane >> 1, hf = lane & 1;
        const LAS float* xr = X + row * 132 + hf * 64;
        float ss = 0.f;
#pragma unroll
        for (int c = 0; c < 16; ++c) { const f32x4 v = *(const LAS f32x4*)(xr + c * 4); ss += (v.x * v.x + v.y * v.y) + (v.z * v.z + v.w * v.w); }
        ss += __shfl_xor(ss, 1);
        const float rstd = oscale / sqrtf(ss * (1.0f / 128.0f) + EPS);
        bf16_t* op = BR + (size_t)(qrow0 + qg * 32 + row) * 1024 + 512 + h * 128 + hf * 64;
        const float* gp = subg + hf * 64;
#pragma unroll
        for (int c = 0; c < 8; ++c) {
            const f32x4 v0 = *(const LAS f32x4*)(xr + c * 8) * rstd * *(const f32x4*)(gp + c * 8), v1 = *(const LAS f32x4*)(xr + c * 8 + 4) * rstd * *(const f32x4*)(gp + c * 8 + 4);
            u32x4 w; w.x = cvt_pk_bf16(v0.x, v0.y); w.y = cvt_pk_bf16(v0.z, v0.w); w.z = cvt_pk_bf16(v1.x, v1.y); w.w = cvt_pk_bf16(v1.z, v1.w);
            *(u32x4*)(op + c * 8) = w;
        }
    }
    __syncthreads();
#undef AT_TROW
}

__device__ __forceinline__ void norm_rows4(const float* x0, size_t xstride, const float* g, const float* sh, const float* sc, bf16_t* o0, size_t ostride, float* fout, int lane) {
    f32x4 v[4][4]; float ss[4];
#pragma unroll
    for (int r = 0; r < 4; ++r)
#pragma unroll
        for (int j = 0; j < 4; ++j) v[r][j] = *((const f32x4*)(x0 + (size_t)r * xstride) + lane + 64 * j);
#pragma unroll
    for (int r = 0; r < 4; ++r) { float s = 0.f;
#pragma unroll
        for (int j = 0; j < 4; ++j) s += (v[r][j].x * v[r][j].x + v[r][j].y * v[r][j].y) + (v[r][j].z * v[r][j].z + v[r][j].w * v[r][j].w);
        ss[r] = 1.0f / sqrtf(wave_sum(s) * (1.0f / D) + EPS); }
#pragma unroll
    for (int j = 0; j < 4; ++j) {
        const int c = (lane + 64 * j) * 4;
        const f32x4 gv = *(const f32x4*)(g + c);
        if (fout) {
#pragma unroll
            for (int r = 0; r < 4; ++r) *(f32x4*)(fout + (size_t)r * xstride + c) = v[r][j] * ss[r] * gv;
        } else {
            const f32x4 m1 = *(const f32x4*)(sc + c) + 1.0f, sv = *(const f32x4*)(sh + c);
#pragma unroll
            for (int r = 0; r < 4; ++r) { const f32x4 y = v[r][j] * ss[r] * gv * m1 + sv;
                u32x2 w; w.x = cvt_pk_bf16(y.x, y.y); w.y = cvt_pk_bf16(y.z, y.w); *(u32x2*)(o0 + (size_t)r * ostride + c) = w; }
        }
    }
}
__device__ __forceinline__ void norm_phase4(Frame& F, const float* xl, const float* xc, const float* g, const float* mod, int sh_off, int sc_off, bf16_t* H, bool with_ctx) {
    const int gw = F.vcu * 8 + F.wave, NGW = F.G * 8, nrows = with_ctx ? MT : ML;
    for (int r = gw * 4; r < nrows; r += NGW * 4) {
        const int b = r < ML ? (r >> 11) : 8;
        const float* xr = r < ML ? xl + (size_t)r * D : xc + (size_t)(r - ML) * D;
        norm_rows4(xr, D, g, mod + (size_t)b * 6144 + sh_off, mod + (size_t)b * 6144 + sc_off, H + (size_t)r * D, D, nullptr, F.lane);
    }
}
#define XB_TMO      128
#define XB_XCNT(j)  (256  + 64 * (j))
#define XB_XSUB(j)  (1280 + 64 * (j))
#define XB_XGEN(j)  (2304 + 64 * (j))
#define XB_TOP      3328
#define XB_TOPGEN   3392
#define XCD_BAR_WORDS 3456
#define XB_SPIN_CAP (1u << 18)
__device__ __forceinline__ unsigned xb_ld(unsigned* p)              { return __hip_atomic_load(p, __ATOMIC_RELAXED, __HIP_MEMORY_SCOPE_AGENT); }
__device__ __forceinline__ unsigned xb_add(unsigned* p, unsigned v) { return __hip_atomic_fetch_add(p, v, __ATOMIC_RELAXED, __HIP_MEMORY_SCOPE_AGENT); }
__device__ __forceinline__ unsigned xb_xcc_id() { return (unsigned)__builtin_amdgcn_s_getreg((3 << 11) | 20) & 0xFu; }
#define XB_SPIN(cond, bar) do { unsigned _sp = 0; while (cond) { __builtin_amdgcn_s_sleep(1); \
    if ((++_sp & 255u) == 0u) { if (xb_ld(&(bar)[XB_TMO])) break; if (_sp > XB_SPIN_CAP) { atomicAdd(&(bar)[XB_TMO], 1u); break; } } } } while (0)
struct XcdBarrier { unsigned* bar; unsigned x; volatile LAS unsigned* st; };
__device__ __forceinline__ XcdBarrier xcd_barrier_post(unsigned* bar, volatile LAS unsigned* st) {
    XcdBarrier b; b.bar = bar; b.x = xb_xcc_id(); b.st = st;
    if (threadIdx.x == 0) (void)xb_add(&bar[XB_XCNT(b.x)], 1u);
    return b;
}
__device__ __forceinline__ void xcd_barrier_complete(unsigned* bar, unsigned x, unsigned& nloc, unsigned& nx) {
    const unsigned G = gridDim.x * gridDim.y * gridDim.z;
    unsigned sum, cnt, mine, sp = 0u;
    for (;;) {
        sum = 0u; cnt = 0u; mine = 0u;
#pragma unroll
        for (unsigned j = 0; j < 16; ++j) { const unsigned c = xb_ld(&bar[XB_XCNT(j)]); sum += c; cnt += (c > 0u) ? 1u : 0u; mine = (j == x) ? c : mine; }
        if (sum == G) break;
        __builtin_amdgcn_s_sleep(1);
        if ((++sp & 255u) == 0u) { if (xb_ld(&bar[XB_TMO])) break; if (sp > XB_SPIN_CAP) { atomicAdd(&bar[XB_TMO], 1u); break; } }
    }
    nloc = mine > 0u ? mine : 1u; nx = cnt > 0u ? cnt : 1u;
}
__device__ __forceinline__ void xcd_barrier(const XcdBarrier& b) {
    asm volatile("s_waitcnt vmcnt(0)" ::: "memory");
    __syncthreads();
    if (threadIdx.x == 0) {
        unsigned* bar = b.bar;
        __builtin_amdgcn_s_waitcnt(0);
        unsigned nloc = b.st[0], nx = b.st[1];
        if (nloc == 0u) { xcd_barrier_complete(bar, b.x, nloc, nx); b.st[0] = nloc; b.st[1] = nx; }
        const unsigned old = xb_add(&bar[XB_XSUB(b.x)], 1u);
        const unsigned gen = old / nloc;
        if (old + 1u == (gen + 1u) * nloc) {
            __builtin_amdgcn_fence(__ATOMIC_RELEASE, "agent");
            asm volatile("s_waitcnt vmcnt(0)" ::: "memory");
            const unsigned og = xb_add(&bar[XB_TOP], 1u);
            const unsigned tg = og / nx;
            if (og + 1u == (tg + 1u) * nx) xb_add(&bar[XB_TOPGEN], 1u);
            else XB_SPIN(xb_ld(&bar[XB_TOPGEN]) == tg, bar);
            __builtin_amdgcn_fence(__ATOMIC_ACQUIRE, "agent");
            xb_add(&bar[XB_XGEN(b.x)], 1u);
            asm volatile("s_waitcnt vmcnt(0)" ::: "memory");
        } else {
            XB_SPIN(xb_ld(&bar[XB_XGEN(b.x)]) == gen, bar);
            __builtin_amdgcn_fence(__ATOMIC_ACQUIRE, "agent");
            asm volatile("s_waitcnt vmcnt(0)" ::: "memory");
        }
    }
    __syncthreads();
}

constexpr int N_PHASES = 20;
__global__ void __launch_bounds__(512, 2) fwd_kernel(Args args) {
    extern __shared__ __attribute__((aligned(16))) unsigned char lds_raw[];
    Frame F;
    F.lds = (LAS unsigned char*)lds_raw;
    F.tid = threadIdx.x; F.lane = F.tid & 63; F.wave = __builtin_amdgcn_readfirstlane(F.tid >> 6);
    F.G = gridDim.x; F.bx = blockIdx.x; F.vcu = (F.G % 8 == 0) ? (F.bx % 8) * (F.G / 8) + F.bx / 8 : F.bx; F.rot = 0;
    unsigned char* const ws = args.ws;
    float* const XL = args.out;
    if (F.tid < 2) ((LAS unsigned*)(F.lds + LDS_XB))[F.tid] = 0u;
    __syncthreads();
    if (args.ph_hi - args.ph_lo > 1) (void)xcd_barrier_post((unsigned*)(ws + WS_BAR), (volatile LAS unsigned*)(F.lds + LDS_XB));
#define WSP(T, off) ((T*)(ws + (off)))
#pragma unroll 1
    for (int ph = args.ph_lo, rep = 0; ph < args.ph_hi;) {
#define REFRESH_LANE() do { int l_ = (int)__builtin_amdgcn_mbcnt_hi(~0u, __builtin_amdgcn_mbcnt_lo(~0u, 0u)); asm volatile("" : "+v"(l_)); F.lane = l_; F.tid = F.wave * 64 + l_; } while (0)
        REFRESH_LANE();
        const int kind = ph < 2 ? ph : 2 + (ph - 2) % 9;
        const int l = ph < 2 ? 0 : (ph - 2) / 9;
        const bool last = (l == 1);
        const float* mod = WSP(float, WS_MOD) + (size_t)l * 9 * 6144;
        const float* biasin = WSP(float, WS_BIASIN) + l * NIN;
        if (kind == 0) {
            LAS float* ct = (LAS float*)(F.lds + LDS_COSTAB);
            for (int i = F.tid; i < 2048; i += 512) ct[i] = cospif((float)i * (1.0f / 1024.0f));
            __syncthreads();
        }
        if (kind == 0) {
            if (F.bx < 192) {
                LAS float* sv = (LAS float*)F.lds;
                LAS float* red = (LAS float*)(F.lds + 40960);
                for (int i = F.tid; i < 9 * 1024; i += 512) { const int r = i >> 10, k = i & 1023; const float c = r < 8 ? args.in[I_C][r * 1024 + k] : args.in[I_CCTX][k]; sv[i] = c / (1.0f + __expf(-c)); }
                __syncthreads();
                for (int job = F.bx; job < 192; job += F.G) {
                    const int jl = job / 96, n0 = (job % 96) * 64, kg = F.tid >> 6, nn = F.tid & 63;
                    const float* wp = args.in[I_WADA] + (size_t)jl * D * 6144 + (size_t)(kg * 128) * 6144 + n0 + nn;
                    float ac[9];
#pragma unroll
                    for (int r = 0; r < 9; ++r) ac[r] = 0.f;
#pragma unroll 1
                    for (int k0 = 0; k0 < 128; k0 += 16) {
                        float wv[16];
#pragma unroll
                        for (int i = 0; i < 16; ++i) wv[i] = wp[(size_t)(k0 + i) * 6144];
#pragma unroll
                        for (int i = 0; i < 16; ++i)
#pragma unroll
                            for (int r = 0; r < 9; ++r) ac[r] += sv[r * 1024 + kg * 128 + k0 + i] * wv[i]; }
#pragma unroll
                    for (int r = 0; r < 9; ++r) red[(kg * 9 + r) * 64 + nn] = ac[r];
                    __syncthreads();
                    for (int o = F.tid; o < 576; o += 512) { const int r = o >> 6, n = o & 63; float s = args.in[I_BADA][jl * 6144 + n0 + n];
#pragma unroll
                        for (int q = 0; q < 8; ++q) s += red[(q * 9 + r) * 64 + n];
                        WSP(float, WS_MOD)[((size_t)jl * 9 + r) * 6144 + n0 + n] = s; }
                    __syncthreads();
                }
            }
            __syncthreads();
            if (F.bx == F.G - 1) {
                float* ROPE = WSP(float, WS_ROPE);
                for (int i = F.tid; i < 1024; i += 512) { const int pos = i >> 4, f = i & 15; const float fr = powf(10000.0f, -(float)f * (1.0f / 16.0f)); const float ang = (float)pos * fr; ROPE[i] = cosf(ang); ROPE[1024 + i] = sinf(ang); }
                if (F.tid < 2) { const int jl = F.tid; float s1 = 0.f, s2 = 0.f;
                    for (int j = 0; j < 64; ++j) { s1 += args.in[I_LQ1][jl * 64 + j] * args.in[I_LK1][jl * 64 + j]; s2 += args.in[I_LQ2][jl * 64 + j] * args.in[I_LK2][jl * 64 + j]; }
                    WSP(float, WS_LAM)[jl] = expf(s1) - expf(s2) + (0.8f - 0.6f * expf(-0.3f * (float)jl)); }
            }
            __syncthreads();
        }
        if (kind == 0) { REFRESH_LANE(); conv_setA(F, args, 0, F.vcu, F.G, 1); }
        if (kind == 1 || kind == 7 || (kind == 10 && !last)) {
            REFRESH_LANE();
            const bool n2 = (kind == 7);
            const float* xl = (kind == 1) ? args.in[I_X] : XL;
            const float* xc = (kind == 1) ? args.in[I_CTX] : WSP(float, WS_XC);
            const float* g = n2 ? args.in[I_N2G] + l * 1024 : args.in[I_N1G] + (kind == 10 ? 1024 : 0);
            const float* m = (kind == 10) ? WSP(float, WS_MOD) + (size_t)9 * 6144 : mod;
            norm_phase4(F, xl, xc, g, m, n2 ? 3072 : 0, n2 ? 4096 : 1024, n2 ? WSP(bf16_t, WS_BR) : WSP(bf16_t, WS_H), n2 ? !last : true);
        }
        if (kind == 10 && last) {
            REFRESH_LANE();
            const int gw = F.vcu * 8 + F.wave, NGW = F.G * 8;
            for (int r = gw * 4; r < ML; r += NGW * 4) norm_rows4(XL + (size_t)r * D, D, args.in[I_FING], nullptr, nullptr, nullptr, 0, XL + (size_t)r * D, F.lane);
        }
        if (kind == 3) {
            const float lam = WSP(float, WS_LAM)[l]; const float osc = 1.0f - (0.8f - 0.6f * expf(-0.3f * (float)l)); const float* subg = args.in[I_SUBG] + l * 128;
            const bf16_t* P = WSP(bf16_t, WS_P); bf16_t* BR = WSP(bf16_t, WS_BR);
            const int npairs = (2 * F.vcu < 512) ? (512 - 2 * F.vcu + 2 * F.G - 1) / (2 * F.G) : 0, nlat = 2 * npairs;
#pragma unroll 1
            for (int rp = 0; rp <= PROBE_ATT; ++rp)
#pragma unroll 1
            for (int i = 0;; ++i) {
                int qrow0, base1, n1, base2, nt, h;
                if (i < nlat) { const int un = (i >> 1) * 2 * F.G + 2 * F.vcu + (i & 1); const int bh = un >> 4, qb = un & 15, b = bh >> 2; h = bh & 3;
                    qrow0 = b * SEQ + qb * 128; base1 = b * SEQ; n1 = 32; base2 = ML + b * CTXL; nt = 36; }
                else { const int cu = F.vcu + (i - nlat) * F.G; if (last || cu >= 64) break; const int bh = cu >> 1, qb = cu & 1, b = bh >> 2; h = bh & 3;
                    qrow0 = ML + b * CTXL + qb * 128; base1 = ML + b * CTXL; n1 = 4; base2 = 0; nt = 4; }
                REFRESH_LANE();
                attn_unit(F, P, BR, qrow0, base1, n1, base2, nt, h, lam, osc, subg);
            }
        }
#pragma unroll 1
        for (int j = 0; j < 4; ++j) {
            GJob J{}; bool have = false;
            J.lda = 1024; J.ldb = 1024; J.K = 1024; J.rot = -1;
            if (kind == 2) {
                if (j < 2) { have = true; J.A = WSP(bf16_t, WS_H) + (j ? (size_t)ML * 1024 : 0); J.Bt = WSP(bf16_t, WS_WIN); J.M = j ? MC : ML; J.N = NP1;
                    J.E.mode = E_INPROJ; J.E.out = WSP(bf16_t, WS_P); J.E.p1 = biasin; J.E.p2 = WSP(float, WS_ROPE); J.E.row_base = j ? ML : 0; J.E.ctx = j; J.E.aux = 0; J.E.p3 = WSP(bf16_t, (l ? WS_FT1 : WS_FT0)); J.E.p4 = WSP(bf16_t, WS_FTC);
                    if (j == 0) J.rot = 0;
                    if (j && last) { J.Bt = WSP(bf16_t, WS_WIN) + (size_t)7 * 256 * 1024; J.N = 1024; J.E.aux = 7; J.E.p1 = biasin + 7 * 256; } }
            } else if (kind == 4) {
                const int nf = (F.G >= 128) ? 64 : 0;
                if (j == 0) { have = true; J.A = WSP(bf16_t, WS_DFT); J.lda = 4096; J.Bt = WSP(bf16_t, (l ? WS_FT1 : WS_FT0)); J.ldb = 4096; J.M = 2048; J.N = 2048; J.K = 4096; J.rot = 0;
                    if (nf) { J.gfirst = 0; J.gsub = nf; }
                    J.E.mode = E_FOUR; J.E.out = WSP(bf16_t, WS_BR); J.E.row_base = 0; J.E.ctx = 0; J.E.scale = 0.02209708691207961f; }
                else if (j == 1 && !last) { have = true; J.A = WSP(bf16_t, WS_DFT256); J.lda = 512; J.Bt = WSP(bf16_t, WS_FTC); J.ldb = 512; J.M = 256; J.N = 2048; J.K = 512; J.rot = 0;
                    if (nf) { J.gfirst = nf; J.gsub = F.G - nf; }
                    J.E.mode = E_FOUR; J.E.out = WSP(bf16_t, WS_BR); J.E.row_base = ML; J.E.ctx = 1; J.E.scale = 0.0625f; }
                else if (j == 2) { have = true; J.A = WSP(bf16_t, WS_H); J.Bt = WSP(bf16_t, WS_WIN) + (size_t)NP1 * 1024; J.M = (last || nf) ? ML : MT; J.N = 3072; J.rot = 0;
                    if (nf) { J.gfirst = nf; J.gsub = F.G - nf; }
                    J.E.mode = E_GATE; J.E.out = WSP(bf16_t, WS_P); J.E.p1 = biasin + NP1; J.E.row_base = 0; }
                else if (j == 3 && !last && nf) { have = true; J.A = WSP(bf16_t, WS_H) + (size_t)ML * 1024; J.Bt = WSP(bf16_t, WS_WIN) + (size_t)NP1 * 1024; J.M = MC; J.N = 3072; J.rot = 0;
                    J.gfirst = 0; J.gsub = nf;
                    J.E.mode = E_GATE; J.E.out = WSP(bf16_t, WS_P); J.E.p1 = biasin + NP1; J.E.row_base = ML; }
            } else if (kind == 5) {
                if (j == 0) { have = true; J.A = WSP(bf16_t, WS_BR); J.Bt = WSP(bf16_t, WS_WB); J.M = last ? ML : MT; J.N = 1024; J.K = 1024; J.rot = 0;
                    J.E.mode = E_BRANCH; J.E.out = WSP(bf16_t, WS_H); J.E.p1 = WSP(bf16_t, WS_P); J.E.aux = 0; J.E.row_base = 0; }
            } else if (kind == 6 || kind == 9) {
                if (j == 0 || (j == 1 && !last)) { have = true;
                    const bool dn = (kind == 9);
                    const bf16_t* Abase = dn ? WSP(bf16_t, WS_P) : WSP(bf16_t, WS_H);
                    J.lda = dn ? DFF : 1024; J.ldb = J.lda; J.K = J.lda;
                    J.A = Abase + (j ? (size_t)ML * J.lda : 0);
                    J.Bt = dn ? WSP(bf16_t, (l ? WS_WD1 : WS_WD0)) : WSP(bf16_t, WS_WOUT);
                    J.M = j ? MC : ML; J.N = 1024; if (j == 0) J.rot = 0;
                    J.E.mode = E_RESID; J.E.ctx = j; J.E.p2 = mod + (dn ? 5120 : 2048);
                    const float* xin_l = (!dn && l == 0) ? args.in[I_X] : XL; const float* xin_c = (!dn && l == 0) ? args.in[I_CTX] : WSP(float, WS_XC);
                    J.E.p1 = j ? xin_c : xin_l; J.E.out = j ? (void*)WSP(float, WS_XC) : (void*)XL; }
            } else if (kind == 8) {
                if (j == 0) { have = true; J.A = WSP(bf16_t, WS_BR); J.Bt = WSP(bf16_t, (l ? WS_WGU1 : WS_WGU0)); J.M = last ? ML : MT; J.N = 2 * DFF; J.rot = 0;
                    J.E.mode = E_GU; J.E.out = WSP(bf16_t, WS_P); J.E.row_base = 0; }
            }
            if (!have) { if (kind == 4) continue; break; }
            REFRESH_LANE();
            gemm_call(F, J);
        }
        if (!last && kind == 2) {
            const int nskip = (F.G > 64) ? 24 : 0;
            if (F.bx >= nskip) {
                const int pidx = F.bx - nskip, pcnt = F.G - nskip;
                REFRESH_LANE();
                { LAS float* ctw = (LAS float*)(F.lds + LDS_COSTAB);
                  for (int i = F.tid; i < 2048; i += 512) ctw[i] = cospif((float)i * (1.0f / 1024.0f));
                  __syncthreads(); }
            {
              const LAS float* ct = (const LAS float*)(F.lds + LDS_COSTAB);
              bf16_t* DFT = WSP(bf16_t, WS_DFT); bf16_t* DFT256 = WSP(bf16_t, WS_DFT256);
              const int gt = pidx * 512 + F.tid, NGT = pcnt * 512;
              for (int q = gt; q < 2048 * 512; q += NGT) { const int k = q >> 9, c8 = (q & 511) * 8; unsigned w[4];
#pragma unroll
                  for (int e = 0; e < 8; e += 2) { float v[2];
#pragma unroll
                      for (int z = 0; z < 2; ++z) { const int np = c8 + e + z; v[z] = np < 2048 ? ct[(k * np) & 2047] : -ct[((k * (np - 2048)) + 1536) & 2047]; }
                      w[e >> 1] = pk2(v[0], v[1]); }
                  *(u32x4*)(DFT + (size_t)k * 4096 + c8) = (u32x4){w[0], w[1], w[2], w[3]}; }
              for (int q = gt; q < 256 * 64; q += NGT) { const int k = q >> 6, c8 = (q & 63) * 8; unsigned w[4];
#pragma unroll
                  for (int e = 0; e < 8; e += 2) { float v[2];
#pragma unroll
                      for (int z = 0; z < 2; ++z) { const int np = c8 + e + z; v[z] = np < 256 ? ct[(((k * np) & 255) * 8) & 2047] : -ct[((((k * (np - 256)) & 255) * 8) + 1536) & 2047]; }
                      w[e >> 1] = pk2(v[0], v[1]); }
                  *(u32x4*)(DFT256 + (size_t)k * 512 + c8) = (u32x4){w[0], w[1], w[2], w[3]}; } }
                __syncthreads();
                REFRESH_LANE();
                conv_setA(F, args, 0, pidx, pcnt, 2);
            }
        }
        if (!last && (kind == 6 || kind == 9)) {
            const int nskip = (F.G > 64) ? 32 : 0;
            if (F.bx >= nskip) {
                const int pidx = F.bx - nskip, pcnt = F.G - nskip;
                if (kind == 6) { REFRESH_LANE(); conv_setB(F, args, 0, pidx, pcnt); }
                else {
                    LAS float* ct = (LAS float*)(F.lds + LDS_COSTAB);
                    REFRESH_LANE();
                    for (int i = F.tid; i < 2048; i += 512) ct[i] = cospif((float)i * (1.0f / 1024.0f));
                    __syncthreads();
                    conv_setA(F, args, 1, pidx, pcnt, 3);
                    REFRESH_LANE();
                    conv_setB(F, args, 1, pidx, pcnt);
                }
            }
        }
        if (kind == 3) {
            REFRESH_LANE();
            const bf16_t* P = WSP(bf16_t, WS_P); bf16_t* BR = WSP(bf16_t, WS_BR);
            const float* cw = args.in[I_CONVW] + l * 768; const float* cb_ = args.in[I_CONVB] + l * 256;
            const int nrows = last ? ML : MT, gt = F.vcu * 512 + F.tid, NGT = F.G * 512;
            for (int idx = gt; idx < nrows * 32; idx += NGT) {
                const int row = idx >> 5, c8 = (idx & 31) * 8;
                const int L = row < ML ? SEQ : CTXL, t = row < ML ? (row & (SEQ - 1)) : ((row - ML) & (CTXL - 1));
                const bf16_t* pr = P + (size_t)row * LDP;
                const u32x4 cbv = *(const u32x4*)(pr + PCB + c8), c0 = *(const u32x4*)(pr + PCC + c8), x0 = *(const u32x4*)(pr + PCX + c8);
                u32x4 cm = (u32x4){0, 0, 0, 0}, xm = cm, cp = cm, xp = cm;
                if (t > 0) { cm = *(const u32x4*)(pr - LDP + PCC + c8); xm = *(const u32x4*)(pr - LDP + PCX + c8); }
                if (t < L - 1) { cp = *(const u32x4*)(pr + LDP + PCC + c8); xp = *(const u32x4*)(pr + LDP + PCX + c8); }
                unsigned ow[4];
#pragma unroll
                for (int e = 0; e < 4; ++e) {
                    const int c = c8 + 2 * e;
                    const float zl = bflo(c0[e]) * bflo(x0[e]), zh = bfhi(c0[e]) * bfhi(x0[e]);
                    const float ml = bflo(cm[e]) * bflo(xm[e]), mh = bfhi(cm[e]) * bfhi(xm[e]);
                    const float pl = bflo(cp[e]) * bflo(xp[e]), phh = bfhi(cp[e]) * bfhi(xp[e]);
                    const float vl = bflo(cbv[e]) * (cw[c] * ml + cw[256 + c] * zl + cw[512 + c] * pl + cb_[c]);
                    const float vh = bfhi(cbv[e]) * (cw[c + 1] * mh + cw[256 + c + 1] * zh + cw[512 + c + 1] * phh + cb_[c + 1]);
                    ow[e] = cvt_pk_bf16(vl, vh);
                }
                *(u32x4*)(BR + (size_t)row * 1024 + 256 + c8) = (u32x4){ow[0], ow[1], ow[2], ow[3]};
            }
        }
        const bool dup_again = (rep == 0) && (((DUP_MASK) >> kind) & 1);
        if (ph + 1 < args.ph_hi || dup_again) {
            if (args.ph_hi > 1000) cg::this_grid().sync();
            { XcdBarrier xbar; xbar.bar = (unsigned*)(ws + WS_BAR); xbar.x = xb_xcc_id(); xbar.st = (volatile LAS unsigned*)(F.lds + LDS_XB); xcd_barrier(xbar); }
        }
        if (dup_again) rep = 1; else { rep = 0; ++ph; }
    }
#undef WSP
}


#ifndef DBG_STOP
#define DBG_STOP N_PHASES
#endif
#ifndef DBG_DUMP
#define DBG_DUMP 0
#endif
__global__ void dbg_dump(const bf16_t* src, float* out, size_t n) {
    for (size_t i = (size_t)blockIdx.x * blockDim.x + threadIdx.x; i < n; i += (size_t)gridDim.x * blockDim.x) out[i] = __uint_as_float(((unsigned)src[i]) << 16);
}
extern "C" void kernel_launch(void* const* d_in, const int* in_sizes, int n_in, void* d_out, int out_size, void* d_ws, size_t ws_size, hipStream_t stream) {
    static int grid = 0;
    if (grid == 0) {
        if (n_in != 25 || in_sizes[0] != ML * D || out_size != ML * D || ws_size < WS_END) { fprintf(stderr, "kernel_launch: unexpected shapes (n_in %d, in0 %d, out %d, ws %zu)\n", n_in, n_in > 0 ? in_sizes[0] : -1, out_size, ws_size); grid = -1; return; }
        int dev = 0, cus = 0, per_cu = 0;
        hipGetDevice(&dev); hipDeviceGetAttribute(&cus, hipDeviceAttributeMultiprocessorCount, dev);
        if (hipFuncSetAttribute((const void*)fwd_kernel, hipFuncAttributeMaxDynamicSharedMemorySize, LDS_BYTES) != hipSuccess) { fprintf(stderr, "kernel_launch: hipFuncSetAttribute failed\n"); grid = -1; return; }
        if (hipOccupancyMaxActiveBlocksPerMultiprocessor(&per_cu, (const void*)fwd_kernel, 512, LDS_BYTES) != hipSuccess || per_cu < 1) { fprintf(stderr, "kernel_launch: occupancy query says %d\n", per_cu); per_cu = 1; }
        (void)hipGetLastError();
        grid = cus * 1;
        if (grid <= 0) grid = 256;
    }
    if (grid < 0) return;
    if (hipMemsetAsync((unsigned char*)d_ws + WS_BAR, 0, 16384, stream) != hipSuccess) { fprintf(stderr, "kernel_launch: memset failed\n"); return; }
    Args a{};
    for (int i = 0; i < 25; ++i) a.in[i] = (const float*)d_in[i];
    a.out = (float*)d_out; a.ws = (unsigned char*)d_ws;
#if MK_MULTI_LAUNCH
    for (int p = 0; p < DBG_STOP; ++p) {
        a.ph_lo = p; a.ph_hi = p + 1;
        hipLaunchKernelGGL(fwd_kernel, dim3(grid), dim3(512), LDS_BYTES, stream, a);
    }
#else
    a.ph_lo = 0; a.ph_hi = DBG_STOP;
    void* kargs[] = {&a};
    hipError_t e = hipLaunchCooperativeKernel((const void*)fwd_kernel, dim3(grid), dim3(512), kargs, LDS_BYTES, stream);
    if (e != hipSuccess) fprintf(stderr, "kernel_launch: cooperative launch failed: %s (grid %d)\n", hipGetErrorString(e), grid);
#endif
#if DBG_DUMP
    { const size_t off = DBG_DUMP == 1 ? WS_H : (DBG_DUMP == 2 ? WS_BR : (DBG_DUMP == 3 ? WS_P : WS_FT0));
      hipLaunchKernelGGL(dbg_dump, dim3(2048), dim3(256), 0, stream, (const bf16_t*)((unsigned char*)d_ws + off), (float*)d_out, (size_t)(DBG_DUMP == 4 ? 8 : 16) * 1024 * 1024); }
#endif
}
```

```cpp
#include <hip/hip_runtime.h>
#include <hip/hip_cooperative_groups.h>
#include <cstdio>
#include <cstdint>
namespace cg = cooperative_groups;

#ifndef PROBE_ATT
#define PROBE_ATT 0
#endif
#ifndef PROBE_FOUR
#define PROBE_FOUR 0
#endif
#ifndef DUP_MASK
#define DUP_MASK 0
#endif
#ifndef MK_MULTI_LAUNCH
#define MK_MULTI_LAUNCH 0
#endif

#define LAS __attribute__((address_space(3)))
#define GAS __attribute__((address_space(1)))
typedef unsigned short bf16_t;
typedef short bf16x8 __attribute__((ext_vector_type(8)));
typedef short s16x4 __attribute__((ext_vector_type(4)));
typedef float f32x4 __attribute__((ext_vector_type(4)));
typedef float f32x16 __attribute__((ext_vector_type(16)));
typedef unsigned u32x4 __attribute__((ext_vector_type(4)));
typedef unsigned u32x2 __attribute__((ext_vector_type(2)));

constexpr int D = 1024, NB = 8, SEQ = 2048, CTXL = 256, DFF = 2816;
constexpr int ML = NB * SEQ;
constexpr int MC = NB * CTXL;
constexpr int MT = ML + MC;
constexpr int DIN = 5632;
constexpr int NIN = 5888;
constexpr int NP1 = 2816;
constexpr int LDP = 2304;
constexpr int PCB = 0, PCC = 256, PCX = 512, PQ = 768, PK = 1280, PV = 1792;
constexpr float QSCALE = 0.125f * 1.4426950408889634f;
constexpr float EPS = 1e-6f;

constexpr size_t MiB = 1u << 20;
constexpr size_t WS_MOD = 0;
constexpr size_t WS_ROPE = 448 * 1024;
constexpr size_t WS_BIASIN = 464 * 1024;
constexpr size_t WS_LAM = 1020 * 1024;
constexpr size_t WS_DFT256 = 1 * MiB;
constexpr size_t WS_DFT = 2 * MiB;
constexpr size_t WS_XC = 18 * MiB;
constexpr size_t WS_WIN = 26 * MiB;
constexpr size_t WS_WB = WS_WIN + 5888 * 1024 * 2;
constexpr size_t WS_WOUT = WS_WB + 2 * MiB;
constexpr size_t WS_WGU0 = WS_WOUT + 2 * MiB;
constexpr size_t WS_WD0 = WS_WGU0 + 11 * MiB;
constexpr size_t WS_WGU1 = WS_WD0 + 5632 * 1024;
constexpr size_t WS_WD1 = WS_WGU1 + 11 * MiB;
constexpr size_t WS_H = 75 * MiB;
constexpr size_t WS_BR = 111 * MiB;
constexpr size_t WS_P = 147 * MiB;
constexpr size_t WS_FT0 = WS_WGU1, WS_FT1 = WS_WGU0, WS_FTC = WS_XC;
constexpr size_t WS_BAR = 255 * MiB;
constexpr size_t WS_END = 255 * MiB + 65536;
static_assert(WS_WD1 + 5632 * 1024 <= WS_H && WS_FT0 + 16 * MiB <= WS_H && WS_FT1 + 16 * MiB <= WS_WGU1, "ws map");
static_assert((size_t)MT * LDP * 2 <= 81 * MiB && (size_t)MT * 3072 * 2 <= 108 * MiB, "ws map");

constexpr int LDS_BYTES = 147456;
constexpr int LDS_XB = 144384;
constexpr int LDS_COSTAB = 131072;

typedef float f32x2_t __attribute__((ext_vector_type(2))); typedef __bf16 bf16x2_t __attribute__((ext_vector_type(2)));
__device__ __forceinline__ unsigned cvt_pk_bf16(float lo, float hi) { f32x2_t v = {lo, hi}; bf16x2_t b = __builtin_convertvector(v, bf16x2_t); return __builtin_bit_cast(unsigned, b); }
__device__ __forceinline__ unsigned f2bf(float f) { unsigned u = __float_as_uint(f); return (u + 0x7fffu + ((u >> 16) & 1u)) >> 16; }
__device__ __forceinline__ unsigned pk2(float lo, float hi) { return f2bf(lo) | (f2bf(hi) << 16); }
__device__ __forceinline__ float bflo(unsigned w) { return __uint_as_float(w << 16); }
__device__ __forceinline__ float bfhi(unsigned w) { return __uint_as_float(w & 0xffff0000u); }
__device__ __forceinline__ float fast_exp2(float x) { return __builtin_amdgcn_exp2f(x); }
__device__ __forceinline__ float fast_rcp(float x) { return __builtin_amdgcn_rcpf(x); }
__device__ __forceinline__ float sigmoidf_(float x) { return fast_rcp(1.0f + fast_exp2(-1.4426950408889634f * x)); }
__device__ __forceinline__ float wave_sum(float v) {
#pragma unroll
    for (int o = 1; o < 64; o <<= 1) v += __shfl_xor(v, o);
    return v;
}

namespace pg8 {
constexpr int BM = 256, BK = 64, HALF = 128, HTB = HALF * BK * 2, STAGE_BYTES = 8 * HTB, NXCD = 8, WGM = 4;
__host__ __device__ __forceinline__ int lds_byte(int r, int c) { const int st = (r >> 4) * 2 + (c >> 5), rr = r & 15, cc = c & 31, ob = rr * 64 + cc * 2; return st * 1024 + (ob ^ (((ob >> 9) & 1) << 5)); }
__host__ __device__ __forceinline__ void stage_rc(int b, int& R, int& C) { const int st = b / 1024, sb = b % 1024, swz = sb ^ (((sb >> 9) & 1) << 5); R = (st >> 1) * 16 + swz / 64; C = (st & 1) * 32 + (swz % 64) / 2; }
__host__ __device__ __forceinline__ int perm32(int rho) { const int n = rho >> 4, i = rho & 15; return 8 * (i >> 2) + 4 * n + (i & 3); }
struct Unit { int pm, pn; };
struct Gemm { const bf16_t* A; const bf16_t* Bt; int M, N, K, lda, ldb; };
struct StaticOrder {
    int nM, nN, nwg, G, c;
    __device__ void init(int M, int N, int G_, int c_) { nM = M / BM; nN = N / BM; nwg = nM * nN; G = G_; c = c_; }
    __device__ bool next(int i, Unit& u) const {
        const long L = (long)i * G + c; if (L >= nwg) return false;
        int wgid = (int)L; { const int q = nwg / NXCD, r = nwg % NXCD, xcd = wgid % NXCD, off = wgid / NXCD; wgid = (xcd < r ? xcd * (q + 1) : r * (q + 1) + (xcd - r) * q) + off; }
        const int nig = WGM * nN, gid = wgid / nig, fm = gid * WGM, gsz = (nM - fm) < WGM ? (nM - fm) : WGM;
        u.pm = fm + ((wgid % nig) % gsz); u.pn = (wgid % nig) / gsz; return true;
    }
};

template <class Epi, class Sched>
__device__ __forceinline__ void gemm_phase(LAS unsigned char* lds, const Gemm g, const Sched& S, const Epi& E, const int tid) {
    const int wid = __builtin_amdgcn_readfirstlane(tid >> 6), lane = tid & 63, wr = wid >> 2, wc = wid & 3, fr = lane & 15, fq = lane >> 4;
    const int K = g.K, nt = K / BK;
    unsigned voffA[2], voffB[2];
#pragma unroll
    for (int i = 0; i < 2; ++i) { int R, C; stage_rc(tid * 16 + i * 8192, R, C); const int Rb = (R & ~31) + perm32(R & 31);
        voffA[i] = (unsigned)(R * g.lda + C) * 2u; voffB[i] = (unsigned)(Rb * g.ldb + C) * 2u; }
    const size_t kstep = (size_t)(BK * 2);
    const size_t hA = (size_t)HALF * g.lda * 2, hB = (size_t)HALF * g.ldb * 2;
    const size_t tA = 2 * hA, tB = 2 * hB;
    const unsigned ldsw = (unsigned)wid * 1024u;
    const int aoff = lds_byte(wr * 64 + fr, fq * 8), boff = lds_byte(wc * 32 + fr, fq * 8);
#define PG8_SA(b, h) (((b) * 2 + (h)) * HTB)
#define PG8_SB(b, h) ((4 + (b) * 2 + (h)) * HTB)
#define PG8_STAGE(bufoff, gbase, voff) do { _Pragma("unroll") for (int _i = 0; _i < 2; ++_i) \
        __builtin_amdgcn_global_load_lds((const unsigned*)((const char*)(gbase) + (voff)[_i]), (LAS unsigned*)(lds + (bufoff) + ldsw + _i * 8192), 16, 0, 0); } while (0)
#define PG8_LDA(dst, b, h) do { _Pragma("unroll") for (int m = 0; m < 4; ++m) _Pragma("unroll") for (int k = 0; k < 2; ++k) dst[m][k] = *(const LAS bf16x8*)(lds + PG8_SA(b, h) + aoff + m * 2048 + k * 1024); } while (0)
#define PG8_LDB(dst, b, h) do { _Pragma("unroll") for (int n = 0; n < 2; ++n) _Pragma("unroll") for (int k = 0; k < 2; ++k) dst[n][k] = *(const LAS bf16x8*)(lds + PG8_SB(b, h) + boff + n * 2048 + k * 1024); } while (0)
#define PG8_MMA(ai, bj, At, Bt) do { __builtin_amdgcn_s_setprio(1); _Pragma("unroll") for (int m = 0; m < 4; ++m) _Pragma("unroll") for (int n = 0; n < 2; ++n) _Pragma("unroll") for (int k = 0; k < 2; ++k) \
        acc[ai][bj][m][n] = __builtin_amdgcn_mfma_f32_16x16x32_bf16(Bt[n][k], At[m][k], acc[ai][bj][m][n], 0, 0, 0); __builtin_amdgcn_s_setprio(0); } while (0)
#define PG8_WAIT_V(n) asm volatile("s_waitcnt vmcnt(" #n ")" ::: "memory")
#define PG8_WAIT_L(n) asm volatile("s_waitcnt lgkmcnt(" #n ")" ::: "memory")
#define PG8_BAR __builtin_amdgcn_s_barrier()
#define PG8_SCHED __builtin_amdgcn_sched_barrier(0)
    Unit cur, nxt; int ui = 0;
    if (!S.next(0, cur)) return;
    const bool hz = E.horner();
    f32x4 acc[2][2][4][2];
#pragma unroll
    for (int a = 0; a < 2; ++a)
#pragma unroll
        for (int b = 0; b < 2; ++b)
#pragma unroll
            for (int m = 0; m < 4; ++m)
#pragma unroll
                for (int n = 0; n < 2; ++n) acc[a][b][m][n] = (f32x4){0.f, 0.f, 0.f, 0.f};
    bf16x8 At[4][2], B0[2][2], B1[2][2];
    const char* cA = (const char*)g.A + (size_t)cur.pm * tA; const char* cB = (const char*)g.Bt + (size_t)cur.pn * tB;
    PG8_STAGE(PG8_SB(0, 0), cB, voffB); PG8_STAGE(PG8_SB(0, 1), cB + hB, voffB); PG8_STAGE(PG8_SA(0, 0), cA, voffA); PG8_STAGE(PG8_SA(0, 1), cA + hA, voffA);
    if (wr == 1) PG8_BAR;
    PG8_WAIT_V(2); PG8_BAR;
    PG8_STAGE(PG8_SB(1, 0), cB + kstep, voffB); PG8_STAGE(PG8_SA(1, 0), cA + kstep, voffA); PG8_STAGE(PG8_SB(1, 1), cB + hB + kstep, voffB);
    PG8_WAIT_V(6); PG8_BAR;
    for (;;) {
        const bool has_next = S.next(ui + 1, nxt);
        const char* nA = has_next ? (const char*)g.A + (size_t)nxt.pm * tA : cA; const char* nB = has_next ? (const char*)g.Bt + (size_t)nxt.pn * tB : cB;
        for (int t = 0; t < nt; t += 2) {
            if (hz && (t == 4 || t == 8)) E.mid(acc, cur, t >> 3, wr, wc, fr, fq);
            const bool last = (t == nt - 2);
            const char* a1 = cA + (size_t)(t + 1) * kstep;
            const char* a2 = last ? nA : cA + (size_t)(t + 2) * kstep; const char* b2 = last ? nB : cB + (size_t)(t + 2) * kstep;
            const char* a3 = a2 + kstep; const char* b3 = b2 + kstep;
            PG8_LDB(B0, 0, 0); PG8_LDB(B1, 0, 1); PG8_SCHED; PG8_LDA(At, 0, 0); PG8_STAGE(PG8_SA(1, 1), a1 + hA, voffA);
            PG8_WAIT_V(8); PG8_WAIT_L(0); PG8_BAR; PG8_MMA(0, 0, At, B0); PG8_MMA(0, 1, At, B1); PG8_BAR; PG8_SCHED;
            PG8_LDA(At, 0, 1); PG8_STAGE(PG8_SB(0, 0), b2, voffB); PG8_STAGE(PG8_SB(0, 1), b2 + hB, voffB); PG8_STAGE(PG8_SA(0, 0), a2, voffA);
            PG8_WAIT_V(8); PG8_WAIT_L(0); PG8_BAR; PG8_MMA(1, 0, At, B0); PG8_MMA(1, 1, At, B1); PG8_BAR; PG8_SCHED;
            PG8_LDB(B0, 1, 0); PG8_LDB(B1, 1, 1); PG8_SCHED; PG8_LDA(At, 1, 0); PG8_STAGE(PG8_SA(0, 1), a2 + hA, voffA);
            PG8_WAIT_V(8); PG8_WAIT_L(0); PG8_BAR; PG8_MMA(0, 0, At, B0); PG8_MMA(0, 1, At, B1); PG8_BAR; PG8_SCHED;
            PG8_LDA(At, 1, 1); PG8_STAGE(PG8_SB(1, 0), b3, voffB); PG8_STAGE(PG8_SB(1, 1), b3 + hB, voffB); PG8_STAGE(PG8_SA(1, 0), a3, voffA);
            PG8_WAIT_V(8); PG8_WAIT_L(0); PG8_BAR; PG8_MMA(1, 0, At, B0); PG8_MMA(1, 1, At, B1); PG8_BAR; PG8_SCHED;
        }
        if (wr == 0) PG8_BAR;
        E(acc, cur, wr, wc, fr, fq);
        if (!has_next) break;
#pragma unroll
        for (int a = 0; a < 2; ++a)
#pragma unroll
            for (int b = 0; b < 2; ++b)
#pragma unroll
                for (int m = 0; m < 4; ++m)
#pragma unroll
                    for (int n = 0; n < 2; ++n) acc[a][b][m][n] = (f32x4){0.f, 0.f, 0.f, 0.f};
        cur = nxt; cA = nA; cB = nB; ++ui;
        if (wr == 1) PG8_BAR;
    }
    PG8_WAIT_V(0);
    PG8_BAR;
#undef PG8_SA
#undef PG8_SB
#undef PG8_STAGE
#undef PG8_LDA
#undef PG8_LDB
#undef PG8_MMA
#undef PG8_WAIT_V
#undef PG8_WAIT_L
#undef PG8_BAR
#undef PG8_SCHED
}
}

enum { E_INPROJ = 0, E_GATE = 1, E_BRANCH = 2, E_RESID = 3, E_GU = 4, E_FOUR = 5 };
constexpr int LDS_EPI = 143360;
struct EpiD {
    int mode;
    int row_base;
    int ctx;
    int aux;
    float scale;
    int pad;
    void* out;
    const void* p1;
    const void* p2;
    void* p3; void* p4;
};
#define RFL2(x) ((unsigned)__builtin_amdgcn_readfirstlane((int)(x)))
struct Epi {
    const LAS unsigned* ed;
    __device__ __forceinline__ bool horner() const { return __builtin_amdgcn_readfirstlane((int)ed[0]) == E_BRANCH; }
    __device__ __forceinline__ void mid(f32x4 (&acc)[2][2][4][2], const pg8::Unit& u, int which, int wr, int wc, int fr, int fq) const {
        asm volatile("" : "+v"(fr), "+v"(fq));
        const int row_base = __builtin_amdgcn_readfirstlane((int)ed[1]);
        const unsigned lo = (unsigned)__builtin_amdgcn_readfirstlane((int)ed[8]), hi_ = (unsigned)__builtin_amdgcn_readfirstlane((int)ed[9]);
        const bf16_t* gbase = (const bf16_t*)(((unsigned long long)hi_ << 32) | lo) + (size_t)(row_base + u.pm * 256 + wr * 64 + fr) * 3072 + which * 1024 + u.pn * 256 + wc * 32 + 8 * fq;
#pragma unroll
        for (int ai = 0; ai < 2; ++ai) {
            u32x4 na[4][2], nb[4][2];
#pragma unroll
            for (int m = 0; m < 4; ++m)
#pragma unroll
                for (int bj = 0; bj < 2; ++bj) { const bf16_t* gp = gbase + (size_t)(ai * 128 + m * 16) * 3072 + bj * 128; na[m][bj] = *(const GAS u32x4*)gp; nb[m][bj] = *(const GAS u32x4*)(gp + 1024); }
            __builtin_amdgcn_sched_barrier(0);
#pragma unroll
            for (int m = 0; m < 4; ++m)
#pragma unroll
                for (int bj = 0; bj < 2; ++bj) {
                    const u32x4 xa = na[m][bj], xb = nb[m][bj];
                    f32x4 r0, r1;
                    r0[0] = bflo(xa.x) * fast_rcp(bflo(xb.x)); r0[1] = bfhi(xa.x) * fast_rcp(bfhi(xb.x)); r0[2] = bflo(xa.y) * fast_rcp(bflo(xb.y)); r0[3] = bfhi(xa.y) * fast_rcp(bfhi(xb.y));
                    r1[0] = bflo(xa.z) * fast_rcp(bflo(xb.z)); r1[1] = bfhi(xa.z) * fast_rcp(bfhi(xb.z)); r1[2] = bflo(xa.w) * fast_rcp(bflo(xb.w)); r1[3] = bfhi(xa.w) * fast_rcp(bfhi(xb.w));
                    acc[ai][bj][m][0] = acc[ai][bj][m][0] * r0; acc[ai][bj][m][1] = acc[ai][bj][m][1] * r1;
                }
            __builtin_amdgcn_sched_barrier(0);
        }
    }
    __device__ __forceinline__ void operator()(const f32x4 (&acc)[2][2][4][2], const pg8::Unit& u, int wr, int wc, int fr, int fq) const {
        asm volatile("" : "+v"(fr), "+v"(fq));
#define RFL(x) ((unsigned)__builtin_amdgcn_readfirstlane((int)(x)))
        const int mode = (int)RFL(ed[0]), row_base = (int)RFL(ed[1]), ctx = (int)RFL(ed[2]), aux = (int)RFL(ed[3]);
        const float scale = __uint_as_float(RFL(ed[4]));
        void* const out = (void*)(((unsigned long long)RFL(ed[7]) << 32) | RFL(ed[6]));
        const void* const p1 = (const void*)(((unsigned long long)RFL(ed[9]) << 32) | RFL(ed[8]));
        const void* const p2 = (const void*)(((unsigned long long)RFL(ed[11]) << 32) | RFL(ed[10]));
#undef RFL
        const int r0 = u.pm * 256 + wr * 64 + fr;
        const int c0 = wc * 32 + 8 * fq;
        const int colt = u.pn * 256;
        if (mode == E_INPROJ) {
            const int ct = aux + u.pn;
            const float* bias = (const float*)p1;
            if (ct < 2) {
                const int gpm = (row_base >> 8) + u.pm;
                bf16_t* dst; int ld, n0;
                if (ctx) { const int b = gpm - 64; dst = (bf16_t*)(((unsigned long long)RFL2(ed[15]) << 32) | RFL2(ed[14])) + (size_t)(b * 256) * 512 + ct * 256; ld = 512; n0 = 0; }
                else { const int b = gpm >> 3; dst = (bf16_t*)(((unsigned long long)RFL2(ed[13]) << 32) | RFL2(ed[12])) + (size_t)(b * 256) * 4096 + ct * 2048; ld = 4096; n0 = (gpm & 7) * 256; }
                LAS unsigned char* stg = (LAS unsigned char*)ed - LDS_EPI + 131072 + (wr * 4 + wc) * 1536;
                const int lane_ = fq * 16 + fr, tcol = lane_ >> 1, thalf = lane_ & 1;
#pragma unroll
                for (int bj = 0; bj < 2; ++bj) {
                    const f32x4 b0 = *(const GAS f32x4*)(bias + colt + bj * 128 + c0), b1 = *(const GAS f32x4*)(bias + colt + bj * 128 + c0 + 4);
                    bf16_t* dcol = dst + (size_t)(bj * 128 + wc * 32 + tcol) * ld + n0 + wr * 64 + thalf * 8;
#pragma unroll
                    for (int ai = 0; ai < 2; ++ai)
#pragma unroll
                        for (int m = 0; m < 4; ++m) {
                            const f32x4 v0 = acc[ai][bj][m][0] + b0, v1 = acc[ai][bj][m][1] + b1;
                            LAS bf16_t* sp = (LAS bf16_t*)stg + (fq * 8) * 16 + fr;
                            sp[0 * 16] = (bf16_t)f2bf(v0[0]); sp[1 * 16] = (bf16_t)f2bf(v0[1]); sp[2 * 16] = (bf16_t)f2bf(v0[2]); sp[3 * 16] = (bf16_t)f2bf(v0[3]);
                            sp[4 * 16] = (bf16_t)f2bf(v1[0]); sp[5 * 16] = (bf16_t)f2bf(v1[1]); sp[6 * 16] = (bf16_t)f2bf(v1[2]); sp[7 * 16] = (bf16_t)f2bf(v1[3]);
                            asm volatile("s_waitcnt lgkmcnt(0)" ::: "memory");
                            const u32x4 w = *(const LAS u32x4*)(stg + tcol * 32 + thalf * 16);
                            *(GAS u32x4*)(dcol + ai * 128 + m * 16) = w;
                            asm volatile("s_waitcnt lgkmcnt(0)" ::: "memory");
                        }
                }
            } else {
                const bool isqk = (ct >= 5 && ct <= 8), dorope = isqk && !ctx;
                const float sc = (ct == 5 || ct == 6) ? QSCALE : 1.0f;
                const int axis = wc & 1, half = fq >> 1;
                const float* rope = (const float*)p2 + 8 * (fq & 1);
                bf16_t* obase = (bf16_t*)out + (size_t)(row_base + r0) * LDP + (ct - 2) * 256 + c0;
#pragma unroll
                for (int bj = 0; bj < 2; ++bj) {
                    const f32x4 b0 = *(const GAS f32x4*)(bias + colt + bj * 128 + c0), b1 = *(const GAS f32x4*)(bias + colt + bj * 128 + c0 + 4);
#pragma unroll
                    for (int ai = 0; ai < 2; ++ai)
#pragma unroll
                        for (int m = 0; m < 4; ++m) {
                            f32x4 v0 = acc[ai][bj][m][0] + b0, v1 = acc[ai][bj][m][1] + b1;
                            if (dorope) {
                                const int t = (row_base + r0 + ai * 128 + m * 16) & 2047, pos = axis ? (t & 63) : (t >> 6);
                                const float* cp = rope + pos * 16;
                                const f32x4 cs0 = *(const GAS f32x4*)cp, cs1 = *(const GAS f32x4*)(cp + 4), sn0 = *(const GAS f32x4*)(cp + 1024), sn1 = *(const GAS f32x4*)(cp + 1028);
                                f32x4 w0, w1;
#pragma unroll
                                for (int j = 0; j < 4; ++j) { w0[j] = __shfl_xor(v0[j], 32); w1[j] = __shfl_xor(v1[j], 32); }
                                if (half) { v0 = v0 * cs0 + w0 * sn0; v1 = v1 * cs1 + w1 * sn1; }
                                else { v0 = v0 * cs0 - w0 * sn0; v1 = v1 * cs1 - w1 * sn1; }
                            }
                            v0 = v0 * sc; v1 = v1 * sc;
                            u32x4 w; w.x = cvt_pk_bf16(v0[0], v0[1]); w.y = cvt_pk_bf16(v0[2], v0[3]); w.z = cvt_pk_bf16(v1[0], v1[1]); w.w = cvt_pk_bf16(v1[2], v1[3]);
                            *(GAS u32x4*)(obase + (size_t)(ai * 128 + m * 16) * LDP + bj * 128) = w;
                        }
                }
            }
        } else if (mode == E_GATE) {
            const float* bias = (const float*)p1;
            bf16_t* obase = (bf16_t*)out + (size_t)(row_base + r0) * 3072 + colt + c0;
#pragma unroll
            for (int bj = 0; bj < 2; ++bj) {
                const f32x4 b0 = *(const GAS f32x4*)(bias + colt + bj * 128 + c0), b1 = *(const GAS f32x4*)(bias + colt + bj * 128 + c0 + 4);
#pragma unroll
                for (int ai = 0; ai < 2; ++ai)
#pragma unroll
                    for (int m = 0; m < 4; ++m) {
                        f32x4 v0 = acc[ai][bj][m][0] + b0, v1 = acc[ai][bj][m][1] + b1;
#pragma unroll
                        for (int j = 0; j < 4; ++j) { v0[j] = fmaxf(sigmoidf_(v0[j]), 1e-18f); v1[j] = fmaxf(sigmoidf_(v1[j]), 1e-18f); }
                        u32x4 w; w.x = cvt_pk_bf16(v0[0], v0[1]); w.y = cvt_pk_bf16(v0[2], v0[3]); w.z = cvt_pk_bf16(v1[0], v1[1]); w.w = cvt_pk_bf16(v1[2], v1[3]);
                        *(GAS u32x4*)(obase + (size_t)(ai * 128 + m * 16) * 3072 + bj * 128) = w;
                    }
            }
        } else if (mode == E_BRANCH) {
            const bf16_t* gbase = (const bf16_t*)p1 + (size_t)(row_base + r0) * 3072 + 2048 + colt + c0;
            bf16_t* ybase = (bf16_t*)out + (size_t)(row_base + r0) * 1024 + colt + c0;
            u32x4 gw[2][4][2];
#pragma unroll
            for (int ai = 0; ai < 2; ++ai)
#pragma unroll
                for (int m = 0; m < 4; ++m)
#pragma unroll
                    for (int bj = 0; bj < 2; ++bj) gw[ai][m][bj] = *(const GAS u32x4*)(gbase + (size_t)(ai * 128 + m * 16) * 3072 + bj * 128);
            __builtin_amdgcn_sched_barrier(0);
#pragma unroll
            for (int ai = 0; ai < 2; ++ai)
#pragma unroll
                for (int m = 0; m < 4; ++m) {
#pragma unroll
                    for (int bj = 0; bj < 2; ++bj) {
                        const u32x4 g = gw[ai][m][bj];
                        const f32x4 g0 = (f32x4){bflo(g.x), bfhi(g.x), bflo(g.y), bfhi(g.y)}, g1 = (f32x4){bflo(g.z), bfhi(g.z), bflo(g.w), bfhi(g.w)};
                        const f32x4 y0 = g0 * acc[ai][bj][m][0], y1 = g1 * acc[ai][bj][m][1];
                        u32x4 w; w.x = cvt_pk_bf16(y0[0], y0[1]); w.y = cvt_pk_bf16(y0[2], y0[3]); w.z = cvt_pk_bf16(y1[0], y1[1]); w.w = cvt_pk_bf16(y1[2], y1[3]);
                        *(GAS u32x4*)(ybase + (size_t)(ai * 128 + m * 16) * 1024 + bj * 128) = w;
                    }
                }
        } else if (mode == E_RESID) {
            const float* xin = (const float*)p1 + (size_t)r0 * 1024 + colt + c0;
            float* xout = (float*)out + (size_t)r0 * 1024 + colt + c0;
            const int b = ctx ? 8 : (u.pm >> 3);
            const float* modg = (const float*)p2 + (size_t)b * 6144 + colt + c0;
            f32x4 gv[2][2];
#pragma unroll
            for (int bj = 0; bj < 2; ++bj) { gv[bj][0] = *(const GAS f32x4*)(modg + bj * 128); gv[bj][1] = *(const GAS f32x4*)(modg + bj * 128 + 4); }
#pragma unroll
            for (int ai = 0; ai < 2; ++ai) {
                f32x4 xv[4][2][2];
#pragma unroll
                for (int m = 0; m < 4; ++m)
#pragma unroll
                    for (int bj = 0; bj < 2; ++bj) { const float* xi = xin + (size_t)(ai * 128 + m * 16) * 1024 + bj * 128; xv[m][bj][0] = *(const GAS f32x4*)xi; xv[m][bj][1] = *(const GAS f32x4*)(xi + 4); }
                __builtin_amdgcn_sched_barrier(0);
#pragma unroll
                for (int m = 0; m < 4; ++m)
#pragma unroll
                    for (int bj = 0; bj < 2; ++bj) { float* xo = xout + (size_t)(ai * 128 + m * 16) * 1024 + bj * 128;
                        *(GAS f32x4*)xo = xv[m][bj][0] + gv[bj][0] * acc[ai][bj][m][0]; *(GAS f32x4*)(xo + 4) = xv[m][bj][1] + gv[bj][1] * acc[ai][bj][m][1]; }
                __builtin_amdgcn_sched_barrier(0);
            }
        } else if (mode == E_GU) {
            bf16_t* obase = (bf16_t*)out + (size_t)(row_base + r0) * DFF + u.pn * 128 + c0;
#pragma unroll
            for (int ai = 0; ai < 2; ++ai)
#pragma unroll
                for (int m = 0; m < 4; ++m) {
                    f32x4 v0, v1;
#pragma unroll
                    for (int j = 0; j < 4; ++j) { const float a = acc[ai][0][m][0][j], b = acc[ai][0][m][1][j];
                        v0[j] = a * sigmoidf_(a) * acc[ai][1][m][0][j]; v1[j] = b * sigmoidf_(b) * acc[ai][1][m][1][j]; }
                    u32x4 w; w.x = cvt_pk_bf16(v0[0], v0[1]); w.y = cvt_pk_bf16(v0[2], v0[3]); w.z = cvt_pk_bf16(v1[0], v1[1]); w.w = cvt_pk_bf16(v1[2], v1[3]);
                    *(GAS u32x4*)(obase + (size_t)(ai * 128 + m * 16) * DFF) = w;
                }
        } else {
            const int L = ctx ? CTXL : SEQ;
            bf16_t* obase = (bf16_t*)out + (size_t)(row_base + u.pn * L + r0) * 1024 + c0;
#pragma unroll
            for (int ai = 0; ai < 2; ++ai)
#pragma unroll
                for (int m = 0; m < 4; ++m) {
#pragma unroll
                    for (int bj = 0; bj < 2; ++bj) {
                        const f32x4 v0 = acc[ai][bj][m][0] * scale, v1 = acc[ai][bj][m][1] * scale;
                        u32x4 w; w.x = cvt_pk_bf16(v0[0], v0[1]); w.y = cvt_pk_bf16(v0[2], v0[3]); w.z = cvt_pk_bf16(v1[0], v1[1]); w.w = cvt_pk_bf16(v1[2], v1[3]);
                        *(GAS u32x4*)(obase + (size_t)(ai * 128 + m * 16) * 1024 + bj * 128) = w;
                    }
                }
        }
    }
};

struct Args {
    const float* in[25];
    float* out; unsigned char* ws;
    int ph_lo, ph_hi;
};
enum { I_X = 0, I_C, I_CTX, I_CCTX, I_WADA, I_BADA, I_N1G, I_N2G, I_WIN, I_BIN, I_CONVW, I_CONVB, I_WFO, I_WCO, I_WAO, I_LQ1, I_LK1, I_LQ2, I_LK2, I_SUBG, I_WOUT, I_WG, I_WU, I_WD, I_FING };

struct Frame {
    LAS unsigned char* lds;
    int tid, lane, wave, G, bx, vcu, rot;
};

struct GJob { const bf16_t* A; const bf16_t* Bt; int lda, ldb, M, N, K, rot; int gfirst, gsub; EpiD E; };
__device__ __forceinline__ void gemm_call(Frame& F, const GJob& j) {
    pg8::Gemm g{j.A, j.Bt, j.M, j.N, j.K, j.lda, j.ldb};
    if (j.rot >= 0) F.rot = j.rot % F.G;
    pg8::StaticOrder S; int c = F.bx - F.rot; if (c < 0) c += F.G;
    int Ge = F.G;
    if (j.gsub > 0) { Ge = j.gsub; c = F.bx - j.gfirst; if (c < 0 || c >= j.gsub) c = 1 << 28; }
    S.init(j.M, j.N, Ge, c);
    if (F.tid == 0) { LAS unsigned* d = (LAS unsigned*)(F.lds + LDS_EPI);
        const unsigned long long o_ = (unsigned long long)j.E.out, a_ = (unsigned long long)j.E.p1, b_ = (unsigned long long)j.E.p2;
        d[0] = (unsigned)j.E.mode; d[1] = (unsigned)j.E.row_base; d[2] = (unsigned)j.E.ctx; d[3] = (unsigned)j.E.aux; d[4] = __float_as_uint(j.E.scale); d[5] = 0u;
        d[6] = (unsigned)o_; d[7] = (unsigned)(o_ >> 32); d[8] = (unsigned)a_; d[9] = (unsigned)(a_ >> 32); d[10] = (unsigned)b_; d[11] = (unsigned)(b_ >> 32);
        const unsigned long long c_ = (unsigned long long)j.E.p3, e_ = (unsigned long long)j.E.p4; d[12] = (unsigned)c_; d[13] = (unsigned)(c_ >> 32); d[14] = (unsigned)e_; d[15] = (unsigned)(e_ >> 32); }
    __syncthreads();
    Epi E{(const LAS unsigned*)(F.lds + LDS_EPI)};
    pg8::gemm_phase<Epi, pg8::StaticOrder>(F.lds, g, S, E, F.tid);
    F.rot = (F.rot + (j.M / 256) * (j.N / 256)) % F.G;
}

__device__ __forceinline__ void tr_item(const float* src, int ldsrc, bf16_t* dst, int ldd, LAS float* scr, int lane) {
#pragma unroll 8
    for (int i = 0; i < 32; ++i) { const int kk = 2 * i + (lane >> 5); scr[kk * 33 + (lane & 31)] = src[(size_t)kk * ldsrc + (lane & 31)]; }
    asm volatile("s_waitcnt lgkmcnt(0)" ::: "memory");
    const int c = lane & 7;
#pragma unroll
    for (int j = 0; j < 4; ++j) { const int n = (lane >> 3) + 8 * j; const LAS float* s = scr + (8 * c) * 33 + n;
        u32x4 o; o.x = pk2(s[0 * 33], s[1 * 33]); o.y = pk2(s[2 * 33], s[3 * 33]); o.z = pk2(s[4 * 33], s[5 * 33]); o.w = pk2(s[6 * 33], s[7 * 33]);
        *(u32x4*)(dst + (size_t)n * ldd + 8 * c) = o; }
    asm volatile("s_waitcnt lgkmcnt(0)" ::: "memory");
}

__device__ __forceinline__ void conv_setA(Frame& F, const Args& a, int l, int pidx, int pcnt, int part) {
    unsigned char* ws = a.ws;
    bf16_t* Win = (bf16_t*)(ws + WS_WIN); bf16_t* Wb = (bf16_t*)(ws + WS_WB); bf16_t* Wout = (bf16_t*)(ws + WS_WOUT);
    const float* w_in = a.in[I_WIN] + (size_t)l * D * DIN;
    LAS float* scr = (LAS float*)(F.lds + F.wave * 16384);
    const int gw = pidx * 8 + F.wave, NGW = pcnt * 8;
    constexpr int I1 = 16 * 168, I2 = 128, I3 = 128, I4 = 256, I5 = 512;
    for (int it = gw; it < I1 + I2 + I3 + I4 + I5; it += NGW) {
        int r = it;
        if (r < I1) { const int kb = r / 168, nb = r % 168, k0 = kb * 64, n0 = 256 + nb * 32;
            if (!((part >> (nb >= 72 ? 1 : 0)) & 1)) continue;
            tr_item(w_in + (size_t)k0 * DIN + n0, DIN, Win + (size_t)(n0 + 256) * 1024 + k0, 1024, scr, F.lane); continue; } r -= I1;
        if (!(part & 2)) break;
        if (r < I2) { const int kb = r / 32, nb = r % 32; tr_item(a.in[I_WFO] + (size_t)l * 256 * D + (size_t)kb * 64 * D + nb * 32, D, Wb + (size_t)(nb * 32) * 1024 + kb * 64, 1024, scr, F.lane); continue; } r -= I2;
        if (r < I3) { const int kb = r / 32, nb = r % 32; tr_item(a.in[I_WCO] + (size_t)l * 256 * D + (size_t)kb * 64 * D + nb * 32, D, Wb + (size_t)(nb * 32) * 1024 + 256 + kb * 64, 1024, scr, F.lane); continue; } r -= I3;
        if (r < I4) { const int kb = r / 32, nb = r % 32; tr_item(a.in[I_WAO] + (size_t)l * 512 * D + (size_t)kb * 64 * D + nb * 32, D, Wb + (size_t)(nb * 32) * 1024 + 512 + kb * 64, 1024, scr, F.lane); continue; } r -= I4;
        { const int kb = r / 32, nb = r % 32; tr_item(a.in[I_WOUT] + (size_t)l * D * D + (size_t)kb * 64 * D + nb * 32, D, Wout + (size_t)(nb * 32) * 1024 + kb * 64, 1024, scr, F.lane); }
    }
    if (!(part & 1)) return;
    const LAS float* ct = (const LAS float*)(F.lds + LDS_COSTAB);
    const int gt = pidx * 512 + F.tid, NGT = pcnt * 512;
    for (int o = gt; o < 1024 * 128; o += NGT) {
        const int k = o & 1023, g = (o >> 10) & 3, mq = o >> 12;
        const float* wp = w_in + (size_t)k * DIN + g * 64;
        f32x4 wv[16];
#pragma unroll
        for (int i = 0; i < 16; ++i) wv[i] = *(const f32x4*)(wp + 4 * i);
#pragma unroll 1
        for (int mm = 0; mm < 2; ++mm) {
            const int m = mq * 2 + mm; float sc = 0.f, ss = 0.f;
#pragma unroll
            for (int j = 0; j < 64; ++j) { const int i = ((j * m) & 63) * 32; const float w = wv[j >> 2][j & 3]; sc += w * ct[i]; ss += w * ct[(i + 1536) & 2047]; }
            Win[(size_t)(g * 64 + m) * 1024 + k] = (bf16_t)f2bf(sc * 0.125f);
            Win[(size_t)(256 + g * 64 + m) * 1024 + k] = (bf16_t)f2bf(ss * 0.125f);
        }
    }
    float* bi = (float*)(ws + WS_BIASIN) + l * NIN; const float* b_in = a.in[I_BIN] + (size_t)l * DIN;
    for (int r = gt; r < NIN; r += NGT) {
        float v;
        if (r < 512) { const int pt = r >> 8, g = (r >> 6) & 3, m = r & 63; float s_ = 0.f;
            for (int j = 0; j < 64; ++j) { const int i = (j * m) & 63; s_ += b_in[g * 64 + j] * ct[(i * 32 + (pt ? 1536 : 0)) & 2047]; }
            v = s_ * 0.125f; }
        else v = b_in[r - 256];
        bi[r] = v;
    }
}
__device__ __forceinline__ void conv_setB(Frame& F, const Args& a, int l, int pidx, int pcnt) {
    unsigned char* ws = a.ws;
    bf16_t* Wgu = (bf16_t*)(ws + (l ? WS_WGU1 : WS_WGU0)); bf16_t* Wd = (bf16_t*)(ws + (l ? WS_WD1 : WS_WD0));
    LAS float* scr = (LAS float*)(F.lds + F.wave * 16384);
    const int gw = pidx * 8 + F.wave, NGW = pcnt * 8;
    constexpr int J1 = 16 * 88, J3 = 44 * 32;
    for (int it = gw; it < 2 * J1 + J3; it += NGW) {
        int r = it;
        if (r < 2 * J1) { const int up = r >= J1; if (up) r -= J1; const int kb = r / 88, nb = r % 88, n0 = nb * 32;
            const float* W = a.in[up ? I_WU : I_WG] + (size_t)l * D * DFF;
            tr_item(W + (size_t)kb * 64 * DFF + n0, DFF, Wgu + (size_t)((n0 >> 7) * 256 + up * 128 + (n0 & 127)) * 1024 + kb * 64, 1024, scr, F.lane); continue; }
        r -= 2 * J1;
        { const int kb = r / 32, nb = r % 32; tr_item(a.in[I_WD] + (size_t)l * DFF * D + (size_t)kb * 64 * D + nb * 32, D, Wd + (size_t)(nb * 32) * DFF + kb * 64, DFF, scr, F.lane); }
    }
}

__device__ __forceinline__ void norm_row(const float* xrow, const float* g, const float* sh, const float* sc, bf16_t* orow, float* fout, int lane) {
    f32x4 v[4]; float s = 0.f;
#pragma unroll
    for (int j = 0; j < 4; ++j) { v[j] = *((const f32x4*)xrow + lane + 64 * j); s += (v[j].x * v[j].x + v[j].y * v[j].y) + (v[j].z * v[j].z + v[j].w * v[j].w); }
    const float rstd = 1.0f / sqrtf(wave_sum(s) * (1.0f / D) + EPS);
#pragma unroll
    for (int j = 0; j < 4; ++j) {
        const int c = (lane + 64 * j) * 4;
        f32x4 y = v[j] * rstd * *(const f32x4*)(g + c);
        if (fout) { *(f32x4*)(fout + c) = y; }
        else { y = y * (*(const f32x4*)(sc + c) + 1.0f) + *(const f32x4*)(sh + c);
            u32x2 w; w.x = cvt_pk_bf16(y.x, y.y); w.y = cvt_pk_bf16(y.z, y.w); *(u32x2*)(orow + c) = w; }
    }
}
__device__ __forceinline__ void norm_phase(Frame& F, const float* xl, const float* xc, const float* g, const float* mod, int sh_off, int sc_off, bf16_t* H, bool with_ctx) {
    const int gw = F.vcu * 8 + F.wave, NGW = F.G * 8, nrows = with_ctx ? MT : ML;
    for (int r = gw; r < nrows; r += NGW) {
        const int b = r < ML ? (r >> 11) : 8;
        const float* xr = r < ML ? xl + (size_t)r * D : xc + (size_t)(r - ML) * D;
        norm_row(xr, g, mod + (size_t)b * 6144 + sh_off, mod + (size_t)b * 6144 + sc_off, H + (size_t)r * D, nullptr, F.lane);
    }
}

__device__ __forceinline__ int crow(int r, int hi) { return (r & 3) + 8 * (r >> 2) + 4 * hi; }
__device__ __forceinline__ s16x4 vtr(const LAS unsigned char* p) { return __builtin_bit_cast(s16x4, __builtin_amdgcn_ds_read_tr16_b64_v4i16((LAS s16x4*)p)); }
constexpr int AT_WSF = 131072;
__device__ __forceinline__ void at_softmax(f32x16& p0, f32x16& p1, f32x16& negm, float& mhat, float& lsum, f32x16 (&o)[4], bf16x8 (&pa)[4], LAS float* wsf, bool first, int r32, int hi) {
    float rm = fmaxf(fmaxf(p0[0], p0[1]), p1[0]);
    { float rb = fmaxf(fmaxf(p0[2], p0[3]), p1[1]); rm = fmaxf(fmaxf(rm, p1[2]), p1[3]);
#pragma unroll
      for (int r = 4; r < 16; r += 4) { rm = fmaxf(fmaxf(rm, p0[r]), p0[r + 1]); rb = fmaxf(fmaxf(rb, p0[r + 2]), p0[r + 3]); rm = fmaxf(fmaxf(rm, p1[r]), p1[r + 1]); rb = fmaxf(fmaxf(rb, p1[r + 2]), p1[r + 3]); }
      rm = fmaxf(rm, rb); }
    rm = fmaxf(rm, __shfl_xor(rm, 32));
    const bool need = first || (rm > 6.0f);
    if (__any(need)) {
        const float dl = need ? rm : 0.f;
        mhat += dl;
#pragma unroll
        for (int r = 0; r < 16; ++r) { p0[r] -= dl; p1[r] -= dl; negm[r] = -mhat; }
        if (!first) {
            const float f = fast_exp2(-dl);
            lsum *= f;
            asm volatile("" ::: "memory");
            if (hi == 0) wsf[r32] = f;
            asm volatile("s_waitcnt lgkmcnt(0)" ::: "memory");
#pragma unroll
            for (int r = 0; r < 16; ++r) { const float fr_ = wsf[crow(r, hi)];
#pragma unroll
                for (int d0 = 0; d0 < 4; ++d0) o[d0][r] *= fr_; }
            asm volatile("s_waitcnt lgkmcnt(0)" ::: "memory");
        }
    }
    f32x2_t ls2 = (f32x2_t){0.f, 0.f};
#pragma unroll
    for (int r = 0; r < 16; r += 2) { p0[r] = fast_exp2(p0[r]); p0[r + 1] = fast_exp2(p0[r + 1]); p1[r] = fast_exp2(p1[r]); p1[r + 1] = fast_exp2(p1[r + 1]);
        ls2 += (f32x2_t){p0[r], p0[r + 1]}; ls2 += (f32x2_t){p1[r], p1[r + 1]}; }
    lsum += ls2.x + ls2.y;
    u32x4 w;
    w.x = cvt_pk_bf16(p0[0], p0[1]); w.y = cvt_pk_bf16(p0[2], p0[3]); w.z = cvt_pk_bf16(p0[4], p0[5]); w.w = cvt_pk_bf16(p0[6], p0[7]); pa[0] = __builtin_bit_cast(bf16x8, w);
    w.x = cvt_pk_bf16(p0[8], p0[9]); w.y = cvt_pk_bf16(p0[10], p0[11]); w.z = cvt_pk_bf16(p0[12], p0[13]); w.w = cvt_pk_bf16(p0[14], p0[15]); pa[1] = __builtin_bit_cast(bf16x8, w);
    w.x = cvt_pk_bf16(p1[0], p1[1]); w.y = cvt_pk_bf16(p1[2], p1[3]); w.z = cvt_pk_bf16(p1[4], p1[5]); w.w = cvt_pk_bf16(p1[6], p1[7]); pa[2] = __builtin_bit_cast(bf16x8, w);
    w.x = cvt_pk_bf16(p1[8], p1[9]); w.y = cvt_pk_bf16(p1[10], p1[11]); w.z = cvt_pk_bf16(p1[12], p1[13]); w.w = cvt_pk_bf16(p1[14], p1[15]); pa[3] = __builtin_bit_cast(bf16x8, w);
}
__device__ __forceinline__ void attn_unit(Frame& F, const bf16_t* P, bf16_t* BR, int qrow0, int base1, int n1, int base2, int nt, int h, float lam, float oscale, const float* subg) {
    LAS unsigned char* lds = F.lds;
    const int tid = F.tid, lane = F.lane, wid = F.wave, r32 = lane & 31, hi = lane >> 5, qg = wid & 3, comp = wid >> 2;
    bf16x8 qf[4];
    { const bf16_t* qp = P + (size_t)(qrow0 + qg * 32 + r32) * LDP + PQ + h * 128 + comp * 64 + hi * 8;
#pragma unroll
      for (int d0 = 0; d0 < 4; ++d0) qf[d0] = *(const bf16x8*)(qp + d0 * 16); }
    int ksrc[2], kdst[2], vsrc[2], vdst[2];
#pragma unroll
    for (int i = 0; i < 2; ++i) { const int pc = wid * 2 + i;
        { const int cmp = pc >> 3, rg = pc & 7, row = rg * 8 + (lane >> 3), c8 = (lane & 7) ^ (lane >> 3); ksrc[i] = row * LDP + PK + h * 128 + cmp * 64 + c8 * 8; kdst[i] = cmp * 8192 + rg * 1024; }
        { const int d0 = pc >> 2, rg = pc & 3; vsrc[i] = (rg * 16 + (lane >> 2)) * LDP + PV + h * 128 + d0 * 32 + (lane & 3) * 8; vdst[i] = 16384 + d0 * 4096 + rg * 1024; } }
#define AT_TROW(t) ((t) < n1 ? base1 + 64 * (t) : base2 + 64 * ((t) - n1))
    LAS float* wsf = (LAS float*)(lds + AT_WSF) + wid * 64;
    float mhat = 0.f, lsum = 0.f;
    f32x16 negm;
#pragma unroll
    for (int r = 0; r < 16; ++r) negm[r] = 0.f;
    f32x16 o[4];
#pragma unroll
    for (int d0 = 0; d0 < 4; ++d0)
#pragma unroll
        for (int r = 0; r < 16; ++r) o[d0][r] = 0.f;
    bf16x8 pa[4];
#pragma unroll
    for (int i = 0; i < 4; ++i) pa[i] = (bf16x8){0, 0, 0, 0, 0, 0, 0, 0};
    s16x4 va[8], vb[8];
#pragma unroll
    for (int i = 0; i < 8; ++i) { va[i] = (s16x4){0, 0, 0, 0}; vb[i] = (s16x4){0, 0, 0, 0}; }
    const int vlane = ((lane >> 4) & 1) * 32 + (lane & 3) * 8 + (4 * hi + ((lane & 15) >> 2)) * 64;
    const int klane = comp * 8192 + r32 * 128;
    int koff[4];
#pragma unroll
    for (int d0 = 0; d0 < 4; ++d0) koff[d0] = ((2 * d0 + hi) ^ (r32 & 7)) * 16;
#define AT_SB() __builtin_amdgcn_sched_barrier(0)
#define AT_DMA4(t, OFF) do { const bf16_t* tp = P + (size_t)AT_TROW(t) * LDP; \
        __builtin_amdgcn_global_load_lds((const unsigned*)(tp + ksrc[0]), (LAS unsigned*)(lds + (OFF) + kdst[0]), 16, 0, 0); \
        __builtin_amdgcn_global_load_lds((const unsigned*)(tp + ksrc[1]), (LAS unsigned*)(lds + (OFF) + kdst[1]), 16, 0, 0); \
        __builtin_amdgcn_global_load_lds((const unsigned*)(tp + vsrc[0]), (LAS unsigned*)(lds + (OFF) + vdst[0]), 16, 0, 0); \
        __builtin_amdgcn_global_load_lds((const unsigned*)(tp + vsrc[1]), (LAS unsigned*)(lds + (OFF) + vdst[1]), 16, 0, 0); } while (0)
#define AT_VF(x, s) ((bf16x8){x[2 * (s)][0], x[2 * (s)][1], x[2 * (s)][2], x[2 * (s)][3], x[2 * (s) + 1][0], x[2 * (s) + 1][1], x[2 * (s) + 1][2], x[2 * (s) + 1][3]})
#define AT_TR(dst, addr, off) asm volatile("ds_read_b64_tr_b16 %0, %1 offset:%c2" : "=&v"(dst) : "v"(addr), "i"(off) : "memory")
    const unsigned ldsb = (unsigned)(unsigned long long)lds;
#define AT_VPRE(OFF) do { const unsigned vp_ = ldsb + (OFF) + 16384 + vlane; \
        _Pragma("unroll") for (int s_ = 0; s_ < 4; ++s_) { AT_TR(va[2 * s_], vp_, s_ * 1024); AT_TR(va[2 * s_ + 1], vp_, s_ * 1024 + 512); AT_TR(vb[2 * s_], vp_, 4096 + s_ * 1024); AT_TR(vb[2 * s_ + 1], vp_, 4096 + s_ * 1024 + 512); } } while (0)
#define AT_PVMMA(OFF) do { const unsigned vp_ = ldsb + (OFF) + 16384 + vlane; \
        asm volatile("s_waitcnt lgkmcnt(0)" ::: "memory"); AT_SB(); __builtin_amdgcn_s_setprio(1); \
        _Pragma("unroll") for (int s_ = 0; s_ < 4; ++s_) { \
            o[0] = __builtin_amdgcn_mfma_f32_32x32x16_bf16(pa[s_], AT_VF(va, s_), o[0], 0, 0, 0); \
            o[1] = __builtin_amdgcn_mfma_f32_32x32x16_bf16(pa[s_], AT_VF(vb, s_), o[1], 0, 0, 0); \
            AT_SB(); \
            AT_TR(va[2 * s_], vp_, 8192 + s_ * 1024); AT_TR(va[2 * s_ + 1], vp_, 8192 + s_ * 1024 + 512); AT_TR(vb[2 * s_], vp_, 12288 + s_ * 1024); AT_TR(vb[2 * s_ + 1], vp_, 12288 + s_ * 1024 + 512); \
            AT_SB(); } \
        asm volatile("s_waitcnt lgkmcnt(0)" ::: "memory"); AT_SB(); \
        _Pragma("unroll") for (int s_ = 0; s_ < 4; ++s_) { \
            o[2] = __builtin_amdgcn_mfma_f32_32x32x16_bf16(pa[s_], AT_VF(va, s_), o[2], 0, 0, 0); \
            o[3] = __builtin_amdgcn_mfma_f32_32x32x16_bf16(pa[s_], AT_VF(vb, s_), o[3], 0, 0, 0); } \
        __builtin_amdgcn_s_setprio(0); AT_SB(); } while (0)
#define AT_STEP(t, CUR, NX2, PRV) do { \
        if ((t) + 2 < nt) AT_DMA4((t) + 2, NX2); \
        if (comp == 1 && (t) > 0) AT_PVMMA(PRV); \
        f32x16 p0, p1; \
        {   bf16x8 kf[8]; const LAS unsigned char* kb = lds + (CUR) + klane; \
            _Pragma("unroll") for (int d0 = 0; d0 < 4; ++d0) { kf[2 * d0] = *(const LAS bf16x8*)(kb + koff[d0]); kf[2 * d0 + 1] = *(const LAS bf16x8*)(kb + koff[d0] + 4096); } \
            AT_SB(); __builtin_amdgcn_s_setprio(1); \
            p0 = __builtin_amdgcn_mfma_f32_32x32x16_bf16(kf[0], qf[0], negm, 0, 0, 0); \
            p1 = __builtin_amdgcn_mfma_f32_32x32x16_bf16(kf[1], qf[0], negm, 0, 0, 0); \
            _Pragma("unroll") for (int d0 = 1; d0 < 4; ++d0) { \
                p0 = __builtin_amdgcn_mfma_f32_32x32x16_bf16(kf[2 * d0], qf[d0], p0, 0, 0, 0); \
                p1 = __builtin_amdgcn_mfma_f32_32x32x16_bf16(kf[2 * d0 + 1], qf[d0], p1, 0, 0, 0); } __builtin_amdgcn_s_setprio(0); } \
        AT_SB(); \
        AT_VPRE(CUR); \
        AT_SB(); \
        at_softmax(p0, p1, negm, mhat, lsum, o, pa, wsf, (t) == 0, r32, hi); \
        AT_SB(); \
        if (comp == 0) AT_PVMMA(CUR); \
          \
        if ((t) + 2 < nt) asm volatile("s_waitcnt vmcnt(4)" ::: "memory"); else asm volatile("s_waitcnt vmcnt(0)" ::: "memory"); \
        AT_SB(); __builtin_amdgcn_s_barrier(); AT_SB(); } while (0)
    AT_DMA4(0, 0);
    if (nt > 1) AT_DMA4(1, 32768);
    if (nt > 1) asm volatile("s_waitcnt vmcnt(4)" ::: "memory"); else asm volatile("s_waitcnt vmcnt(0)" ::: "memory");
    __syncthreads();
#pragma unroll 1
    for (int t = 0; t < nt; t += 4) {
        AT_STEP(t, 0, 65536, 98304);
        if (t + 1 < nt) AT_STEP(t + 1, 32768, 98304, 0);
        if (t + 2 < nt) AT_STEP(t + 2, 65536, 0, 32768);
        if (t + 3 < nt) AT_STEP(t + 3, 98304, 32768, 65536);
    }
    if (comp == 1) { const int lo_ = ((nt - 1) & 3) * 32768; AT_PVMMA(lo_); }
    __syncthreads();
#undef AT_STEP
#undef AT_PVMMA
#undef AT_VPRE
#undef AT_TR
#undef AT_VF
#undef AT_DMA4
#undef AT_SB
    lsum += __shfl_xor(lsum, 32);
    { float inv = 1.0f / lsum; if (comp) inv *= lam;
      asm volatile("" ::: "memory");
      if (hi == 0) wsf[r32] = inv;
      asm volatile("s_waitcnt lgkmcnt(0)" ::: "memory");
#pragma unroll
      for (int r = 0; r < 16; ++r) { const float fr_ = wsf[crow(r, hi)];
#pragma unroll
          for (int d0 = 0; d0 < 4; ++d0) o[d0][r] *= fr_; } }
    LAS float* X = (LAS float*)lds + qg * (32 * 132);
    if (comp == 1) {
#pragma unroll
        for (int d0 = 0; d0 < 4; ++d0)
#pragma unroll
            for (int r = 0; r < 16; ++r) X[crow(r, hi) * 132 + d0 * 32 + r32] = o[d0][r];
    }
    __syncthreads();
    if (comp == 0) {
#pragma unroll
        for (int d0 = 0; d0 < 4; ++d0)
#pragma unroll
            for (int r = 0; r < 16; ++r) { const int ix = crow(r, hi) * 132 + d0 * 32 + r32; X[ix] = o[d0][r] - X[ix]; }
        asm volatile("s_waitcnt lgkmcnt(0)" ::: "memory");
        const int row = lane >> 1, hf = lane & 1;
        const LAS float* xr = X + row * 132 + hf * 64;
        float ss = 0.f;
#pragma unroll
        for (int c = 0; c < 16; ++c) { const f32x4 v = *(const LAS f32x4*)(xr + c * 4); ss += (v.x * v.x + v.y * v.y) + (v.z * v.z + v.w * v.w); }
        ss += __shfl_xor(ss, 1);
        const float rstd = oscale / sqrtf(ss * (1.0f / 128.0f) + EPS);
        bf16_t* op = BR + (size_t)(qrow0 + qg * 32 + row) * 1024 + 512 + h * 128 + hf * 64;
        const float* gp = subg + hf * 64;
#pragma unroll
        for (int c = 0; c < 8; ++c) {
            const f32x4 v0 = *(const LAS f32x4*)(xr + c * 8) * rstd * *(const f32x4*)(gp + c * 8), v1 = *(const LAS f32x4*)(xr + c * 8 + 4) * rstd * *(const f32x4*)(gp + c * 8 + 4);
            u32x4 w; w.x = cvt_pk_bf16(v0.x, v0.y); w.y = cvt_pk_bf16(v0.z, v0.w); w.z = cvt_pk_bf16(v1.x, v1.y); w.w = cvt_pk_bf16(v1.z, v1.w);
            *(u32x4*)(op + c * 8) = w;
        }
    }
    __syncthreads();
#undef AT_TROW
}

__device__ __forceinline__ void norm_rows4(const float* x0, size_t xstride, const float* g, const float* sh, const float* sc, bf16_t* o0, size_t ostride, float* fout, int lane) {
    f32x4 v[4][4]; float ss[4];
#pragma unroll
    for (int r = 0; r < 4; ++r)
#pragma unroll
        for (int j = 0; j < 4; ++j) v[r][j] = *((const f32x4*)(x0 + (size_t)r * xstride) + lane + 64 * j);
#pragma unroll
    for (int r = 0; r < 4; ++r) { float s = 0.f;
#pragma unroll
        for (int j = 0; j < 4; ++j) s += (v[r][j].x * v[r][j].x + v[r][j].y * v[r][j].y) + (v[r][j].z * v[r][j].z + v[r][j].w * v[r][j].w);
        ss[r] = 1.0f / sqrtf(wave_sum(s) * (1.0f / D) + EPS); }
#pragma unroll
    for (int j = 0; j < 4; ++j) {
        const int c = (lane + 64 * j) * 4;
        const f32x4 gv = *(const f32x4*)(g + c);
        if (fout) {
#pragma unroll
            for (int r = 0; r < 4; ++r) *(f32x4*)(fout + (size_t)r * xstride + c) = v[r][j] * ss[r] * gv;
        } else {
            const f32x4 m1 = *(const f32x4*)(sc + c) + 1.0f, sv = *(const f32x4*)(sh + c);
#pragma unroll
            for (int r = 0; r < 4; ++r) { const f32x4 y = v[r][j] * ss[r] * gv * m1 + sv;
                u32x2 w; w.x = cvt_pk_bf16(y.x, y.y); w.y = cvt_pk_bf16(y.z, y.w); *(u32x2*)(o0 + (size_t)r * ostride + c) = w; }
        }
    }
}
__device__ __forceinline__ void norm_phase4(Frame& F, const float* xl, const float* xc, const float* g, const float* mod, int sh_off, int sc_off, bf16_t* H, bool with_ctx) {
    const int gw = F.vcu * 8 + F.wave, NGW = F.G * 8, nrows = with_ctx ? MT : ML;
    for (int r = gw * 4; r < nrows; r += NGW * 4) {
        const int b = r < ML ? (r >> 11) : 8;
        const float* xr = r < ML ? xl + (size_t)r * D : xc + (size_t)(r - ML) * D;
        norm_rows4(xr, D, g, mod + (size_t)b * 6144 + sh_off, mod + (size_t)b * 6144 + sc_off, H + (size_t)r * D, D, nullptr, F.lane);
    }
}
#define XB_TMO      128
#define XB_XCNT(j)  (256  + 64 * (j))
#define XB_XSUB(j)  (1280 + 64 * (j))
#define XB_XGEN(j)  (2304 + 64 * (j))
#define XB_TOP      3328
#define XB_TOPGEN   3392
#define XCD_BAR_WORDS 3456
#define XB_SPIN_CAP (1u << 18)
__device__ __forceinline__ unsigned xb_ld(unsigned* p)              { return __hip_atomic_load(p, __ATOMIC_RELAXED, __HIP_MEMORY_SCOPE_AGENT); }
__device__ __forceinline__ unsigned xb_add(unsigned* p, unsigned v) { return __hip_atomic_fetch_add(p, v, __ATOMIC_RELAXED, __HIP_MEMORY_SCOPE_AGENT); }
__device__ __forceinline__ unsigned xb_xcc_id() { return (unsigned)__builtin_amdgcn_s_getreg((3 << 11) | 20) & 0xFu; }
#define XB_SPIN(cond, bar) do { unsigned _sp = 0; while (cond) { __builtin_amdgcn_s_sleep(1); \
    if ((++_sp & 255u) == 0u) { if (xb_ld(&(bar)[XB_TMO])) break; if (_sp > XB_SPIN_CAP) { atomicAdd(&(bar)[XB_TMO], 1u); break; } } } } while (0)
struct XcdBarrier { unsigned* bar; unsigned x; volatile LAS unsigned* st; };
__device__ __forceinline__ XcdBarrier xcd_barrier_post(unsigned* bar, volatile LAS unsigned* st) {
    XcdBarrier b; b.bar = bar; b.x = xb_xcc_id(); b.st = st;
    if (threadIdx.x == 0) (void)xb_add(&bar[XB_XCNT(b.x)], 1u);
    return b;
}
__device__ __forceinline__ void xcd_barrier_complete(unsigned* bar, unsigned x, unsigned& nloc, unsigned& nx) {
    const unsigned G = gridDim.x * gridDim.y * gridDim.z;
    unsigned sum, cnt, mine, sp = 0u;
    for (;;) {
        sum = 0u; cnt = 0u; mine = 0u;
#pragma unroll
        for (unsigned j = 0; j < 16; ++j) { const unsigned c = xb_ld(&bar[XB_XCNT(j)]); sum += c; cnt += (c > 0u) ? 1u : 0u; mine = (j == x) ? c : mine; }
        if (sum == G) break;
        __builtin_amdgcn_s_sleep(1);
        if ((++sp & 255u) == 0u) { if (xb_ld(&bar[XB_TMO])) break; if (sp > XB_SPIN_CAP) { atomicAdd(&bar[XB_TMO], 1u); break; } }
    }
    nloc = mine > 0u ? mine : 1u; nx = cnt > 0u ? cnt : 1u;
}
__device__ __forceinline__ void xcd_barrier(const XcdBarrier& b) {
    asm volatile("s_waitcnt vmcnt(0)" ::: "memory");
    __syncthreads();
    if (threadIdx.x == 0) {
        unsigned* bar = b.bar;
        __builtin_amdgcn_s_waitcnt(0);
        unsigned nloc = b.st[0], nx = b.st[1];
        if (nloc == 0u) { xcd_barrier_complete(bar, b.x, nloc, nx); b.st[0] = nloc; b.st[1] = nx; }
        const unsigned old = xb_add(&bar[XB_XSUB(b.x)], 1u);
        const unsigned gen = old / nloc;
        if (old + 1u == (gen + 1u) * nloc) {
            __builtin_amdgcn_fence(__ATOMIC_RELEASE, "agent");
            asm volatile("s_waitcnt vmcnt(0)" ::: "memory");
            const unsigned og = xb_add(&bar[XB_TOP], 1u);
            const unsigned tg = og / nx;
            if (og + 1u == (tg + 1u) * nx) xb_add(&bar[XB_TOPGEN], 1u);
            else XB_SPIN(xb_ld(&bar[XB_TOPGEN]) == tg, bar);
            __builtin_amdgcn_fence(__ATOMIC_ACQUIRE, "agent");
            xb_add(&bar[XB_XGEN(b.x)], 1u);
            asm volatile("s_waitcnt vmcnt(0)" ::: "memory");
        } else {
            XB_SPIN(xb_ld(&bar[XB_XGEN(b.x)]) == gen, bar);
            __builtin_amdgcn_fence(__ATOMIC_ACQUIRE, "agent");
            asm volatile("s_waitcnt vmcnt(0)" ::: "memory");
        }
    }
    __syncthreads();
}

constexpr int N_PHASES = 20;
__global__ void __launch_bounds__(512, 2) fwd_kernel(Args args) {
    extern __shared__ __attribute__((aligned(16))) unsigned char lds_raw[];
    Frame F;
    F.lds = (LAS unsigned char*)lds_raw;
    F.tid = threadIdx.x; F.lane = F.tid & 63; F.wave = __builtin_amdgcn_readfirstlane(F.tid >> 6);
    F.G = gridDim.x; F.bx = blockIdx.x; F.vcu = (F.G % 8 == 0) ? (F.bx % 8) * (F.G / 8) + F.bx / 8 : F.bx; F.rot = 0;
    unsigned char* const ws = args.ws;
    float* const XL = args.out;
    if (F.tid < 2) ((LAS unsigned*)(F.lds + LDS_XB))[F.tid] = 0u;
    __syncthreads();
    if (args.ph_hi - args.ph_lo > 1) (void)xcd_barrier_post((unsigned*)(ws + WS_BAR), (volatile LAS unsigned*)(F.lds + LDS_XB));
#define WSP(T, off) ((T*)(ws + (off)))
#pragma unroll 1
    for (int ph = args.ph_lo, rep = 0; ph < args.ph_hi;) {
#define REFRESH_LANE() do { int l_ = (int)__builtin_amdgcn_mbcnt_hi(~0u, __builtin_amdgcn_mbcnt_lo(~0u, 0u)); asm volatile("" : "+v"(l_)); F.lane = l_; F.tid = F.wave * 64 + l_; } while (0)
        REFRESH_LANE();
        const int kind = ph < 2 ? ph : 2 + (ph - 2) % 9;
        const int l = ph < 2 ? 0 : (ph - 2) / 9;
        const bool last = (l == 1);
        const float* mod = WSP(float, WS_MOD) + (size_t)l * 9 * 6144;
        const float* biasin = WSP(float, WS_BIASIN) + l * NIN;
        if (kind == 0) {
            LAS float* ct = (LAS float*)(F.lds + LDS_COSTAB);
            for (int i = F.tid; i < 2048; i += 512) ct[i] = cospif((float)i * (1.0f / 1024.0f));
            __syncthreads();
        }
        if (kind == 0) {
            if (F.bx < 192) {
                LAS float* sv = (LAS float*)F.lds;
                LAS float* red = (LAS float*)(F.lds + 40960);
                for (int i = F.tid; i < 9 * 1024; i += 512) { const int r = i >> 10, k = i & 1023; const float c = r < 8 ? args.in[I_C][r * 1024 + k] : args.in[I_CCTX][k]; sv[i] = c / (1.0f + __expf(-c)); }
                __syncthreads();
                for (int job = F.bx; job < 192; job += F.G) {
                    const int jl = job / 96, n0 = (job % 96) * 64, kg = F.tid >> 6, nn = F.tid & 63;
                    const float* wp = args.in[I_WADA] + (size_t)jl * D * 6144 + (size_t)(kg * 128) * 6144 + n0 + nn;
                    float ac[9];
#pragma unroll
                    for (int r = 0; r < 9; ++r) ac[r] = 0.f;
#pragma unroll 1
                    for (int k0 = 0; k0 < 128; k0 += 16) {
                        float wv[16];
#pragma unroll
                        for (int i = 0; i < 16; ++i) wv[i] = wp[(size_t)(k0 + i) * 6144];
#pragma unroll
                        for (int i = 0; i < 16; ++i)
#pragma unroll
                            for (int r = 0; r < 9; ++r) ac[r] += sv[r * 1024 + kg * 128 + k0 + i] * wv[i]; }
#pragma unroll
                    for (int r = 0; r < 9; ++r) red[(kg * 9 + r) * 64 + nn] = ac[r];
                    __syncthreads();
                    for (int o = F.tid; o < 576; o += 512) { const int r = o >> 6, n = o & 63; float s = args.in[I_BADA][jl * 6144 + n0 + n];
#pragma unroll
                        for (int q = 0; q < 8; ++q) s += red[(q * 9 + r) * 64 + n];
                        WSP(float, WS_MOD)[((size_t)jl * 9 + r) * 6144 + n0 + n] = s; }
                    __syncthreads();
                }
            }
            __syncthreads();
            if (F.bx == F.G - 1) {
                float* ROPE = WSP(float, WS_ROPE);
                for (int i = F.tid; i < 1024; i += 512) { const int pos = i >> 4, f = i & 15; const float fr = powf(10000.0f, -(float)f * (1.0f / 16.0f)); const float ang = (float)pos * fr; ROPE[i] = cosf(ang); ROPE[1024 + i] = sinf(ang); }
                if (F.tid < 2) { const int jl = F.tid; float s1 = 0.f, s2 = 0.f;
                    for (int j = 0; j < 64; ++j) { s1 += args.in[I_LQ1][jl * 64 + j] * args.in[I_LK1][jl * 64 + j]; s2 += args.in[I_LQ2][jl * 64 + j] * args.in[I_LK2][jl * 64 + j]; }
                    WSP(float, WS_LAM)[jl] = expf(s1) - expf(s2) + (0.8f - 0.6f * expf(-0.3f * (float)jl)); }
            }
            __syncthreads();
        }
        if (kind == 0) { REFRESH_LANE(); conv_setA(F, args, 0, F.vcu, F.G, 1); }
        if (kind == 1 || kind == 7 || (kind == 10 && !last)) {
            REFRESH_LANE();
            const bool n2 = (kind == 7);
            const float* xl = (kind == 1) ? args.in[I_X] : XL;
            const float* xc = (kind == 1) ? args.in[I_CTX] : WSP(float, WS_XC);
            const float* g = n2 ? args.in[I_N2G] + l * 1024 : args.in[I_N1G] + (kind == 10 ? 1024 : 0);
            const float* m = (kind == 10) ? WSP(float, WS_MOD) + (size_t)9 * 6144 : mod;
            norm_phase4(F, xl, xc, g, m, n2 ? 3072 : 0, n2 ? 4096 : 1024, n2 ? WSP(bf16_t, WS_BR) : WSP(bf16_t, WS_H), n2 ? !last : true);
        }
        if (kind == 10 && last) {
            REFRESH_LANE();
            const int gw = F.vcu * 8 + F.wave, NGW = F.G * 8;
            for (int r = gw * 4; r < ML; r += NGW * 4) norm_rows4(XL + (size_t)r * D, D, args.in[I_FING], nullptr, nullptr, nullptr, 0, XL + (size_t)r * D, F.lane);
        }
        if (kind == 3) {
            const float lam = WSP(float, WS_LAM)[l]; const float osc = 1.0f - (0.8f - 0.6f * expf(-0.3f * (float)l)); const float* subg = args.in[I_SUBG] + l * 128;
            const bf16_t* P = WSP(bf16_t, WS_P); bf16_t* BR = WSP(bf16_t, WS_BR);
            const int npairs = (2 * F.vcu < 512) ? (512 - 2 * F.vcu + 2 * F.G - 1) / (2 * F.G) : 0, nlat = 2 * npairs;
#pragma unroll 1
            for (int rp = 0; rp <= PROBE_ATT; ++rp)
#pragma unroll 1
            for (int i = 0;; ++i) {
                int qrow0, base1, n1, base2, nt, h;
                if (i < nlat) { const int un = (i >> 1) * 2 * F.G + 2 * F.vcu + (i & 1); const int bh = un >> 4, qb = un & 15, b = bh >> 2; h = bh & 3;
                    qrow0 = b * SEQ + qb * 128; base1 = b * SEQ; n1 = 32; base2 = ML + b * CTXL; nt = 36; }
                else { const int cu = F.vcu + (i - nlat) * F.G; if (last || cu >= 64) break; const int bh = cu >> 1, qb = cu & 1, b = bh >> 2; h = bh & 3;
                    qrow0 = ML + b * CTXL + qb * 128; base1 = ML + b * CTXL; n1 = 4; base2 = 0; nt = 4; }
                REFRESH_LANE();
                attn_unit(F, P, BR, qrow0, base1, n1, base2, nt, h, lam, osc, subg);
            }
        }
#pragma unroll 1
        for (int j = 0; j < 4; ++j) {
            GJob J{}; bool have = false;
            J.lda = 1024; J.ldb = 1024; J.K = 1024; J.rot = -1;
            if (kind == 2) {
                if (j < 2) { have = true; J.A = WSP(bf16_t, WS_H) + (j ? (size_t)ML * 1024 : 0); J.Bt = WSP(bf16_t, WS_WIN); J.M = j ? MC : ML; J.N = NP1;
                    J.E.mode = E_INPROJ; J.E.out = WSP(bf16_t, WS_P); J.E.p1 = biasin; J.E.p2 = WSP(float, WS_ROPE); J.E.row_base = j ? ML : 0; J.E.ctx = j; J.E.aux = 0; J.E.p3 = WSP(bf16_t, (l ? WS_FT1 : WS_FT0)); J.E.p4 = WSP(bf16_t, WS_FTC);
                    if (j == 0) J.rot = 0;
                    if (j && last) { J.Bt = WSP(bf16_t, WS_WIN) + (size_t)7 * 256 * 1024; J.N = 1024; J.E.aux = 7; J.E.p1 = biasin + 7 * 256; } }
            } else if (kind == 4) {
                const int nf = (F.G >= 128) ? 64 : 0;
                if (j == 0) { have = true; J.A = WSP(bf16_t, WS_DFT); J.lda = 4096; J.Bt = WSP(bf16_t, (l ? WS_FT1 : WS_FT0)); J.ldb = 4096; J.M = 2048; J.N = 2048; J.K = 4096; J.rot = 0;
                    if (nf) { J.gfirst = 0; J.gsub = nf; }
                    J.E.mode = E_FOUR; J.E.out = WSP(bf16_t, WS_BR); J.E.row_base = 0; J.E.ctx = 0; J.E.scale = 0.02209708691207961f; }
                else if (j == 1 && !last) { have = true; J.A = WSP(bf16_t, WS_DFT256); J.lda = 512; J.Bt = WSP(bf16_t, WS_FTC); J.ldb = 512; J.M = 256; J.N = 2048; J.K = 512; J.rot = 0;
                    if (nf) { J.gfirst = nf; J.gsub = F.G - nf; }
                    J.E.mode = E_FOUR; J.E.out = WSP(bf16_t, WS_BR); J.E.row_base = ML; J.E.ctx = 1; J.E.scale = 0.0625f; }
                else if (j == 2) { have = true; J.A = WSP(bf16_t, WS_H); J.Bt = WSP(bf16_t, WS_WIN) + (size_t)NP1 * 1024; J.M = (last || nf) ? ML : MT; J.N = 3072; J.rot = 0;
                    if (nf) { J.gfirst = nf; J.gsub = F.G - nf; }
                    J.E.mode = E_GATE; J.E.out = WSP(bf16_t, WS_P); J.E.p1 = biasin + NP1; J.E.row_base = 0; }
                else if (j == 3 && !last && nf) { have = true; J.A = WSP(bf16_t, WS_H) + (size_t)ML * 1024; J.Bt = WSP(bf16_t, WS_WIN) + (size_t)NP1 * 1024; J.M = MC; J.N = 3072; J.rot = 0;
                    J.gfirst = 0; J.gsub = nf;
                    J.E.mode = E_GATE; J.E.out = WSP(bf16_t, WS_P); J.E.p1 = biasin + NP1; J.E.row_base = ML; }
            } else if (kind == 5) {
                if (j == 0) { have = true; J.A = WSP(bf16_t, WS_BR); J.Bt = WSP(bf16_t, WS_WB); J.M = last ? ML : MT; J.N = 1024; J.K = 1024; J.rot = 0;
                    J.E.mode = E_BRANCH; J.E.out = WSP(bf16_t, WS_H); J.E.p1 = WSP(bf16_t, WS_P); J.E.aux = 0; J.E.row_base = 0; }
            } else if (kind == 6 || kind == 9) {
                if (j == 0 || (j == 1 && !last)) { have = true;
                    const bool dn = (kind == 9);
                    const bf16_t* Abase = dn ? WSP(bf16_t, WS_P) : WSP(bf16_t, WS_H);
                    J.lda = dn ? DFF : 1024; J.ldb = J.lda; J.K = J.lda;
                    J.A = Abase + (j ? (size_t)ML * J.lda : 0);
                    J.Bt = dn ? WSP(bf16_t, (l ? WS_WD1 : WS_WD0)) : WSP(bf16_t, WS_WOUT);
                    J.M = j ? MC : ML; J.N = 1024; if (j == 0) J.rot = 0;
                    J.E.mode = E_RESID; J.E.ctx = j; J.E.p2 = mod + (dn ? 5120 : 2048);
                    const float* xin_l = (!dn && l == 0) ? args.in[I_X] : XL; const float* xin_c = (!dn && l == 0) ? args.in[I_CTX] : WSP(float, WS_XC);
                    J.E.p1 = j ? xin_c : xin_l; J.E.out = j ? (void*)WSP(float, WS_XC) : (void*)XL; }
            } else if (kind == 8) {
                if (j == 0) { have = true; J.A = WSP(bf16_t, WS_BR); J.Bt = WSP(bf16_t, (l ? WS_WGU1 : WS_WGU0)); J.M = last ? ML : MT; J.N = 2 * DFF; J.rot = 0;
                    J.E.mode = E_GU; J.E.out = WSP(bf16_t, WS_P); J.E.row_base = 0; }
            }
            if (!have) { if (kind == 4) continue; break; }
            REFRESH_LANE();
            gemm_call(F, J);
        }
        if (!last && kind == 2) {
            const int nskip = (F.G > 64) ? 24 : 0;
            if (F.bx >= nskip) {
                const int pidx = F.bx - nskip, pcnt = F.G - nskip;
                REFRESH_LANE();
                { LAS float* ctw = (LAS float*)(F.lds + LDS_COSTAB);
                  for (int i = F.tid; i < 2048; i += 512) ctw[i] = cospif((float)i * (1.0f / 1024.0f));
                  __syncthreads(); }
            {
              const LAS float* ct = (const LAS float*)(F.lds + LDS_COSTAB);
              bf16_t* DFT = WSP(bf16_t, WS_DFT); bf16_t* DFT256 = WSP(bf16_t, WS_DFT256);
              const int gt = pidx * 512 + F.tid, NGT = pcnt * 512;
              for (int q = gt; q < 2048 * 512; q += NGT) { const int k = q >> 9, c8 = (q & 511) * 8; unsigned w[4];
#pragma unroll
                  for (int e = 0; e < 8; e += 2) { float v[2];
#pragma unroll
                      for (int z = 0; z < 2; ++z) { const int np = c8 + e + z; v[z] = np < 2048 ? ct[(k * np) & 2047] : -ct[((k * (np - 2048)) + 1536) & 2047]; }
                      w[e >> 1] = pk2(v[0], v[1]); }
                  *(u32x4*)(DFT + (size_t)k * 4096 + c8) = (u32x4){w[0], w[1], w[2], w[3]}; }
              for (int q = gt; q < 256 * 64; q += NGT) { const int k = q >> 6, c8 = (q & 63) * 8; unsigned w[4];
#pragma unroll
                  for (int e = 0; e < 8; e += 2) { float v[2];
#pragma unroll
                      for (int z = 0; z < 2; ++z) { const int np = c8 + e + z; v[z] = np < 256 ? ct[(((k * np) & 255) * 8) & 2047] : -ct[((((k * (np - 256)) & 255) * 8) + 1536) & 2047]; }
                      w[e >> 1] = pk2(v[0], v[1]); }
                  *(u32x4*)(DFT256 + (size_t)k * 512 + c8) = (u32x4){w[0], w[1], w[2], w[3]}; } }
                __syncthreads();
                REFRESH_LANE();
                conv_setA(F, args, 0, pidx, pcnt, 2);
            }
        }
        if (!last && (kind == 6 || kind == 9)) {
            const int nskip = (F.G > 64) ? 32 : 0;
            if (F.bx >= nskip) {
                const int pidx = F.bx - nskip, pcnt = F.G - nskip;
                if (kind == 6) { REFRESH_LANE(); conv_setB(F, args, 0, pidx, pcnt); }
                else {
                    LAS float* ct = (LAS float*)(F.lds + LDS_COSTAB);
                    REFRESH_LANE();
                    for (int i = F.tid; i < 2048; i += 512) ct[i] = cospif((float)i * (1.0f / 1024.0f));
                    __syncthreads();
                    conv_setA(F, args, 1, pidx, pcnt, 3);
                    REFRESH_LANE();
                    conv_setB(F, args, 1, pidx, pcnt);
                }
            }
        }
        if (kind == 3) {
            REFRESH_LANE();
            const bf16_t* P = WSP(bf16_t, WS_P); bf16_t* BR = WSP(bf16_t, WS_BR);
            const float* cw = args.in[I_CONVW] + l * 768; const float* cb_ = args.in[I_CONVB] + l * 256;
            const int cskip = (!last && F.G >= 128) ? 64 : 0;
            const int nrows = last ? ML : MT, gt = (F.vcu - cskip) * 512 + F.tid, NGT = (F.G - cskip) * 512;
            for (int idx = (F.vcu >= cskip) ? gt : nrows * 16; idx < nrows * 16; idx += NGT) {
                const int row = (idx >> 5) * 2, c8 = (idx & 31) * 8;
                const int L = row < ML ? SEQ : CTXL, t = row < ML ? (row & (SEQ - 1)) : ((row - ML) & (CTXL - 1));
                const bf16_t* pr = P + (size_t)row * LDP;
                const u32x4 b0v = *(const u32x4*)(pr + PCB + c8), b1v = *(const u32x4*)(pr + LDP + PCB + c8);
                const u32x4 c0 = *(const u32x4*)(pr + PCC + c8), x0 = *(const u32x4*)(pr + PCX + c8), c1 = *(const u32x4*)(pr + LDP + PCC + c8), x1 = *(const u32x4*)(pr + LDP + PCX + c8);
                u32x4 cm = (u32x4){0, 0, 0, 0}, xm = cm, cp = cm, xp = cm;
                if (t > 0) { cm = *(const u32x4*)(pr - LDP + PCC + c8); xm = *(const u32x4*)(pr - LDP + PCX + c8); }
                if (t + 1 < L - 1) { cp = *(const u32x4*)(pr + 2 * LDP + PCC + c8); xp = *(const u32x4*)(pr + 2 * LDP + PCX + c8); }
                unsigned o0[4], o1[4];
#pragma unroll
                for (int e = 0; e < 4; ++e) {
                    const int c = c8 + 2 * e;
                    const float w0l = cw[c], w1l = cw[256 + c], w2l = cw[512 + c], bl = cb_[c], w0h = cw[c + 1], w1h = cw[256 + c + 1], w2h = cw[512 + c + 1], bh = cb_[c + 1];
                    const float zml = bflo(cm[e]) * bflo(xm[e]), zmh = bfhi(cm[e]) * bfhi(xm[e]);
                    const float z0l = bflo(c0[e]) * bflo(x0[e]), z0h = bfhi(c0[e]) * bfhi(x0[e]);
                    const float z1l = bflo(c1[e]) * bflo(x1[e]), z1h = bfhi(c1[e]) * bfhi(x1[e]);
                    const float zpl = bflo(cp[e]) * bflo(xp[e]), zph = bfhi(cp[e]) * bfhi(xp[e]);
                    o0[e] = cvt_pk_bf16(bflo(b0v[e]) * (w0l * zml + w1l * z0l + w2l * z1l + bl), bfhi(b0v[e]) * (w0h * zmh + w1h * z0h + w2h * z1h + bh));
                    o1[e] = cvt_pk_bf16(bflo(b1v[e]) * (w0l * z0l + w1l * z1l + w2l * zpl + bl), bfhi(b1v[e]) * (w0h * z0h + w1h * z1h + w2h * zph + bh));
                }
                *(u32x4*)(BR + (size_t)row * 1024 + 256 + c8) = (u32x4){o0[0], o0[1], o0[2], o0[3]};
                *(u32x4*)(BR + (size_t)(row + 1) * 1024 + 256 + c8) = (u32x4){o1[0], o1[1], o1[2], o1[3]};
            }
        }
        const bool dup_again = (rep == 0) && (((DUP_MASK) >> kind) & 1);
        if (ph + 1 < args.ph_hi || dup_again) {
            if (args.ph_hi > 1000) cg::this_grid().sync();
            { XcdBarrier xbar; xbar.bar = (unsigned*)(ws + WS_BAR); xbar.x = xb_xcc_id(); xbar.st = (volatile LAS unsigned*)(F.lds + LDS_XB); xcd_barrier(xbar); }
        }
        if (dup_again) rep = 1; else { rep = 0; ++ph; }
    }
#undef WSP
}


#ifndef DBG_STOP
#define DBG_STOP N_PHASES
#endif
#ifndef DBG_DUMP
#define DBG_DUMP 0
#endif
__global__ void dbg_dump(const bf16_t* src, float* out, size_t n) {
    for (size_t i = (size_t)blockIdx.x * blockDim.x + threadIdx.x; i < n; i += (size_t)gridDim.x * blockDim.x) out[i] = __uint_as_float(((unsigned)src[i]) << 16);
}
extern "C" void kernel_launch(void* const* d_in, const int* in_sizes, int n_in, void* d_out, int out_size, void* d_ws, size_t ws_size, hipStream_t stream) {
    static int grid = 0;
    if (grid == 0) {
        if (n_in != 25 || in_sizes[0] != ML * D || out_size != ML * D || ws_size < WS_END) { fprintf(stderr, "kernel_launch: unexpected shapes (n_in %d, in0 %d, out %d, ws %zu)\n", n_in, n_in > 0 ? in_sizes[0] : -1, out_size, ws_size); grid = -1; return; }
        int dev = 0, cus = 0, per_cu = 0;
        hipGetDevice(&dev); hipDeviceGetAttribute(&cus, hipDeviceAttributeMultiprocessorCount, dev);
        if (hipFuncSetAttribute((const void*)fwd_kernel, hipFuncAttributeMaxDynamicSharedMemorySize, LDS_BYTES) != hipSuccess) { fprintf(stderr, "kernel_launch: hipFuncSetAttribute failed\n"); grid = -1; return; }
        if (hipOccupancyMaxActiveBlocksPerMultiprocessor(&per_cu, (const void*)fwd_kernel, 512, LDS_BYTES) != hipSuccess || per_cu < 1) { fprintf(stderr, "kernel_launch: occupancy query says %d\n", per_cu); per_cu = 1; }
        (void)hipGetLastError();
        grid = cus * 1;
        if (grid <= 0) grid = 256;
    }
    if (grid < 0) return;
    if (hipMemsetAsync((unsigned char*)d_ws + WS_BAR, 0, 16384, stream) != hipSuccess) { fprintf(stderr, "kernel_launch: memset failed\n"); return; }
    Args a{};
    for (int i = 0; i < 25; ++i) a.in[i] = (const float*)d_in[i];
    a.out = (float*)d_out; a.ws = (unsigned char*)d_ws;
#if MK_MULTI_LAUNCH
    for (int p = 0; p < DBG_STOP; ++p) {
        a.ph_lo = p; a.ph_hi = p + 1;
        hipLaunchKernelGGL(fwd_kernel, dim3(grid), dim3(512), LDS_BYTES, stream, a);
    }
#else
    a.ph_lo = 0; a.ph_hi = DBG_STOP;
    void* kargs[] = {&a};
    hipError_t e = hipLaunchCooperativeKernel((const void*)fwd_kernel, dim3(grid), dim3(512), kargs, LDS_BYTES, stream);
    if (e != hipSuccess) fprintf(stderr, "kernel_launch: cooperative launch failed: %s (grid %d)\n", hipGetErrorString(e), grid);
#endif
#if DBG_DUMP
    { const size_t off = DBG_DUMP == 1 ? WS_H : (DBG_DUMP == 2 ? WS_BR : (DBG_DUMP == 3 ? WS_P : WS_FT0));
      hipLaunchKernelGGL(dbg_dump, dim3(2048), dim3(256), 0, stream, (const bf16_t*)((unsigned char*)d_ws + off), (float*)d_out, (size_t)(DBG_DUMP == 4 ? 8 : 16) * 1024 * 1024); }
#endif
}
```

```cpp
#include <hip/hip_runtime.h>
#include <hip/hip_cooperative_groups.h>
#include <cstdio>
#include <cstdint>
namespace cg = cooperative_groups;

#ifndef PROBE_ATT
#define PROBE_ATT 0
#endif
#ifndef PROBE_FOUR
#define PROBE_FOUR 0
#endif
#ifndef DUP_MASK
#define DUP_MASK 0
#endif
#ifndef MK_MULTI_LAUNCH
#define MK_MULTI_LAUNCH 0
#endif

#define LAS __attribute__((address_space(3)))
#define GAS __attribute__((address_space(1)))
typedef unsigned short bf16_t;
typedef short bf16x8 __attribute__((ext_vector_type(8)));
typedef short s16x4 __attribute__((ext_vector_type(4)));
typedef float f32x4 __attribute__((ext_vector_type(4)));
typedef float f32x16 __attribute__((ext_vector_type(16)));
typedef unsigned u32x4 __attribute__((ext_vector_type(4)));
typedef unsigned u32x2 __attribute__((ext_vector_type(2)));

constexpr int D = 1024, NB = 8, SEQ = 2048, CTXL = 256, DFF = 2816;
constexpr int ML = NB * SEQ;
constexpr int MC = NB * CTXL;
constexpr int MT = ML + MC;
constexpr int DIN = 5632;
constexpr int NIN = 5888;
constexpr int NP1 = 2816;
constexpr int LDP = 2304;
constexpr int PCB = 0, PCC = 256, PCX = 512, PQ = 768, PK = 1280, PV = 1792;
constexpr float QSCALE = 0.125f * 1.4426950408889634f;
constexpr float EPS = 1e-6f;

constexpr size_t MiB = 1u << 20;
constexpr size_t WS_MOD = 0;
constexpr size_t WS_ROPE = 448 * 1024;
constexpr size_t WS_BIASIN = 464 * 1024;
constexpr size_t WS_LAM = 1020 * 1024;
constexpr size_t WS_DFT256 = 1 * MiB;
constexpr size_t WS_DFT = 2 * MiB;
constexpr size_t WS_XC = 18 * MiB;
constexpr size_t WS_WIN = 26 * MiB;
constexpr size_t WS_WB = WS_WIN + 5888 * 1024 * 2;
constexpr size_t WS_WOUT = WS_WB + 2 * MiB;
constexpr size_t WS_WGU0 = WS_WOUT + 2 * MiB;
constexpr size_t WS_WD0 = WS_WGU0 + 11 * MiB;
constexpr size_t WS_WGU1 = WS_WD0 + 5632 * 1024;
constexpr size_t WS_WD1 = WS_WGU1 + 11 * MiB;
constexpr size_t WS_H = 75 * MiB;
constexpr size_t WS_BR = 111 * MiB;
constexpr size_t WS_P = 147 * MiB;
constexpr size_t WS_FT0 = WS_WGU1, WS_FT1 = WS_WGU0, WS_FTC = WS_XC;
constexpr size_t WS_BAR = 255 * MiB;
constexpr size_t WS_END = 255 * MiB + 65536;
static_assert(WS_WD1 + 5632 * 1024 <= WS_H && WS_FT0 + 16 * MiB <= WS_H && WS_FT1 + 16 * MiB <= WS_WGU1, "ws map");
static_assert((size_t)MT * LDP * 2 <= 81 * MiB && (size_t)MT * 3072 * 2 <= 108 * MiB, "ws map");

constexpr int LDS_BYTES = 155648;
constexpr int LDS_ROPE = 147456;
constexpr int LDS_XB = 144384;
constexpr int LDS_COSTAB = 131072;

typedef float f32x2_t __attribute__((ext_vector_type(2))); typedef __bf16 bf16x2_t __attribute__((ext_vector_type(2)));
__device__ __forceinline__ unsigned cvt_pk_bf16(float lo, float hi) { f32x2_t v = {lo, hi}; bf16x2_t b = __builtin_convertvector(v, bf16x2_t); return __builtin_bit_cast(unsigned, b); }
__device__ __forceinline__ unsigned f2bf(float f) { unsigned u = __float_as_uint(f); return (u + 0x7fffu + ((u >> 16) & 1u)) >> 16; }
__device__ __forceinline__ unsigned pk2(float lo, float hi) { return f2bf(lo) | (f2bf(hi) << 16); }
__device__ __forceinline__ float bflo(unsigned w) { return __uint_as_float(w << 16); }
__device__ __forceinline__ float bfhi(unsigned w) { return __uint_as_float(w & 0xffff0000u); }
__device__ __forceinline__ float fast_exp2(float x) { return __builtin_amdgcn_exp2f(x); }
__device__ __forceinline__ float fast_rcp(float x) { return __builtin_amdgcn_rcpf(x); }
__device__ __forceinline__ float sigmoidf_(float x) { return fast_rcp(1.0f + fast_exp2(-1.4426950408889634f * x)); }
__device__ __forceinline__ float wave_sum(float v) {
#pragma unroll
    for (int o = 1; o < 64; o <<= 1) v += __shfl_xor(v, o);
    return v;
}

namespace pg8 {
constexpr int BM = 256, BK = 64, HALF = 128, HTB = HALF * BK * 2, STAGE_BYTES = 8 * HTB, NXCD = 8, WGM = 4;
__host__ __device__ __forceinline__ int lds_byte(int r, int c) { const int st = (r >> 4) * 2 + (c >> 5), rr = r & 15, cc = c & 31, ob = rr * 64 + cc * 2; return st * 1024 + (ob ^ (((ob >> 9) & 1) << 5)); }
__host__ __device__ __forceinline__ void stage_rc(int b, int& R, int& C) { const int st = b / 1024, sb = b % 1024, swz = sb ^ (((sb >> 9) & 1) << 5); R = (st >> 1) * 16 + swz / 64; C = (st & 1) * 32 + (swz % 64) / 2; }
__host__ __device__ __forceinline__ int perm32(int rho) { const int n = rho >> 4, i = rho & 15; return 8 * (i >> 2) + 4 * n + (i & 3); }
struct Unit { int pm, pn; };
struct Gemm { const bf16_t* A; const bf16_t* Bt; int M, N, K, lda, ldb; };
struct StaticOrder {
    int nM, nN, nwg, G, c;
    __device__ void init(int M, int N, int G_, int c_) { nM = M / BM; nN = N / BM; nwg = nM * nN; G = G_; c = c_; }
    __device__ bool next(int i, Unit& u) const {
        const long L = (long)i * G + c; if (L >= nwg) return false;
        int wgid = (int)L; { const int q = nwg / NXCD, r = nwg % NXCD, xcd = wgid % NXCD, off = wgid / NXCD; wgid = (xcd < r ? xcd * (q + 1) : r * (q + 1) + (xcd - r) * q) + off; }
        const int nig = WGM * nN, gid = wgid / nig, fm = gid * WGM, gsz = (nM - fm) < WGM ? (nM - fm) : WGM;
        u.pm = fm + ((wgid % nig) % gsz); u.pn = (wgid % nig) / gsz; return true;
    }
};

template <class Epi, class Sched>
__device__ __forceinline__ void gemm_phase(LAS unsigned char* lds, const Gemm g, const Sched& S, const Epi& E, const int tid) {
    const int wid = __builtin_amdgcn_readfirstlane(tid >> 6), lane = tid & 63, wr = wid >> 2, wc = wid & 3, fr = lane & 15, fq = lane >> 4;
    const int K = g.K, nt = K / BK;
    unsigned voffA[2], voffB[2];
#pragma unroll
    for (int i = 0; i < 2; ++i) { int R, C; stage_rc(tid * 16 + i * 8192, R, C); const int Rb = (R & ~31) + perm32(R & 31);
        voffA[i] = (unsigned)(R * g.lda + C) * 2u; voffB[i] = (unsigned)(Rb * g.ldb + C) * 2u; }
    const size_t kstep = (size_t)(BK * 2);
    const size_t hA = (size_t)HALF * g.lda * 2, hB = (size_t)HALF * g.ldb * 2;
    const size_t tA = 2 * hA, tB = 2 * hB;
    const unsigned ldsw = (unsigned)wid * 1024u;
    const int aoff = lds_byte(wr * 64 + fr, fq * 8), boff = lds_byte(wc * 32 + fr, fq * 8);
#define PG8_SA(b, h) (((b) * 2 + (h)) * HTB)
#define PG8_SB(b, h) ((4 + (b) * 2 + (h)) * HTB)
#define PG8_STAGE(bufoff, gbase, voff) do { _Pragma("unroll") for (int _i = 0; _i < 2; ++_i) \
        __builtin_amdgcn_global_load_lds((const unsigned*)((const char*)(gbase) + (voff)[_i]), (LAS unsigned*)(lds + (bufoff) + ldsw + _i * 8192), 16, 0, 0); } while (0)
#define PG8_LDA(dst, b, h) do { _Pragma("unroll") for (int m = 0; m < 4; ++m) _Pragma("unroll") for (int k = 0; k < 2; ++k) dst[m][k] = *(const LAS bf16x8*)(lds + PG8_SA(b, h) + aoff + m * 2048 + k * 1024); } while (0)
#define PG8_LDB(dst, b, h) do { _Pragma("unroll") for (int n = 0; n < 2; ++n) _Pragma("unroll") for (int k = 0; k < 2; ++k) dst[n][k] = *(const LAS bf16x8*)(lds + PG8_SB(b, h) + boff + n * 2048 + k * 1024); } while (0)
#define PG8_MMA(ai, bj, At, Bt) do { __builtin_amdgcn_s_setprio(1); _Pragma("unroll") for (int m = 0; m < 4; ++m) _Pragma("unroll") for (int n = 0; n < 2; ++n) _Pragma("unroll") for (int k = 0; k < 2; ++k) \
        acc[ai][bj][m][n] = __builtin_amdgcn_mfma_f32_16x16x32_bf16(Bt[n][k], At[m][k], acc[ai][bj][m][n], 0, 0, 0); __builtin_amdgcn_s_setprio(0); } while (0)
#define PG8_WAIT_V(n) asm volatile("s_waitcnt vmcnt(" #n ")" ::: "memory")
#define PG8_WAIT_L(n) asm volatile("s_waitcnt lgkmcnt(" #n ")" ::: "memory")
#define PG8_BAR __builtin_amdgcn_s_barrier()
#define PG8_SCHED __builtin_amdgcn_sched_barrier(0)
    Unit cur, nxt; int ui = 0;
    if (!S.next(0, cur)) return;
    const bool hz = E.horner();
    f32x4 acc[2][2][4][2];
#pragma unroll
    for (int a = 0; a < 2; ++a)
#pragma unroll
        for (int b = 0; b < 2; ++b)
#pragma unroll
            for (int m = 0; m < 4; ++m)
#pragma unroll
                for (int n = 0; n < 2; ++n) acc[a][b][m][n] = (f32x4){0.f, 0.f, 0.f, 0.f};
    bf16x8 At[4][2], B0[2][2], B1[2][2];
    const char* cA = (const char*)g.A + (size_t)cur.pm * tA; const char* cB = (const char*)g.Bt + (size_t)cur.pn * tB;
    PG8_STAGE(PG8_SB(0, 0), cB, voffB); PG8_STAGE(PG8_SB(0, 1), cB + hB, voffB); PG8_STAGE(PG8_SA(0, 0), cA, voffA); PG8_STAGE(PG8_SA(0, 1), cA + hA, voffA);
    if (wr == 1) PG8_BAR;
    PG8_WAIT_V(2); PG8_BAR;
    PG8_STAGE(PG8_SB(1, 0), cB + kstep, voffB); PG8_STAGE(PG8_SA(1, 0), cA + kstep, voffA); PG8_STAGE(PG8_SB(1, 1), cB + hB + kstep, voffB);
    PG8_WAIT_V(6); PG8_BAR;
    for (;;) {
        const bool has_next = S.next(ui + 1, nxt);
        const char* nA = has_next ? (const char*)g.A + (size_t)nxt.pm * tA : cA; const char* nB = has_next ? (const char*)g.Bt + (size_t)nxt.pn * tB : cB;
        for (int t = 0; t < nt; t += 2) {
            if (hz && (t == 4 || t == 8)) E.mid(acc, cur, t >> 3, wr, wc, fr, fq);
            const bool last = (t == nt - 2);
            const char* a1 = cA + (size_t)(t + 1) * kstep;
            const char* a2 = last ? nA : cA + (size_t)(t + 2) * kstep; const char* b2 = last ? nB : cB + (size_t)(t + 2) * kstep;
            const char* a3 = a2 + kstep; const char* b3 = b2 + kstep;
            PG8_LDB(B0, 0, 0); PG8_LDB(B1, 0, 1); PG8_SCHED; PG8_LDA(At, 0, 0); PG8_STAGE(PG8_SA(1, 1), a1 + hA, voffA);
            PG8_WAIT_V(8); PG8_WAIT_L(0); PG8_BAR; PG8_MMA(0, 0, At, B0); PG8_MMA(0, 1, At, B1); PG8_BAR; PG8_SCHED;
            PG8_LDA(At, 0, 1); PG8_STAGE(PG8_SB(0, 0), b2, voffB); PG8_STAGE(PG8_SB(0, 1), b2 + hB, voffB); PG8_STAGE(PG8_SA(0, 0), a2, voffA);
            PG8_WAIT_V(8); PG8_WAIT_L(0); PG8_BAR; PG8_MMA(1, 0, At, B0); PG8_MMA(1, 1, At, B1); PG8_BAR; PG8_SCHED;
            PG8_LDB(B0, 1, 0); PG8_LDB(B1, 1, 1); PG8_SCHED; PG8_LDA(At, 1, 0); PG8_STAGE(PG8_SA(0, 1), a2 + hA, voffA);
            PG8_WAIT_V(8); PG8_WAIT_L(0); PG8_BAR; PG8_MMA(0, 0, At, B0); PG8_MMA(0, 1, At, B1); PG8_BAR; PG8_SCHED;
            PG8_LDA(At, 1, 1); PG8_STAGE(PG8_SB(1, 0), b3, voffB); PG8_STAGE(PG8_SB(1, 1), b3 + hB, voffB); PG8_STAGE(PG8_SA(1, 0), a3, voffA);
            PG8_WAIT_V(8); PG8_WAIT_L(0); PG8_BAR; PG8_MMA(1, 0, At, B0); PG8_MMA(1, 1, At, B1); PG8_BAR; PG8_SCHED;
        }
        if (wr == 0) PG8_BAR;
        E(acc, cur, wr, wc, fr, fq);
        if (!has_next) break;
#pragma unroll
        for (int a = 0; a < 2; ++a)
#pragma unroll
            for (int b = 0; b < 2; ++b)
#pragma unroll
                for (int m = 0; m < 4; ++m)
#pragma unroll
                    for (int n = 0; n < 2; ++n) acc[a][b][m][n] = (f32x4){0.f, 0.f, 0.f, 0.f};
        cur = nxt; cA = nA; cB = nB; ++ui;
        if (wr == 1) PG8_BAR;
    }
    PG8_WAIT_V(0);
    PG8_BAR;
#undef PG8_SA
#undef PG8_SB
#undef PG8_STAGE
#undef PG8_LDA
#undef PG8_LDB
#undef PG8_MMA
#undef PG8_WAIT_V
#undef PG8_WAIT_L
#undef PG8_BAR
#undef PG8_SCHED
}
}

enum { E_INPROJ = 0, E_GATE = 1, E_BRANCH = 2, E_RESID = 3, E_GU = 4, E_FOUR = 5 };
constexpr int LDS_EPI = 143360;
struct EpiD {
    int mode;
    int row_base;
    int ctx;
    int aux;
    float scale;
    int pad;
    void* out;
    const void* p1;
    const void* p2;
    void* p3; void* p4;
};
#define RFL2(x) ((unsigned)__builtin_amdgcn_readfirstlane((int)(x)))
struct Epi {
    const LAS unsigned* ed;
    __device__ __forceinline__ bool horner() const { return __builtin_amdgcn_readfirstlane((int)ed[0]) == E_BRANCH; }
    __device__ __forceinline__ void mid(f32x4 (&acc)[2][2][4][2], const pg8::Unit& u, int which, int wr, int wc, int fr, int fq) const {
        asm volatile("" : "+v"(fr), "+v"(fq));
        const int row_base = __builtin_amdgcn_readfirstlane((int)ed[1]);
        const unsigned lo = (unsigned)__builtin_amdgcn_readfirstlane((int)ed[8]), hi_ = (unsigned)__builtin_amdgcn_readfirstlane((int)ed[9]);
        const bf16_t* gbase = (const bf16_t*)(((unsigned long long)hi_ << 32) | lo) + (size_t)(row_base + u.pm * 256 + wr * 64 + fr) * 3072 + which * 1024 + u.pn * 256 + wc * 32 + 8 * fq;
#pragma unroll
        for (int ai = 0; ai < 2; ++ai) {
            u32x4 na[4][2], nb[4][2];
#pragma unroll
            for (int m = 0; m < 4; ++m)
#pragma unroll
                for (int bj = 0; bj < 2; ++bj) { const bf16_t* gp = gbase + (size_t)(ai * 128 + m * 16) * 3072 + bj * 128; na[m][bj] = *(const GAS u32x4*)gp; nb[m][bj] = *(const GAS u32x4*)(gp + 1024); }
            __builtin_amdgcn_sched_barrier(0);
#pragma unroll
            for (int m = 0; m < 4; ++m)
#pragma unroll
                for (int bj = 0; bj < 2; ++bj) {
                    const u32x4 xa = na[m][bj], xb = nb[m][bj];
                    f32x4 r0, r1;
                    r0[0] = bflo(xa.x) * fast_rcp(bflo(xb.x)); r0[1] = bfhi(xa.x) * fast_rcp(bfhi(xb.x)); r0[2] = bflo(xa.y) * fast_rcp(bflo(xb.y)); r0[3] = bfhi(xa.y) * fast_rcp(bfhi(xb.y));
                    r1[0] = bflo(xa.z) * fast_rcp(bflo(xb.z)); r1[1] = bfhi(xa.z) * fast_rcp(bfhi(xb.z)); r1[2] = bflo(xa.w) * fast_rcp(bflo(xb.w)); r1[3] = bfhi(xa.w) * fast_rcp(bfhi(xb.w));
                    acc[ai][bj][m][0] = acc[ai][bj][m][0] * r0; acc[ai][bj][m][1] = acc[ai][bj][m][1] * r1;
                }
            __builtin_amdgcn_sched_barrier(0);
        }
    }
    __device__ __forceinline__ void operator()(const f32x4 (&acc)[2][2][4][2], const pg8::Unit& u, int wr, int wc, int fr, int fq) const {
        asm volatile("" : "+v"(fr), "+v"(fq));
#define RFL(x) ((unsigned)__builtin_amdgcn_readfirstlane((int)(x)))
        const int mode = (int)RFL(ed[0]), row_base = (int)RFL(ed[1]), ctx = (int)RFL(ed[2]), aux = (int)RFL(ed[3]);
        const float scale = __uint_as_float(RFL(ed[4]));
        void* const out = (void*)(((unsigned long long)RFL(ed[7]) << 32) | RFL(ed[6]));
        const void* const p1 = (const void*)(((unsigned long long)RFL(ed[9]) << 32) | RFL(ed[8]));
        const void* const p2 = (const void*)(((unsigned long long)RFL(ed[11]) << 32) | RFL(ed[10]));
#undef RFL
        const int r0 = u.pm * 256 + wr * 64 + fr;
        const int c0 = wc * 32 + 8 * fq;
        const int colt = u.pn * 256;
        if (mode == E_INPROJ) {
            const int ct = aux + u.pn;
            const float* bias = (const float*)p1;
            if (ct < 2) {
                const int gpm = (row_base >> 8) + u.pm;
                bf16_t* dst; int ld, n0;
                if (ctx) { const int b = gpm - 64; dst = (bf16_t*)(((unsigned long long)RFL2(ed[15]) << 32) | RFL2(ed[14])) + (size_t)(b * 256) * 512 + ct * 256; ld = 512; n0 = 0; }
                else { const int b = gpm >> 3; dst = (bf16_t*)(((unsigned long long)RFL2(ed[13]) << 32) | RFL2(ed[12])) + (size_t)(b * 256) * 4096 + ct * 2048; ld = 4096; n0 = (gpm & 7) * 256; }
                LAS unsigned char* stg = (LAS unsigned char*)ed - LDS_EPI + 131072 + (wr * 4 + wc) * 1536;
                const int lane_ = fq * 16 + fr, tcol = lane_ >> 1, thalf = lane_ & 1;
#pragma unroll
                for (int bj = 0; bj < 2; ++bj) {
                    const f32x4 b0 = *(const GAS f32x4*)(bias + colt + bj * 128 + c0), b1 = *(const GAS f32x4*)(bias + colt + bj * 128 + c0 + 4);
                    bf16_t* dcol = dst + (size_t)(bj * 128 + wc * 32 + tcol) * ld + n0 + wr * 64 + thalf * 8;
#pragma unroll
                    for (int ai = 0; ai < 2; ++ai)
#pragma unroll
                        for (int m = 0; m < 4; ++m) {
                            const f32x4 v0 = acc[ai][bj][m][0] + b0, v1 = acc[ai][bj][m][1] + b1;
                            LAS bf16_t* sp = (LAS bf16_t*)stg + (fq * 8) * 16 + fr;
                            sp[0 * 16] = (bf16_t)f2bf(v0[0]); sp[1 * 16] = (bf16_t)f2bf(v0[1]); sp[2 * 16] = (bf16_t)f2bf(v0[2]); sp[3 * 16] = (bf16_t)f2bf(v0[3]);
                            sp[4 * 16] = (bf16_t)f2bf(v1[0]); sp[5 * 16] = (bf16_t)f2bf(v1[1]); sp[6 * 16] = (bf16_t)f2bf(v1[2]); sp[7 * 16] = (bf16_t)f2bf(v1[3]);
                            asm volatile("s_waitcnt lgkmcnt(0)" ::: "memory");
                            const u32x4 w = *(const LAS u32x4*)(stg + tcol * 32 + thalf * 16);
                            *(GAS u32x4*)(dcol + ai * 128 + m * 16) = w;
                            asm volatile("s_waitcnt lgkmcnt(0)" ::: "memory");
                        }
                }
            } else {
                const bool isqk = (ct >= 5 && ct <= 8), dorope = isqk && !ctx;
                const float sc = (ct == 5 || ct == 6) ? QSCALE : 1.0f;
                const int axis = wc & 1, half = fq >> 1;
                const LAS float* rope = (const LAS float*)((const LAS unsigned char*)ed - LDS_EPI + LDS_ROPE) + 8 * (fq & 1);
                bf16_t* obase = (bf16_t*)out + (size_t)(row_base + r0) * LDP + (ct - 2) * 256 + c0;
#pragma unroll
                for (int bj = 0; bj < 2; ++bj) {
                    const f32x4 b0 = *(const GAS f32x4*)(bias + colt + bj * 128 + c0), b1 = *(const GAS f32x4*)(bias + colt + bj * 128 + c0 + 4);
#pragma unroll
                    for (int ai = 0; ai < 2; ++ai)
#pragma unroll
                        for (int m = 0; m < 4; ++m) {
                            f32x4 v0 = acc[ai][bj][m][0] + b0, v1 = acc[ai][bj][m][1] + b1;
                            if (dorope) {
                                const int t = (row_base + r0 + ai * 128 + m * 16) & 2047, pos = axis ? (t & 63) : (t >> 6);
                                const LAS float* cp = rope + pos * 16;
                                const f32x4 cs0 = *(const LAS f32x4*)cp, cs1 = *(const LAS f32x4*)(cp + 4), sn0 = *(const LAS f32x4*)(cp + 1024), sn1 = *(const LAS f32x4*)(cp + 1028);
                                f32x4 w0, w1;
#pragma unroll
                                for (int j = 0; j < 4; ++j) { w0[j] = __shfl_xor(v0[j], 32); w1[j] = __shfl_xor(v1[j], 32); }
                                if (half) { v0 = v0 * cs0 + w0 * sn0; v1 = v1 * cs1 + w1 * sn1; }
                                else { v0 = v0 * cs0 - w0 * sn0; v1 = v1 * cs1 - w1 * sn1; }
                            }
                            v0 = v0 * sc; v1 = v1 * sc;
                            u32x4 w; w.x = cvt_pk_bf16(v0[0], v0[1]); w.y = cvt_pk_bf16(v0[2], v0[3]); w.z = cvt_pk_bf16(v1[0], v1[1]); w.w = cvt_pk_bf16(v1[2], v1[3]);
                            *(GAS u32x4*)(obase + (size_t)(ai * 128 + m * 16) * LDP + bj * 128) = w;
                        }
                }
            }
        } else if (mode == E_GATE) {
            const float* bias = (const float*)p1;
            bf16_t* obase = (bf16_t*)out + (size_t)(row_base + r0) * 3072 + colt + c0;
#pragma unroll
            for (int bj = 0; bj < 2; ++bj) {
                const f32x4 b0 = *(const GAS f32x4*)(bias + colt + bj * 128 + c0), b1 = *(const GAS f32x4*)(bias + colt + bj * 128 + c0 + 4);
#pragma unroll
                for (int ai = 0; ai < 2; ++ai)
#pragma unroll
                    for (int m = 0; m < 4; ++m) {
                        f32x4 v0 = acc[ai][bj][m][0] + b0, v1 = acc[ai][bj][m][1] + b1;
#pragma unroll
                        for (int j = 0; j < 4; ++j) { v0[j] = fmaxf(sigmoidf_(v0[j]), 1e-18f); v1[j] = fmaxf(sigmoidf_(v1[j]), 1e-18f); }
                        u32x4 w; w.x = cvt_pk_bf16(v0[0], v0[1]); w.y = cvt_pk_bf16(v0[2], v0[3]); w.z = cvt_pk_bf16(v1[0], v1[1]); w.w = cvt_pk_bf16(v1[2], v1[3]);
                        *(GAS u32x4*)(obase + (size_t)(ai * 128 + m * 16) * 3072 + bj * 128) = w;
                    }
            }
        } else if (mode == E_BRANCH) {
            const bf16_t* gbase = (const bf16_t*)p1 + (size_t)(row_base + r0) * 3072 + 2048 + colt + c0;
            bf16_t* ybase = (bf16_t*)out + (size_t)(row_base + r0) * 1024 + colt + c0;
            u32x4 gw[2][4][2];
#pragma unroll
            for (int ai = 0; ai < 2; ++ai)
#pragma unroll
                for (int m = 0; m < 4; ++m)
#pragma unroll
                    for (int bj = 0; bj < 2; ++bj) gw[ai][m][bj] = *(const GAS u32x4*)(gbase + (size_t)(ai * 128 + m * 16) * 3072 + bj * 128);
            __builtin_amdgcn_sched_barrier(0);
#pragma unroll
            for (int ai = 0; ai < 2; ++ai)
#pragma unroll
                for (int m = 0; m < 4; ++m) {
#pragma unroll
                    for (int bj = 0; bj < 2; ++bj) {
                        const u32x4 g = gw[ai][m][bj];
                        const f32x4 g0 = (f32x4){bflo(g.x), bfhi(g.x), bflo(g.y), bfhi(g.y)}, g1 = (f32x4){bflo(g.z), bfhi(g.z), bflo(g.w), bfhi(g.w)};
                        const f32x4 y0 = g0 * acc[ai][bj][m][0], y1 = g1 * acc[ai][bj][m][1];
                        u32x4 w; w.x = cvt_pk_bf16(y0[0], y0[1]); w.y = cvt_pk_bf16(y0[2], y0[3]); w.z = cvt_pk_bf16(y1[0], y1[1]); w.w = cvt_pk_bf16(y1[2], y1[3]);
                        *(GAS u32x4*)(ybase + (size_t)(ai * 128 + m * 16) * 1024 + bj * 128) = w;
                    }
                }
        } else if (mode == E_RESID) {
            const float* xin = (const float*)p1 + (size_t)r0 * 1024 + colt + c0;
            float* xout = (float*)out + (size_t)r0 * 1024 + colt + c0;
            const int b = ctx ? 8 : (u.pm >> 3);
            const float* modg = (const float*)p2 + (size_t)b * 6144 + colt + c0;
            f32x4 gv[2][2];
#pragma unroll
            for (int bj = 0; bj < 2; ++bj) { gv[bj][0] = *(const GAS f32x4*)(modg + bj * 128); gv[bj][1] = *(const GAS f32x4*)(modg + bj * 128 + 4); }
#pragma unroll
            for (int ai = 0; ai < 2; ++ai) {
                f32x4 xv[4][2][2];
#pragma unroll
                for (int m = 0; m < 4; ++m)
#pragma unroll
                    for (int bj = 0; bj < 2; ++bj) { const float* xi = xin + (size_t)(ai * 128 + m * 16) * 1024 + bj * 128; xv[m][bj][0] = *(const GAS f32x4*)xi; xv[m][bj][1] = *(const GAS f32x4*)(xi + 4); }
                __builtin_amdgcn_sched_barrier(0);
#pragma unroll
                for (int m = 0; m < 4; ++m)
#pragma unroll
                    for (int bj = 0; bj < 2; ++bj) { float* xo = xout + (size_t)(ai * 128 + m * 16) * 1024 + bj * 128;
                        *(GAS f32x4*)xo = xv[m][bj][0] + gv[bj][0] * acc[ai][bj][m][0]; *(GAS f32x4*)(xo + 4) = xv[m][bj][1] + gv[bj][1] * acc[ai][bj][m][1]; }
                __builtin_amdgcn_sched_barrier(0);
            }
        } else if (mode == E_GU) {
            bf16_t* obase = (bf16_t*)out + (size_t)(row_base + r0) * DFF + u.pn * 128 + c0;
#pragma unroll
            for (int ai = 0; ai < 2; ++ai)
#pragma unroll
                for (int m = 0; m < 4; ++m) {
                    f32x4 v0, v1;
#pragma unroll
                    for (int j = 0; j < 4; ++j) { const float a = acc[ai][0][m][0][j], b = acc[ai][0][m][1][j];
                        v0[j] = a * sigmoidf_(a) * acc[ai][1][m][0][j]; v1[j] = b * sigmoidf_(b) * acc[ai][1][m][1][j]; }
                    u32x4 w; w.x = cvt_pk_bf16(v0[0], v0[1]); w.y = cvt_pk_bf16(v0[2], v0[3]); w.z = cvt_pk_bf16(v1[0], v1[1]); w.w = cvt_pk_bf16(v1[2], v1[3]);
                    *(GAS u32x4*)(obase + (size_t)(ai * 128 + m * 16) * DFF) = w;
                }
        } else {
            const int L = ctx ? CTXL : SEQ;
            bf16_t* obase = (bf16_t*)out + (size_t)(row_base + u.pn * L + r0) * 1024 + c0;
#pragma unroll
            for (int ai = 0; ai < 2; ++ai)
#pragma unroll
                for (int m = 0; m < 4; ++m) {
#pragma unroll
                    for (int bj = 0; bj < 2; ++bj) {
                        const f32x4 v0 = acc[ai][bj][m][0] * scale, v1 = acc[ai][bj][m][1] * scale;
                        u32x4 w; w.x = cvt_pk_bf16(v0[0], v0[1]); w.y = cvt_pk_bf16(v0[2], v0[3]); w.z = cvt_pk_bf16(v1[0], v1[1]); w.w = cvt_pk_bf16(v1[2], v1[3]);
                        *(GAS u32x4*)(obase + (size_t)(ai * 128 + m * 16) * 1024 + bj * 128) = w;
                    }
                }
        }
    }
};

struct Args {
    const float* in[25];
    float* out; unsigned char* ws;
    int ph_lo, ph_hi;
};
enum { I_X = 0, I_C, I_CTX, I_CCTX, I_WADA, I_BADA, I_N1G, I_N2G, I_WIN, I_BIN, I_CONVW, I_CONVB, I_WFO, I_WCO, I_WAO, I_LQ1, I_LK1, I_LQ2, I_LK2, I_SUBG, I_WOUT, I_WG, I_WU, I_WD, I_FING };

struct Frame {
    LAS unsigned char* lds;
    int tid, lane, wave, G, bx, vcu, rot;
};

struct GJob { const bf16_t* A; const bf16_t* Bt; int lda, ldb, M, N, K, rot; int gfirst, gsub; EpiD E; };
__device__ __forceinline__ void gemm_call(Frame& F, const GJob& j) {
    pg8::Gemm g{j.A, j.Bt, j.M, j.N, j.K, j.lda, j.ldb};
    if (j.rot >= 0) F.rot = j.rot % F.G;
    pg8::StaticOrder S; int c = F.bx - F.rot; if (c < 0) c += F.G;
    int Ge = F.G;
    if (j.gsub > 0) { Ge = j.gsub; c = F.bx - j.gfirst; if (c < 0 || c >= j.gsub) c = 1 << 28; }
    S.init(j.M, j.N, Ge, c);
    if (F.tid == 0) { LAS unsigned* d = (LAS unsigned*)(F.lds + LDS_EPI);
        const unsigned long long o_ = (unsigned long long)j.E.out, a_ = (unsigned long long)j.E.p1, b_ = (unsigned long long)j.E.p2;
        d[0] = (unsigned)j.E.mode; d[1] = (unsigned)j.E.row_base; d[2] = (unsigned)j.E.ctx; d[3] = (unsigned)j.E.aux; d[4] = __float_as_uint(j.E.scale); d[5] = 0u;
        d[6] = (unsigned)o_; d[7] = (unsigned)(o_ >> 32); d[8] = (unsigned)a_; d[9] = (unsigned)(a_ >> 32); d[10] = (unsigned)b_; d[11] = (unsigned)(b_ >> 32);
        const unsigned long long c_ = (unsigned long long)j.E.p3, e_ = (unsigned long long)j.E.p4; d[12] = (unsigned)c_; d[13] = (unsigned)(c_ >> 32); d[14] = (unsigned)e_; d[15] = (unsigned)(e_ >> 32); }
    __syncthreads();
    Epi E{(const LAS unsigned*)(F.lds + LDS_EPI)};
    pg8::gemm_phase<Epi, pg8::StaticOrder>(F.lds, g, S, E, F.tid);
    F.rot = (F.rot + (j.M / 256) * (j.N / 256)) % F.G;
}

__device__ __forceinline__ void tr_item(const float* src, int ldsrc, bf16_t* dst, int ldd, LAS float* scr, int lane) {
#pragma unroll 8
    for (int i = 0; i < 32; ++i) { const int kk = 2 * i + (lane >> 5); scr[kk * 33 + (lane & 31)] = src[(size_t)kk * ldsrc + (lane & 31)]; }
    asm volatile("s_waitcnt lgkmcnt(0)" ::: "memory");
    const int c = lane & 7;
#pragma unroll
    for (int j = 0; j < 4; ++j) { const int n = (lane >> 3) + 8 * j; const LAS float* s = scr + (8 * c) * 33 + n;
        u32x4 o; o.x = pk2(s[0 * 33], s[1 * 33]); o.y = pk2(s[2 * 33], s[3 * 33]); o.z = pk2(s[4 * 33], s[5 * 33]); o.w = pk2(s[6 * 33], s[7 * 33]);
        *(u32x4*)(dst + (size_t)n * ldd + 8 * c) = o; }
    asm volatile("s_waitcnt lgkmcnt(0)" ::: "memory");
}

__device__ __forceinline__ void conv_setA(Frame& F, const Args& a, int l, int pidx, int pcnt, int part) {
    unsigned char* ws = a.ws;
    bf16_t* Win = (bf16_t*)(ws + WS_WIN); bf16_t* Wb = (bf16_t*)(ws + WS_WB); bf16_t* Wout = (bf16_t*)(ws + WS_WOUT);
    const float* w_in = a.in[I_WIN] + (size_t)l * D * DIN;
    LAS float* scr = (LAS float*)(F.lds + F.wave * 16384);
    const int gw = pidx * 8 + F.wave, NGW = pcnt * 8;
    constexpr int I1 = 16 * 168, I2 = 128, I3 = 128, I4 = 256, I5 = 512;
    for (int it = gw; it < I1 + I2 + I3 + I4 + I5; it += NGW) {
        int r = it;
        if (r < I1) { const int kb = r / 168, nb = r % 168, k0 = kb * 64, n0 = 256 + nb * 32;
            if (!((part >> (nb >= 72 ? 1 : 0)) & 1)) continue;
            tr_item(w_in + (size_t)k0 * DIN + n0, DIN, Win + (size_t)(n0 + 256) * 1024 + k0, 1024, scr, F.lane); continue; } r -= I1;
        if (!(part & 2)) break;
        if (r < I2) { const int kb = r / 32, nb = r % 32; tr_item(a.in[I_WFO] + (size_t)l * 256 * D + (size_t)kb * 64 * D + nb * 32, D, Wb + (size_t)(nb * 32) * 1024 + kb * 64, 1024, scr, F.lane); continue; } r -= I2;
        if (r < I3) { const int kb = r / 32, nb = r % 32; tr_item(a.in[I_WCO] + (size_t)l * 256 * D + (size_t)kb * 64 * D + nb * 32, D, Wb + (size_t)(nb * 32) * 1024 + 256 + kb * 64, 1024, scr, F.lane); continue; } r -= I3;
        if (r < I4) { const int kb = r / 32, nb = r % 32; tr_item(a.in[I_WAO] + (size_t)l * 512 * D + (size_t)kb * 64 * D + nb * 32, D, Wb + (size_t)(nb * 32) * 1024 + 512 + kb * 64, 1024, scr, F.lane); continue; } r -= I4;
        { const int kb = r / 32, nb = r % 32; tr_item(a.in[I_WOUT] + (size_t)l * D * D + (size_t)kb * 64 * D + nb * 32, D, Wout + (size_t)(nb * 32) * 1024 + kb * 64, 1024, scr, F.lane); }
    }
    if (!(part & 1)) return;
    const LAS float* ct = (const LAS float*)(F.lds + LDS_COSTAB);
    const int gt = pidx * 512 + F.tid, NGT = pcnt * 512;
    for (int o = gt; o < 1024 * 128; o += NGT) {
        const int k = o & 1023, g = (o >> 10) & 3, mq = o >> 12;
        const float* wp = w_in + (size_t)k * DIN + g * 64;
        f32x4 wv[16];
#pragma unroll
        for (int i = 0; i < 16; ++i) wv[i] = *(const f32x4*)(wp + 4 * i);
#pragma unroll 1
        for (int mm = 0; mm < 2; ++mm) {
            const int m = mq * 2 + mm; float sc = 0.f, ss = 0.f;
#pragma unroll
            for (int j = 0; j < 64; ++j) { const int i = ((j * m) & 63) * 32; const float w = wv[j >> 2][j & 3]; sc += w * ct[i]; ss += w * ct[(i + 1536) & 2047]; }
            Win[(size_t)(g * 64 + m) * 1024 + k] = (bf16_t)f2bf(sc * 0.125f);
            Win[(size_t)(256 + g * 64 + m) * 1024 + k] = (bf16_t)f2bf(ss * 0.125f);
        }
    }
    float* bi = (float*)(ws + WS_BIASIN) + l * NIN; const float* b_in = a.in[I_BIN] + (size_t)l * DIN;
    for (int r = gt; r < NIN; r += NGT) {
        float v;
        if (r < 512) { const int pt = r >> 8, g = (r >> 6) & 3, m = r & 63; float s_ = 0.f;
            for (int j = 0; j < 64; ++j) { const int i = (j * m) & 63; s_ += b_in[g * 64 + j] * ct[(i * 32 + (pt ? 1536 : 0)) & 2047]; }
            v = s_ * 0.125f; }
        else v = b_in[r - 256];
        bi[r] = v;
    }
}
__device__ __forceinline__ void conv_setB(Frame& F, const Args& a, int l, int pidx, int pcnt) {
    unsigned char* ws = a.ws;
    bf16_t* Wgu = (bf16_t*)(ws + (l ? WS_WGU1 : WS_WGU0)); bf16_t* Wd = (bf16_t*)(ws + (l ? WS_WD1 : WS_WD0));
    LAS float* scr = (LAS float*)(F.lds + F.wave * 16384);
    const int gw = pidx * 8 + F.wave, NGW = pcnt * 8;
    constexpr int J1 = 16 * 88, J3 = 44 * 32;
    for (int it = gw; it < 2 * J1 + J3; it += NGW) {
        int r = it;
        if (r < 2 * J1) { const int up = r >= J1; if (up) r -= J1; const int kb = r / 88, nb = r % 88, n0 = nb * 32;
            const float* W = a.in[up ? I_WU : I_WG] + (size_t)l * D * DFF;
            tr_item(W + (size_t)kb * 64 * DFF + n0, DFF, Wgu + (size_t)((n0 >> 7) * 256 + up * 128 + (n0 & 127)) * 1024 + kb * 64, 1024, scr, F.lane); continue; }
        r -= 2 * J1;
        { const int kb = r / 32, nb = r % 32; tr_item(a.in[I_WD] + (size_t)l * DFF * D + (size_t)kb * 64 * D + nb * 32, D, Wd + (size_t)(nb * 32) * DFF + kb * 64, DFF, scr, F.lane); }
    }
}

__device__ __forceinline__ void norm_row(const float* xrow, const float* g, const float* sh, const float* sc, bf16_t* orow, float* fout, int lane) {
    f32x4 v[4]; float s = 0.f;
#pragma unroll
    for (int j = 0; j < 4; ++j) { v[j] = *((const f32x4*)xrow + lane + 64 * j); s += (v[j].x * v[j].x + v[j].y * v[j].y) + (v[j].z * v[j].z + v[j].w * v[j].w); }
    const float rstd = 1.0f / sqrtf(wave_sum(s) * (1.0f / D) + EPS);
#pragma unroll
    for (int j = 0; j < 4; ++j) {
        const int c = (lane + 64 * j) * 4;
        f32x4 y = v[j] * rstd * *(const f32x4*)(g + c);
        if (fout) { *(f32x4*)(fout + c) = y; }
        else { y = y * (*(const f32x4*)(sc + c) + 1.0f) + *(const f32x4*)(sh + c);
            u32x2 w; w.x = cvt_pk_bf16(y.x, y.y); w.y = cvt_pk_bf16(y.z, y.w); *(u32x2*)(orow + c) = w; }
    }
}
__device__ __forceinline__ void norm_phase(Frame& F, const float* xl, const float* xc, const float* g, const float* mod, int sh_off, int sc_off, bf16_t* H, bool with_ctx) {
    const int gw = F.vcu * 8 + F.wave, NGW = F.G * 8, nrows = with_ctx ? MT : ML;
    for (int r = gw; r < nrows; r += NGW) {
        const int b = r < ML ? (r >> 11) : 8;
        const float* xr = r < ML ? xl + (size_t)r * D : xc + (size_t)(r - ML) * D;
        norm_row(xr, g, mod + (size_t)b * 6144 + sh_off, mod + (size_t)b * 6144 + sc_off, H + (size_t)r * D, nullptr, F.lane);
    }
}

__device__ __forceinline__ int crow(int r, int hi) { return (r & 3) + 8 * (r >> 2) + 4 * hi; }
__device__ __forceinline__ s16x4 vtr(const LAS unsigned char* p) { return __builtin_bit_cast(s16x4, __builtin_amdgcn_ds_read_tr16_b64_v4i16((LAS s16x4*)p)); }
constexpr int AT_WSF = 131072;
__device__ __forceinline__ void at_softmax(f32x16& p0, f32x16& p1, f32x16& negm, float& mhat, float& lsum, f32x16 (&o)[4], bf16x8 (&pa)[4], LAS float* wsf, bool first, int r32, int hi) {
    float rm = fmaxf(fmaxf(p0[0], p0[1]), p1[0]);
    { float rb = fmaxf(fmaxf(p0[2], p0[3]), p1[1]); rm = fmaxf(fmaxf(rm, p1[2]), p1[3]);
#pragma unroll
      for (int r = 4; r < 16; r += 4) { rm = fmaxf(fmaxf(rm, p0[r]), p0[r + 1]); rb = fmaxf(fmaxf(rb, p0[r + 2]), p0[r + 3]); rm = fmaxf(fmaxf(rm, p1[r]), p1[r + 1]); rb = fmaxf(fmaxf(rb, p1[r + 2]), p1[r + 3]); }
      rm = fmaxf(rm, rb); }
    rm = fmaxf(rm, __shfl_xor(rm, 32));
    const bool need = first || (rm > 6.0f);
    if (__any(need)) {
        const float dl = need ? rm : 0.f;
        mhat += dl;
#pragma unroll
        for (int r = 0; r < 16; ++r) { p0[r] -= dl; p1[r] -= dl; negm[r] = -mhat; }
        if (!first) {
            const float f = fast_exp2(-dl);
            lsum *= f;
            asm volatile("" ::: "memory");
            if (hi == 0) wsf[r32] = f;
            asm volatile("s_waitcnt lgkmcnt(0)" ::: "memory");
#pragma unroll
            for (int r = 0; r < 16; ++r) { const float fr_ = wsf[crow(r, hi)];
#pragma unroll
                for (int d0 = 0; d0 < 4; ++d0) o[d0][r] *= fr_; }
            asm volatile("s_waitcnt lgkmcnt(0)" ::: "memory");
        }
    }
    f32x2_t ls2 = (f32x2_t){0.f, 0.f};
#pragma unroll
    for (int r = 0; r < 16; r += 2) { p0[r] = fast_exp2(p0[r]); p0[r + 1] = fast_exp2(p0[r + 1]); p1[r] = fast_exp2(p1[r]); p1[r + 1] = fast_exp2(p1[r + 1]);
        ls2 += (f32x2_t){p0[r], p0[r + 1]}; ls2 += (f32x2_t){p1[r], p1[r + 1]}; }
    lsum += ls2.x + ls2.y;
    u32x4 w;
    w.x = cvt_pk_bf16(p0[0], p0[1]); w.y = cvt_pk_bf16(p0[2], p0[3]); w.z = cvt_pk_bf16(p0[4], p0[5]); w.w = cvt_pk_bf16(p0[6], p0[7]); pa[0] = __builtin_bit_cast(bf16x8, w);
    w.x = cvt_pk_bf16(p0[8], p0[9]); w.y = cvt_pk_bf16(p0[10], p0[11]); w.z = cvt_pk_bf16(p0[12], p0[13]); w.w = cvt_pk_bf16(p0[14], p0[15]); pa[1] = __builtin_bit_cast(bf16x8, w);
    w.x = cvt_pk_bf16(p1[0], p1[1]); w.y = cvt_pk_bf16(p1[2], p1[3]); w.z = cvt_pk_bf16(p1[4], p1[5]); w.w = cvt_pk_bf16(p1[6], p1[7]); pa[2] = __builtin_bit_cast(bf16x8, w);
    w.x = cvt_pk_bf16(p1[8], p1[9]); w.y = cvt_pk_bf16(p1[10], p1[11]); w.z = cvt_pk_bf16(p1[12], p1[13]); w.w = cvt_pk_bf16(p1[14], p1[15]); pa[3] = __builtin_bit_cast(bf16x8, w);
}
__device__ __forceinline__ void attn_unit(Frame& F, const bf16_t* P, bf16_t* BR, int qrow0, int base1, int n1, int base2, int nt, int h, float lam, float oscale, const float* subg) {
    LAS unsigned char* lds = F.lds;
    const int tid = F.tid, lane = F.lane, wid = F.wave, r32 = lane & 31, hi = lane >> 5, qg = wid & 3, comp = wid >> 2;
    bf16x8 qf[4];
    { const bf16_t* qp = P + (size_t)(qrow0 + qg * 32 + r32) * LDP + PQ + h * 128 + comp * 64 + hi * 8;
#pragma unroll
      for (int d0 = 0; d0 < 4; ++d0) qf[d0] = *(const bf16x8*)(qp + d0 * 16); }
    int ksrc[2], kdst[2], vsrc[2], vdst[2];
#pragma unroll
    for (int i = 0; i < 2; ++i) { const int pc = wid * 2 + i;
        { const int cmp = pc >> 3, rg = pc & 7, row = rg * 8 + (lane >> 3), c8 = (lane & 7) ^ (lane >> 3); ksrc[i] = row * LDP + PK + h * 128 + cmp * 64 + c8 * 8; kdst[i] = cmp * 8192 + rg * 1024; }
        { const int d0 = pc >> 2, rg = pc & 3; vsrc[i] = (rg * 16 + (lane >> 2)) * LDP + PV + h * 128 + d0 * 32 + (lane & 3) * 8; vdst[i] = 16384 + d0 * 4096 + rg * 1024; } }
#define AT_TROW(t) ((t) < n1 ? base1 + 64 * (t) : base2 + 64 * ((t) - n1))
    LAS float* wsf = (LAS float*)(lds + AT_WSF) + wid * 64;
    float mhat = 0.f, lsum = 0.f;
    f32x16 negm;
#pragma unroll
    for (int r = 0; r < 16; ++r) negm[r] = 0.f;
    f32x16 o[4];
#pragma unroll
    for (int d0 = 0; d0 < 4; ++d0)
#pragma unroll
        for (int r = 0; r < 16; ++r) o[d0][r] = 0.f;
    bf16x8 pa[4];
#pragma unroll
    for (int i = 0; i < 4; ++i) pa[i] = (bf16x8){0, 0, 0, 0, 0, 0, 0, 0};
    s16x4 va[8], vb[8];
#pragma unroll
    for (int i = 0; i < 8; ++i) { va[i] = (s16x4){0, 0, 0, 0}; vb[i] = (s16x4){0, 0, 0, 0}; }
    const int vlane = ((lane >> 4) & 1) * 32 + (lane & 3) * 8 + (4 * hi + ((lane & 15) >> 2)) * 64;
    const int klane = comp * 8192 + r32 * 128;
    int koff[4];
#pragma unroll
    for (int d0 = 0; d0 < 4; ++d0) koff[d0] = ((2 * d0 + hi) ^ (r32 & 7)) * 16;
#define AT_SB() __builtin_amdgcn_sched_barrier(0)
#define AT_DMA4(t, OFF) do { const bf16_t* tp = P + (size_t)AT_TROW(t) * LDP; \
        __builtin_amdgcn_global_load_lds((const unsigned*)(tp + ksrc[0]), (LAS unsigned*)(lds + (OFF) + kdst[0]), 16, 0, 0); \
        __builtin_amdgcn_global_load_lds((const unsigned*)(tp + ksrc[1]), (LAS unsigned*)(lds + (OFF) + kdst[1]), 16, 0, 0); \
        __builtin_amdgcn_global_load_lds((const unsigned*)(tp + vsrc[0]), (LAS unsigned*)(lds + (OFF) + vdst[0]), 16, 0, 0); \
        __builtin_amdgcn_global_load_lds((const unsigned*)(tp + vsrc[1]), (LAS unsigned*)(lds + (OFF) + vdst[1]), 16, 0, 0); } while (0)
#define AT_VF(x, s) ((bf16x8){x[2 * (s)][0], x[2 * (s)][1], x[2 * (s)][2], x[2 * (s)][3], x[2 * (s) + 1][0], x[2 * (s) + 1][1], x[2 * (s) + 1][2], x[2 * (s) + 1][3]})
#define AT_TR(dst, addr, off) asm volatile("ds_read_b64_tr_b16 %0, %1 offset:%c2" : "=&v"(dst) : "v"(addr), "i"(off) : "memory")
    const unsigned ldsb = (unsigned)(unsigned long long)lds;
#define AT_VPRE(OFF) do { const unsigned vp_ = ldsb + (OFF) + 16384 + vlane; \
        _Pragma("unroll") for (int s_ = 0; s_ < 4; ++s_) { AT_TR(va[2 * s_], vp_, s_ * 1024); AT_TR(va[2 * s_ + 1], vp_, s_ * 1024 + 512); AT_TR(vb[2 * s_], vp_, 4096 + s_ * 1024); AT_TR(vb[2 * s_ + 1], vp_, 4096 + s_ * 1024 + 512); } } while (0)
#define AT_PVMMA(OFF) do { const unsigned vp_ = ldsb + (OFF) + 16384 + vlane; \
        asm volatile("s_waitcnt lgkmcnt(0)" ::: "memory"); AT_SB(); __builtin_amdgcn_s_setprio(1); \
        _Pragma("unroll") for (int s_ = 0; s_ < 4; ++s_) { \
            o[0] = __builtin_amdgcn_mfma_f32_32x32x16_bf16(pa[s_], AT_VF(va, s_), o[0], 0, 0, 0); \
            o[1] = __builtin_amdgcn_mfma_f32_32x32x16_bf16(pa[s_], AT_VF(vb, s_), o[1], 0, 0, 0); \
            AT_SB(); \
            AT_TR(va[2 * s_], vp_, 8192 + s_ * 1024); AT_TR(va[2 * s_ + 1], vp_, 8192 + s_ * 1024 + 512); AT_TR(vb[2 * s_], vp_, 12288 + s_ * 1024); AT_TR(vb[2 * s_ + 1], vp_, 12288 + s_ * 1024 + 512); \
            AT_SB(); } \
        asm volatile("s_waitcnt lgkmcnt(0)" ::: "memory"); AT_SB(); \
        _Pragma("unroll") for (int s_ = 0; s_ < 4; ++s_) { \
            o[2] = __builtin_amdgcn_mfma_f32_32x32x16_bf16(pa[s_], AT_VF(va, s_), o[2], 0, 0, 0); \
            o[3] = __builtin_amdgcn_mfma_f32_32x32x16_bf16(pa[s_], AT_VF(vb, s_), o[3], 0, 0, 0); } \
        __builtin_amdgcn_s_setprio(0); AT_SB(); } while (0)
#define AT_STEP(t, CUR, NX2, PRV) do { \
        if ((t) + 2 < nt) AT_DMA4((t) + 2, NX2); \
        if (comp == 1 && (t) > 0) AT_PVMMA(PRV); \
        f32x16 p0, p1; \
        {   bf16x8 kf[8]; const LAS unsigned char* kb = lds + (CUR) + klane; \
            _Pragma("unroll") for (int d0 = 0; d0 < 4; ++d0) { kf[2 * d0] = *(const LAS bf16x8*)(kb + koff[d0]); kf[2 * d0 + 1] = *(const LAS bf16x8*)(kb + koff[d0] + 4096); } \
            AT_SB(); __builtin_amdgcn_s_setprio(1); \
            p0 = __builtin_amdgcn_mfma_f32_32x32x16_bf16(kf[0], qf[0], negm, 0, 0, 0); \
            p1 = __builtin_amdgcn_mfma_f32_32x32x16_bf16(kf[1], qf[0], negm, 0, 0, 0); \
            _Pragma("unroll") for (int d0 = 1; d0 < 4; ++d0) { \
                p0 = __builtin_amdgcn_mfma_f32_32x32x16_bf16(kf[2 * d0], qf[d0], p0, 0, 0, 0); \
                p1 = __builtin_amdgcn_mfma_f32_32x32x16_bf16(kf[2 * d0 + 1], qf[d0], p1, 0, 0, 0); } __builtin_amdgcn_s_setprio(0); } \
        AT_SB(); \
        AT_VPRE(CUR); \
        AT_SB(); \
        at_softmax(p0, p1, negm, mhat, lsum, o, pa, wsf, (t) == 0, r32, hi); \
        AT_SB(); \
        if (comp == 0) AT_PVMMA(CUR); \
          \
        if ((t) + 2 < nt) asm volatile("s_waitcnt vmcnt(4)" ::: "memory"); else asm volatile("s_waitcnt vmcnt(0)" ::: "memory"); \
        AT_SB(); __builtin_amdgcn_s_barrier(); AT_SB(); } while (0)
    AT_DMA4(0, 0);
    if (nt > 1) AT_DMA4(1, 32768);
    if (nt > 1) asm volatile("s_waitcnt vmcnt(4)" ::: "memory"); else asm volatile("s_waitcnt vmcnt(0)" ::: "memory");
    __syncthreads();
#pragma unroll 1
    for (int t = 0; t < nt; t += 4) {
        AT_STEP(t, 0, 65536, 98304);
        if (t + 1 < nt) AT_STEP(t + 1, 32768, 98304, 0);
        if (t + 2 < nt) AT_STEP(t + 2, 65536, 0, 32768);
        if (t + 3 < nt) AT_STEP(t + 3, 98304, 32768, 65536);
    }
    if (comp == 1) { const int lo_ = ((nt - 1) & 3) * 32768; AT_PVMMA(lo_); }
    __syncthreads();
#undef AT_STEP
#undef AT_PVMMA
#undef AT_VPRE
#undef AT_TR
#undef AT_VF
#undef AT_DMA4
#undef AT_SB
    lsum += __shfl_xor(lsum, 32);
    { float inv = 1.0f / lsum; if (comp) inv *= lam;
      asm volatile("" ::: "memory");
      if (hi == 0) wsf[r32] = inv;
      asm volatile("s_waitcnt lgkmcnt(0)" ::: "memory");
#pragma unroll
      for (int r = 0; r < 16; ++r) { const float fr_ = wsf[crow(r, hi)];
#pragma unroll
          for (int d0 = 0; d0 < 4; ++d0) o[d0][r] *= fr_; } }
    LAS float* X = (LAS float*)lds + qg * (32 * 132);
    if (comp == 1) {
#pragma unroll
        for (int d0 = 0; d0 < 4; ++d0)
#pragma unroll
            for (int r = 0; r < 16; ++r) X[crow(r, hi) * 132 + d0 * 32 + r32] = o[d0][r];
    }
    __syncthreads();
    if (comp == 0) {
#pragma unroll
        for (int d0 = 0; d0 < 4; ++d0)
#pragma unroll
            for (int r = 0; r < 16; ++r) { const int ix = crow(r, hi) * 132 + d0 * 32 + r32; X[ix] = o[d0][r] - X[ix]; }
        asm volatile("s_waitcnt lgkmcnt(0)" ::: "memory");
        const int row = lane >> 1, hf = lane & 1;
        const LAS float* xr = X + row * 132 + hf * 64;
        float ss = 0.f;
#pragma unroll
        for (int c = 0; c < 16; ++c) { const f32x4 v = *(const LAS f32x4*)(xr + c * 4); ss += (v.x * v.x + v.y * v.y) + (v.z * v.z + v.w * v.w); }
        ss += __shfl_xor(ss, 1);
        const float rstd = oscale / sqrtf(ss * (1.0f / 128.0f) + EPS);
        bf16_t* op = BR + (size_t)(qrow0 + qg * 32 + row) * 1024 + 512 + h * 128 + hf * 64;
        const float* gp = subg + hf * 64;
#pragma unroll
        for (int c = 0; c < 8; ++c) {
            const f32x4 v0 = *(const LAS f32x4*)(xr + c * 8) * rstd * *(const f32x4*)(gp + c * 8), v1 = *(const LAS f32x4*)(xr + c * 8 + 4) * rstd * *(const f32x4*)(gp + c * 8 + 4);
            u32x4 w; w.x = cvt_pk_bf16(v0.x, v0.y); w.y = cvt_pk_bf16(v0.z, v0.w); w.z = cvt_pk_bf16(v1.x, v1.y); w.w = cvt_pk_bf16(v1.z, v1.w);
            *(u32x4*)(op + c * 8) = w;
        }
    }
    __syncthreads();
#undef AT_TROW
}

__device__ __forceinline__ void norm_rows4(const float* x0, size_t xstride, const float* g, const float* sh, const float* sc, bf16_t* o0, size_t ostride, float* fout, int lane) {
    f32x4 v[4][4]; float ss[4];
#pragma unroll
    for (int r = 0; r < 4; ++r)
#pragma unroll
        for (int j = 0; j < 4; ++j) v[r][j] = *((const f32x4*)(x0 + (size_t)r * xstride) + lane + 64 * j);
#pragma unroll
    for (int r = 0; r < 4; ++r) { float s = 0.f;
#pragma unroll
        for (int j = 0; j < 4; ++j) s += (v[r][j].x * v[r][j].x + v[r][j].y * v[r][j].y) + (v[r][j].z * v[r][j].z + v[r][j].w * v[r][j].w);
        ss[r] = 1.0f / sqrtf(wave_sum(s) * (1.0f / D) + EPS); }
#pragma unroll
    for (int j = 0; j < 4; ++j) {
        const int c = (lane + 64 * j) * 4;
        const f32x4 gv = *(const f32x4*)(g + c);
        if (fout) {
#pragma unroll
            for (int r = 0; r < 4; ++r) *(f32x4*)(fout + (size_t)r * xstride + c) = v[r][j] * ss[r] * gv;
        } else {
            const f32x4 m1 = *(const f32x4*)(sc + c) + 1.0f, sv = *(const f32x4*)(sh + c);
#pragma unroll
            for (int r = 0; r < 4; ++r) { const f32x4 y = v[r][j] * ss[r] * gv * m1 + sv;
                u32x2 w; w.x = cvt_pk_bf16(y.x, y.y); w.y = cvt_pk_bf16(y.z, y.w); *(u32x2*)(o0 + (size_t)r * ostride + c) = w; }
        }
    }
}
__device__ __forceinline__ void norm_phase4(Frame& F, const float* xl, const float* xc, const float* g, const float* mod, int sh_off, int sc_off, bf16_t* H, bool with_ctx) {
    const int gw = F.vcu * 8 + F.wave, NGW = F.G * 8, nrows = with_ctx ? MT : ML;
    for (int r = gw * 4; r < nrows; r += NGW * 4) {
        const int b = r < ML ? (r >> 11) : 8;
        const float* xr = r < ML ? xl + (size_t)r * D : xc + (size_t)(r - ML) * D;
        norm_rows4(xr, D, g, mod + (size_t)b * 6144 + sh_off, mod + (size_t)b * 6144 + sc_off, H + (size_t)r * D, D, nullptr, F.lane);
    }
}
#define XB_TMO      128
#define XB_XCNT(j)  (256  + 64 * (j))
#define XB_XSUB(j)  (1280 + 64 * (j))
#define XB_XGEN(j)  (2304 + 64 * (j))
#define XB_TOP      3328
#define XB_TOPGEN   3392
#define XCD_BAR_WORDS 3456
#define XB_SPIN_CAP (1u << 18)
__device__ __forceinline__ unsigned xb_ld(unsigned* p)              { return __hip_atomic_load(p, __ATOMIC_RELAXED, __HIP_MEMORY_SCOPE_AGENT); }
__device__ __forceinline__ unsigned xb_add(unsigned* p, unsigned v) { return __hip_atomic_fetch_add(p, v, __ATOMIC_RELAXED, __HIP_MEMORY_SCOPE_AGENT); }
__device__ __forceinline__ unsigned xb_xcc_id() { return (unsigned)__builtin_amdgcn_s_getreg((3 << 11) | 20) & 0xFu; }
#define XB_SPIN(cond, bar) do { unsigned _sp = 0; while (cond) { __builtin_amdgcn_s_sleep(1); \
    if ((++_sp & 255u) == 0u) { if (xb_ld(&(bar)[XB_TMO])) break; if (_sp > XB_SPIN_CAP) { atomicAdd(&(bar)[XB_TMO], 1u); break; } } } } while (0)
struct XcdBarrier { unsigned* bar; unsigned x; volatile LAS unsigned* st; };
__device__ __forceinline__ XcdBarrier xcd_barrier_post(unsigned* bar, volatile LAS unsigned* st) {
    XcdBarrier b; b.bar = bar; b.x = xb_xcc_id(); b.st = st;
    if (threadIdx.x == 0) (void)xb_add(&bar[XB_XCNT(b.x)], 1u);
    return b;
}
__device__ __forceinline__ void xcd_barrier_complete(unsigned* bar, unsigned x, unsigned& nloc, unsigned& nx) {
    const unsigned G = gridDim.x * gridDim.y * gridDim.z;
    unsigned sum, cnt, mine, sp = 0u;
    for (;;) {
        sum = 0u; cnt = 0u; mine = 0u;
#pragma unroll
        for (unsigned j = 0; j < 16; ++j) { const unsigned c = xb_ld(&bar[XB_XCNT(j)]); sum += c; cnt += (c > 0u) ? 1u : 0u; mine = (j == x) ? c : mine; }
        if (sum == G) break;
        __builtin_amdgcn_s_sleep(1);
        if ((++sp & 255u) == 0u) { if (xb_ld(&bar[XB_TMO])) break; if (sp > XB_SPIN_CAP) { atomicAdd(&bar[XB_TMO], 1u); break; } }
    }
    nloc = mine > 0u ? mine : 1u; nx = cnt > 0u ? cnt : 1u;
}
__device__ __forceinline__ void xcd_barrier(const XcdBarrier& b) {
    asm volatile("s_waitcnt vmcnt(0)" ::: "memory");
    __syncthreads();
    if (threadIdx.x == 0) {
        unsigned* bar = b.bar;
        __builtin_amdgcn_s_waitcnt(0);
        unsigned nloc = b.st[0], nx = b.st[1];
        if (nloc == 0u) { xcd_barrier_complete(bar, b.x, nloc, nx); b.st[0] = nloc; b.st[1] = nx; }
        const unsigned old = xb_add(&bar[XB_XSUB(b.x)], 1u);
        const unsigned gen = old / nloc;
        if (old + 1u == (gen + 1u) * nloc) {
            __builtin_amdgcn_fence(__ATOMIC_RELEASE, "agent");
            asm volatile("s_waitcnt vmcnt(0)" ::: "memory");
            const unsigned og = xb_add(&bar[XB_TOP], 1u);
            const unsigned tg = og / nx;
            if (og + 1u == (tg + 1u) * nx) xb_add(&bar[XB_TOPGEN], 1u);
            else XB_SPIN(xb_ld(&bar[XB_TOPGEN]) == tg, bar);
            __builtin_amdgcn_fence(__ATOMIC_ACQUIRE, "agent");
            xb_add(&bar[XB_XGEN(b.x)], 1u);
            asm volatile("s_waitcnt vmcnt(0)" ::: "memory");
        } else {
            XB_SPIN(xb_ld(&bar[XB_XGEN(b.x)]) == gen, bar);
            __builtin_amdgcn_fence(__ATOMIC_ACQUIRE, "agent");
            asm volatile("s_waitcnt vmcnt(0)" ::: "memory");
        }
    }
    __syncthreads();
}

constexpr int N_PHASES = 20;
__global__ void __launch_bounds__(512, 2) fwd_kernel(Args args) {
    extern __shared__ __attribute__((aligned(16))) unsigned char lds_raw[];
    Frame F;
    F.lds = (LAS unsigned char*)lds_raw;
    F.tid = threadIdx.x; F.lane = F.tid & 63; F.wave = __builtin_amdgcn_readfirstlane(F.tid >> 6);
    F.G = gridDim.x; F.bx = blockIdx.x; F.vcu = (F.G % 8 == 0) ? (F.bx % 8) * (F.G / 8) + F.bx / 8 : F.bx; F.rot = 0;
    unsigned char* const ws = args.ws;
    float* const XL = args.out;
    if (F.tid < 2) ((LAS unsigned*)(F.lds + LDS_XB))[F.tid] = 0u;
    __syncthreads();
    if (args.ph_hi - args.ph_lo > 1) (void)xcd_barrier_post((unsigned*)(ws + WS_BAR), (volatile LAS unsigned*)(F.lds + LDS_XB));
#define WSP(T, off) ((T*)(ws + (off)))
#pragma unroll 1
    for (int ph = args.ph_lo, rep = 0; ph < args.ph_hi;) {
#define REFRESH_LANE() do { int l_ = (int)__builtin_amdgcn_mbcnt_hi(~0u, __builtin_amdgcn_mbcnt_lo(~0u, 0u)); asm volatile("" : "+v"(l_)); F.lane = l_; F.tid = F.wave * 64 + l_; } while (0)
        REFRESH_LANE();
        const int kind = ph < 2 ? ph : 2 + (ph - 2) % 9;
        const int l = ph < 2 ? 0 : (ph - 2) / 9;
        const bool last = (l == 1);
        const float* mod = WSP(float, WS_MOD) + (size_t)l * 9 * 6144;
        const float* biasin = WSP(float, WS_BIASIN) + l * NIN;
        if (kind == 0) {
            LAS float* ct = (LAS float*)(F.lds + LDS_COSTAB);
            for (int i = F.tid; i < 2048; i += 512) ct[i] = cospif((float)i * (1.0f / 1024.0f));
            __syncthreads();
        }
        if (kind == 0) {
            if (F.bx < 192) {
                LAS float* sv = (LAS float*)F.lds;
                LAS float* red = (LAS float*)(F.lds + 40960);
                for (int i = F.tid; i < 9 * 1024; i += 512) { const int r = i >> 10, k = i & 1023; const float c = r < 8 ? args.in[I_C][r * 1024 + k] : args.in[I_CCTX][k]; sv[i] = c / (1.0f + __expf(-c)); }
                __syncthreads();
                for (int job = F.bx; job < 192; job += F.G) {
                    const int jl = job / 96, n0 = (job % 96) * 64, kg = F.tid >> 6, nn = F.tid & 63;
                    const float* wp = args.in[I_WADA] + (size_t)jl * D * 6144 + (size_t)(kg * 128) * 6144 + n0 + nn;
                    float ac[9];
#pragma unroll
                    for (int r = 0; r < 9; ++r) ac[r] = 0.f;
#pragma unroll 1
                    for (int k0 = 0; k0 < 128; k0 += 16) {
                        float wv[16];
#pragma unroll
                        for (int i = 0; i < 16; ++i) wv[i] = wp[(size_t)(k0 + i) * 6144];
#pragma unroll
                        for (int i = 0; i < 16; ++i)
#pragma unroll
                            for (int r = 0; r < 9; ++r) ac[r] += sv[r * 1024 + kg * 128 + k0 + i] * wv[i]; }
#pragma unroll
                    for (int r = 0; r < 9; ++r) red[(kg * 9 + r) * 64 + nn] = ac[r];
                    __syncthreads();
                    for (int o = F.tid; o < 576; o += 512) { const int r = o >> 6, n = o & 63; float s = args.in[I_BADA][jl * 6144 + n0 + n];
#pragma unroll
                        for (int q = 0; q < 8; ++q) s += red[(q * 9 + r) * 64 + n];
                        WSP(float, WS_MOD)[((size_t)jl * 9 + r) * 6144 + n0 + n] = s; }
                    __syncthreads();
                }
            }
            __syncthreads();
            if (F.bx == F.G - 1) {
                float* ROPE = WSP(float, WS_ROPE);
                for (int i = F.tid; i < 1024; i += 512) { const int pos = i >> 4, f = i & 15; const float fr = powf(10000.0f, -(float)f * (1.0f / 16.0f)); const float ang = (float)pos * fr; ROPE[i] = cosf(ang); ROPE[1024 + i] = sinf(ang); }
                if (F.tid < 2) { const int jl = F.tid; float s1 = 0.f, s2 = 0.f;
                    for (int j = 0; j < 64; ++j) { s1 += args.in[I_LQ1][jl * 64 + j] * args.in[I_LK1][jl * 64 + j]; s2 += args.in[I_LQ2][jl * 64 + j] * args.in[I_LK2][jl * 64 + j]; }
                    WSP(float, WS_LAM)[jl] = expf(s1) - expf(s2) + (0.8f - 0.6f * expf(-0.3f * (float)jl)); }
            }
            __syncthreads();
        }
        if (kind == 0) { REFRESH_LANE(); conv_setA(F, args, 0, F.vcu, F.G, 1); }
        if (kind == 1 || kind == 7 || (kind == 10 && !last)) {
            REFRESH_LANE();
            const bool n2 = (kind == 7);
            const float* xl = (kind == 1) ? args.in[I_X] : XL;
            const float* xc = (kind == 1) ? args.in[I_CTX] : WSP(float, WS_XC);
            const float* g = n2 ? args.in[I_N2G] + l * 1024 : args.in[I_N1G] + (kind == 10 ? 1024 : 0);
            const float* m = (kind == 10) ? WSP(float, WS_MOD) + (size_t)9 * 6144 : mod;
            norm_phase4(F, xl, xc, g, m, n2 ? 3072 : 0, n2 ? 4096 : 1024, n2 ? WSP(bf16_t, WS_BR) : WSP(bf16_t, WS_H), n2 ? !last : true);
        }
        if (kind == 10 && last) {
            REFRESH_LANE();
            const int gw = F.vcu * 8 + F.wave, NGW = F.G * 8;
            for (int r = gw * 4; r < ML; r += NGW * 4) norm_rows4(XL + (size_t)r * D, D, args.in[I_FING], nullptr, nullptr, nullptr, 0, XL + (size_t)r * D, F.lane);
        }
        if (kind == 3) {
            const float lam = WSP(float, WS_LAM)[l]; const float osc = 1.0f - (0.8f - 0.6f * expf(-0.3f * (float)l)); const float* subg = args.in[I_SUBG] + l * 128;
            const bf16_t* P = WSP(bf16_t, WS_P); bf16_t* BR = WSP(bf16_t, WS_BR);
            const int npairs = (2 * F.vcu < 512) ? (512 - 2 * F.vcu + 2 * F.G - 1) / (2 * F.G) : 0, nlat = 2 * npairs;
#pragma unroll 1
            for (int rp = 0; rp <= PROBE_ATT; ++rp)
#pragma unroll 1
            for (int i = 0;; ++i) {
                int qrow0, base1, n1, base2, nt, h;
                if (i < nlat) { const int un = (i >> 1) * 2 * F.G + 2 * F.vcu + (i & 1); const int bh = un >> 4, qb = un & 15, b = bh >> 2; h = bh & 3;
                    qrow0 = b * SEQ + qb * 128; base1 = b * SEQ; n1 = 32; base2 = ML + b * CTXL; nt = 36; }
                else { const int cu = F.vcu + (i - nlat) * F.G; if (last || cu >= 64) break; const int bh = cu >> 1, qb = cu & 1, b = bh >> 2; h = bh & 3;
                    qrow0 = ML + b * CTXL + qb * 128; base1 = ML + b * CTXL; n1 = 4; base2 = 0; nt = 4; }
                REFRESH_LANE();
                attn_unit(F, P, BR, qrow0, base1, n1, base2, nt, h, lam, osc, subg);
            }
        }
        if (kind == 2) {
            REFRESH_LANE();
            const float* rp = WSP(float, WS_ROPE); LAS float* rl = (LAS float*)(F.lds + LDS_ROPE);
            for (int i = F.tid; i < 2048; i += 512) rl[i] = rp[i];
            __syncthreads();
        }
#pragma unroll 1
        for (int j = 0; j < 4; ++j) {
            GJob J{}; bool have = false;
            J.lda = 1024; J.ldb = 1024; J.K = 1024; J.rot = -1;
            if (kind == 2) {
                if (j < 2) { have = true; J.A = WSP(bf16_t, WS_H) + (j ? (size_t)ML * 1024 : 0); J.Bt = WSP(bf16_t, WS_WIN); J.M = j ? MC : ML; J.N = NP1;
                    J.E.mode = E_INPROJ; J.E.out = WSP(bf16_t, WS_P); J.E.p1 = biasin; J.E.p2 = WSP(float, WS_ROPE); J.E.row_base = j ? ML : 0; J.E.ctx = j; J.E.aux = 0; J.E.p3 = WSP(bf16_t, (l ? WS_FT1 : WS_FT0)); J.E.p4 = WSP(bf16_t, WS_FTC);
                    if (j == 0) J.rot = 0;
                    if (j && last) { J.Bt = WSP(bf16_t, WS_WIN) + (size_t)7 * 256 * 1024; J.N = 1024; J.E.aux = 7; J.E.p1 = biasin + 7 * 256; } }
            } else if (kind == 4) {
                const int nf = (F.G >= 128) ? 64 : 0;
                if (j == 0) { have = true; J.A = WSP(bf16_t, WS_DFT); J.lda = 4096; J.Bt = WSP(bf16_t, (l ? WS_FT1 : WS_FT0)); J.ldb = 4096; J.M = 2048; J.N = 2048; J.K = 4096; J.rot = 0;
                    if (nf) { J.gfirst = 0; J.gsub = nf; }
                    J.E.mode = E_FOUR; J.E.out = WSP(bf16_t, WS_BR); J.E.row_base = 0; J.E.ctx = 0; J.E.scale = 0.02209708691207961f; }
                else if (j == 1 && !last) { have = true; J.A = WSP(bf16_t, WS_DFT256); J.lda = 512; J.Bt = WSP(bf16_t, WS_FTC); J.ldb = 512; J.M = 256; J.N = 2048; J.K = 512; J.rot = 0;
                    if (nf) { J.gfirst = nf; J.gsub = F.G - nf; }
                    J.E.mode = E_FOUR; J.E.out = WSP(bf16_t, WS_BR); J.E.row_base = ML; J.E.ctx = 1; J.E.scale = 0.0625f; }
                else if (j == 2) { have = true; J.A = WSP(bf16_t, WS_H); J.Bt = WSP(bf16_t, WS_WIN) + (size_t)NP1 * 1024; J.M = (last || nf) ? ML : MT; J.N = 3072; J.rot = 0;
                    if (nf) { J.gfirst = nf; J.gsub = F.G - nf; }
                    J.E.mode = E_GATE; J.E.out = WSP(bf16_t, WS_P); J.E.p1 = biasin + NP1; J.E.row_base = 0; }
                else if (j == 3 && !last && nf) { have = true; J.A = WSP(bf16_t, WS_H) + (size_t)ML * 1024; J.Bt = WSP(bf16_t, WS_WIN) + (size_t)NP1 * 1024; J.M = MC; J.N = 3072; J.rot = 0;
                    J.gfirst = 0; J.gsub = nf;
                    J.E.mode = E_GATE; J.E.out = WSP(bf16_t, WS_P); J.E.p1 = biasin + NP1; J.E.row_base = ML; }
            } else if (kind == 5) {
                if (j == 0) { have = true; J.A = WSP(bf16_t, WS_BR); J.Bt = WSP(bf16_t, WS_WB); J.M = last ? ML : MT; J.N = 1024; J.K = 1024; J.rot = 0;
                    J.E.mode = E_BRANCH; J.E.out = WSP(bf16_t, WS_H); J.E.p1 = WSP(bf16_t, WS_P); J.E.aux = 0; J.E.row_base = 0; }
            } else if (kind == 6 || kind == 9) {
                if (j == 0 || (j == 1 && !last)) { have = true;
                    const bool dn = (kind == 9);
                    const bf16_t* Abase = dn ? WSP(bf16_t, WS_P) : WSP(bf16_t, WS_H);
                    J.lda = dn ? DFF : 1024; J.ldb = J.lda; J.K = J.lda;
                    J.A = Abase + (j ? (size_t)ML * J.lda : 0);
                    J.Bt = dn ? WSP(bf16_t, (l ? WS_WD1 : WS_WD0)) : WSP(bf16_t, WS_WOUT);
                    J.M = j ? MC : ML; J.N = 1024; if (j == 0) J.rot = 0;
                    J.E.mode = E_RESID; J.E.ctx = j; J.E.p2 = mod + (dn ? 5120 : 2048);
                    const float* xin_l = (!dn && l == 0) ? args.in[I_X] : XL; const float* xin_c = (!dn && l == 0) ? args.in[I_CTX] : WSP(float, WS_XC);
                    J.E.p1 = j ? xin_c : xin_l; J.E.out = j ? (void*)WSP(float, WS_XC) : (void*)XL; }
            } else if (kind == 8) {
                if (j == 0) { have = true; J.A = WSP(bf16_t, WS_BR); J.Bt = WSP(bf16_t, (l ? WS_WGU1 : WS_WGU0)); J.M = last ? ML : MT; J.N = 2 * DFF; J.rot = 0;
                    J.E.mode = E_GU; J.E.out = WSP(bf16_t, WS_P); J.E.row_base = 0; }
            }
            if (!have) { if (kind == 4) continue; break; }
            REFRESH_LANE();
            gemm_call(F, J);
        }
        if (!last && kind == 2) {
            const int nskip = (F.G > 64) ? 24 : 0;
            if (F.bx >= nskip) {
                const int pidx = F.bx - nskip, pcnt = F.G - nskip;
                REFRESH_LANE();
                { LAS float* ctw = (LAS float*)(F.lds + LDS_COSTAB);
                  for (int i = F.tid; i < 2048; i += 512) ctw[i] = cospif((float)i * (1.0f / 1024.0f));
                  __syncthreads(); }
            {
              const LAS float* ct = (const LAS float*)(F.lds + LDS_COSTAB);
              bf16_t* DFT = WSP(bf16_t, WS_DFT); bf16_t* DFT256 = WSP(bf16_t, WS_DFT256);
              const int gt = pidx * 512 + F.tid, NGT = pcnt * 512;
              for (int q = gt; q < 2048 * 512; q += NGT) { const int k = q >> 9, c8 = (q & 511) * 8; unsigned w[4];
#pragma unroll
                  for (int e = 0; e < 8; e += 2) { float v[2];
#pragma unroll
                      for (int z = 0; z < 2; ++z) { const int np = c8 + e + z; v[z] = np < 2048 ? ct[(k * np) & 2047] : -ct[((k * (np - 2048)) + 1536) & 2047]; }
                      w[e >> 1] = pk2(v[0], v[1]); }
                  *(u32x4*)(DFT + (size_t)k * 4096 + c8) = (u32x4){w[0], w[1], w[2], w[3]}; }
              for (int q = gt; q < 256 * 64; q += NGT) { const int k = q >> 6, c8 = (q & 63) * 8; unsigned w[4];
#pragma unroll
                  for (int e = 0; e < 8; e += 2) { float v[2];
#pragma unroll
                      for (int z = 0; z < 2; ++z) { const int np = c8 + e + z; v[z] = np < 256 ? ct[(((k * np) & 255) * 8) & 2047] : -ct[((((k * (np - 256)) & 255) * 8) + 1536) & 2047]; }
                      w[e >> 1] = pk2(v[0], v[1]); }
                  *(u32x4*)(DFT256 + (size_t)k * 512 + c8) = (u32x4){w[0], w[1], w[2], w[3]}; } }
                __syncthreads();
                REFRESH_LANE();
                conv_setA(F, args, 0, pidx, pcnt, 2);
            }
        }
        if (!last && (kind == 6 || kind == 9)) {
            const int nskip = (F.G > 64) ? 32 : 0;
            if (F.bx >= nskip) {
                const int pidx = F.bx - nskip, pcnt = F.G - nskip;
                if (kind == 6) { REFRESH_LANE(); conv_setB(F, args, 0, pidx, pcnt); }
                else {
                    LAS float* ct = (LAS float*)(F.lds + LDS_COSTAB);
                    REFRESH_LANE();
                    for (int i = F.tid; i < 2048; i += 512) ct[i] = cospif((float)i * (1.0f / 1024.0f));
                    __syncthreads();
                    conv_setA(F, args, 1, pidx, pcnt, 3);
                    REFRESH_LANE();
                    conv_setB(F, args, 1, pidx, pcnt);
                }
            }
        }
        if (kind == 3) {
            REFRESH_LANE();
            const bf16_t* P = WSP(bf16_t, WS_P); bf16_t* BR = WSP(bf16_t, WS_BR);
            const float* cw = args.in[I_CONVW] + l * 768; const float* cb_ = args.in[I_CONVB] + l * 256;
            const int cskip = (!last && F.G >= 128) ? 64 : 0;
            const int nrows = last ? ML : MT, gt = (F.vcu - cskip) * 512 + F.tid, NGT = (F.G - cskip) * 512;
            for (int idx = (F.vcu >= cskip) ? gt : nrows * 16; idx < nrows * 16; idx += NGT) {
                const int row = (idx >> 5) * 2, c8 = (idx & 31) * 8;
                const int L = row < ML ? SEQ : CTXL, t = row < ML ? (row & (SEQ - 1)) : ((row - ML) & (CTXL - 1));
                const bf16_t* pr = P + (size_t)row * LDP;
                const u32x4 b0v = *(const u32x4*)(pr + PCB + c8), b1v = *(const u32x4*)(pr + LDP + PCB + c8);
                const u32x4 c0 = *(const u32x4*)(pr + PCC + c8), x0 = *(const u32x4*)(pr + PCX + c8), c1 = *(const u32x4*)(pr + LDP + PCC + c8), x1 = *(const u32x4*)(pr + LDP + PCX + c8);
                u32x4 cm = (u32x4){0, 0, 0, 0}, xm = cm, cp = cm, xp = cm;
                if (t > 0) { cm = *(const u32x4*)(pr - LDP + PCC + c8); xm = *(const u32x4*)(pr - LDP + PCX + c8); }
                if (t + 1 < L - 1) { cp = *(const u32x4*)(pr + 2 * LDP + PCC + c8); xp = *(const u32x4*)(pr + 2 * LDP + PCX + c8); }
                unsigned o0[4], o1[4];
#pragma unroll
                for (int e = 0; e < 4; ++e) {
                    const int c = c8 + 2 * e;
                    const float w0l = cw[c], w1l = cw[256 + c], w2l = cw[512 + c], bl = cb_[c], w0h = cw[c + 1], w1h = cw[256 + c + 1], w2h = cw[512 + c + 1], bh = cb_[c + 1];
                    const float zml = bflo(cm[e]) * bflo(xm[e]), zmh = bfhi(cm[e]) * bfhi(xm[e]);
                    const float z0l = bflo(c0[e]) * bflo(x0[e]), z0h = bfhi(c0[e]) * bfhi(x0[e]);
                    const float z1l = bflo(c1[e]) * bflo(x1[e]), z1h = bfhi(c1[e]) * bfhi(x1[e]);
                    const float zpl = bflo(cp[e]) * bflo(xp[e]), zph = bfhi(cp[e]) * bfhi(xp[e]);
                    o0[e] = cvt_pk_bf16(bflo(b0v[e]) * (w0l * zml + w1l * z0l + w2l * z1l + bl), bfhi(b0v[e]) * (w0h * zmh + w1h * z0h + w2h * z1h + bh));
                    o1[e] = cvt_pk_bf16(bflo(b1v[e]) * (w0l * z0l + w1l * z1l + w2l * zpl + bl), bfhi(b1v[e]) * (w0h * z0h + w1h * z1h + w2h * zph + bh));
                }
                *(u32x4*)(BR + (size_t)row * 1024 + 256 + c8) = (u32x4){o0[0], o0[1], o0[2], o0[3]};
                *(u32x4*)(BR + (size_t)(row + 1) * 1024 + 256 + c8) = (u32x4){o1[0], o1[1], o1[2], o1[3]};
            }
        }
        const bool dup_again = (rep == 0) && (((DUP_MASK) >> kind) & 1);
        if (ph + 1 < args.ph_hi || dup_again) {
            if (args.ph_hi > 1000) cg::this_grid().sync();
            { XcdBarrier xbar; xbar.bar = (unsigned*)(ws + WS_BAR); xbar.x = xb_xcc_id(); xbar.st = (volatile LAS unsigned*)(F.lds + LDS_XB); xcd_barrier(xbar); }
        }
        if (dup_again) rep = 1; else { rep = 0; ++ph; }
    }
#undef WSP
}


#ifndef DBG_STOP
#define DBG_STOP N_PHASES
#endif
#ifndef DBG_DUMP
#define DBG_DUMP 0
#endif
__global__ void dbg_dump(const bf16_t* src, float* out, size_t n) {
    for (size_t i = (size_t)blockIdx.x * blockDim.x + threadIdx.x; i < n; i += (size_t)gridDim.x * blockDim.x) out[i] = __uint_as_float(((unsigned)src[i]) << 16);
}
extern "C" void kernel_launch(void* const* d_in, const int* in_sizes, int n_in, void* d_out, int out_size, void* d_ws, size_t ws_size, hipStream_t stream) {
    static int grid = 0;
    if (grid == 0) {
        if (n_in != 25 || in_sizes[0] != ML * D || out_size != ML * D || ws_size < WS_END) { fprintf(stderr, "kernel_launch: unexpected shapes (n_in %d, in0 %d, out %d, ws %zu)\n", n_in, n_in > 0 ? in_sizes[0] : -1, out_size, ws_size); grid = -1; return; }
        int dev = 0, cus = 0, per_cu = 0;
        hipGetDevice(&dev); hipDeviceGetAttribute(&cus, hipDeviceAttributeMultiprocessorCount, dev);
        if (hipFuncSetAttribute((const void*)fwd_kernel, hipFuncAttributeMaxDynamicSharedMemorySize, LDS_BYTES) != hipSuccess) { fprintf(stderr, "kernel_launch: hipFuncSetAttribute failed\n"); grid = -1; return; }
        if (hipOccupancyMaxActiveBlocksPerMultiprocessor(&per_cu, (const void*)fwd_kernel, 512, LDS_BYTES) != hipSuccess || per_cu < 1) { fprintf(stderr, "kernel_launch: occupancy query says %d\n", per_cu); per_cu = 1; }
        (void)hipGetLastError();
        grid = cus * 1;
        if (grid <= 0) grid = 256;
    }
    if (grid < 0) return;
    if (hipMemsetAsync((unsigned char*)d_ws + WS_BAR, 0, 16384, stream) != hipSuccess) { fprintf(stderr, "kernel_launch: memset failed\n"); return; }
    Args a{};
    for (int i = 0; i < 25; ++i) a.in[i] = (const float*)d_in[i];
    a.out = (float*)d_out; a.ws = (unsigned char*)d_ws;
#if MK_MULTI_LAUNCH
    for (int p = 0; p < DBG_STOP; ++p) {
        a.ph_lo = p; a.ph_hi = p + 1;
        hipLaunchKernelGGL(fwd_kernel, dim3(grid), dim3(512), LDS_BYTES, stream, a);
    }
#else
    a.ph_lo = 0; a.ph_hi = DBG_STOP;
    void* kargs[] = {&a};
    hipError_t e = hipLaunchCooperativeKernel((const void*)fwd_kernel, dim3(grid), dim3(512), kargs, LDS_BYTES, stream);
    if (e != hipSuccess) fprintf(stderr, "kernel_launch: cooperative launch failed: %s (grid %d)\n", hipGetErrorString(e), grid);
#endif
#if DBG_DUMP
    { const size_t off = DBG_DUMP == 1 ? WS_H : (DBG_DUMP == 2 ? WS_BR : (DBG_DUMP == 3 ? WS_P : WS_FT0));
      hipLaunchKernelGGL(dbg_dump, dim3(2048), dim3(256), 0, stream, (const bf16_t*)((unsigned char*)d_ws + off), (float*)d_out, (size_t)(DBG_DUMP == 4 ? 8 : 16) * 1024 * 1024); }
#endif
}
```

```cpp
#include <hip/hip_runtime.h>
#include <hip/hip_cooperative_groups.h>
#include <cstdio>
#include <cstdint>
namespace cg = cooperative_groups;

#ifndef PROBE_ATT
#define PROBE_ATT 0
#endif
#ifndef PROBE_FOUR
#define PROBE_FOUR 0
#endif
#ifndef DUP_MASK
#define DUP_MASK 0
#endif
#ifndef MK_MULTI_LAUNCH
#define MK_MULTI_LAUNCH 0
#endif

#define LAS __attribute__((address_space(3)))
#define GAS __attribute__((address_space(1)))
typedef unsigned short bf16_t;
typedef short bf16x8 __attribute__((ext_vector_type(8)));
typedef short s16x4 __attribute__((ext_vector_type(4)));
typedef float f32x4 __attribute__((ext_vector_type(4)));
typedef float f32x16 __attribute__((ext_vector_type(16)));
typedef unsigned u32x4 __attribute__((ext_vector_type(4)));
typedef unsigned u32x2 __attribute__((ext_vector_type(2)));

constexpr int D = 1024, NB = 8, SEQ = 2048, CTXL = 256, DFF = 2816;
constexpr int ML = NB * SEQ;
constexpr int MC = NB * CTXL;
constexpr int MT = ML + MC;
constexpr int DIN = 5632;
constexpr int NIN = 5888;
constexpr int NP1 = 2816;
constexpr int LDP = 2304;
constexpr int PCB = 0, PCC = 256, PCX = 512, PQ = 768, PK = 1280, PV = 1792;
constexpr float QSCALE = 0.125f * 1.4426950408889634f;
constexpr float EPS = 1e-6f;

constexpr size_t MiB = 1u << 20;
constexpr size_t WS_MOD = 0;
constexpr size_t WS_ROPE = 448 * 1024;
constexpr size_t WS_BIASIN = 464 * 1024;
constexpr size_t WS_LAM = 1020 * 1024;
constexpr size_t WS_DFT256 = 1 * MiB;
constexpr size_t WS_DFT = 2 * MiB;
constexpr size_t WS_XC = 18 * MiB;
constexpr size_t WS_WIN = 26 * MiB;
constexpr size_t WS_WB = WS_WIN + 5888 * 1024 * 2;
constexpr size_t WS_WOUT = WS_WB + 2 * MiB;
constexpr size_t WS_WGU0 = WS_WOUT + 2 * MiB;
constexpr size_t WS_WD0 = WS_WGU0 + 11 * MiB;
constexpr size_t WS_WGU1 = WS_WD0 + 5632 * 1024;
constexpr size_t WS_WD1 = WS_WGU1 + 11 * MiB;
constexpr size_t WS_H = 75 * MiB;
constexpr size_t WS_BR = 111 * MiB;
constexpr size_t WS_P = 147 * MiB;
constexpr size_t WS_FT0 = WS_WGU1, WS_FT1 = WS_WGU0, WS_FTC = WS_XC;
constexpr size_t WS_BAR = 255 * MiB;
constexpr size_t WS_END = 255 * MiB + 65536;
static_assert(WS_WD1 + 5632 * 1024 <= WS_H && WS_FT0 + 16 * MiB <= WS_H && WS_FT1 + 16 * MiB <= WS_WGU1, "ws map");
static_assert((size_t)MT * LDP * 2 <= 81 * MiB && (size_t)MT * 3072 * 2 <= 108 * MiB, "ws map");

constexpr int LDS_BYTES = 155648;
constexpr int LDS_ROPE = 147456;
constexpr int LDS_XB = 144384;
constexpr int LDS_COSTAB = 131072;

typedef float f32x2_t __attribute__((ext_vector_type(2))); typedef __bf16 bf16x2_t __attribute__((ext_vector_type(2)));
__device__ __forceinline__ unsigned cvt_pk_bf16(float lo, float hi) { f32x2_t v = {lo, hi}; bf16x2_t b = __builtin_convertvector(v, bf16x2_t); return __builtin_bit_cast(unsigned, b); }
__device__ __forceinline__ unsigned f2bf(float f) { unsigned u = __float_as_uint(f); return (u + 0x7fffu + ((u >> 16) & 1u)) >> 16; }
__device__ __forceinline__ unsigned pk2(float lo, float hi) { return f2bf(lo) | (f2bf(hi) << 16); }
__device__ __forceinline__ float bflo(unsigned w) { return __uint_as_float(w << 16); }
__device__ __forceinline__ float bfhi(unsigned w) { return __uint_as_float(w & 0xffff0000u); }
__device__ __forceinline__ float fast_exp2(float x) { return __builtin_amdgcn_exp2f(x); }
__device__ __forceinline__ float fast_rcp(float x) { return __builtin_amdgcn_rcpf(x); }
__device__ __forceinline__ float sigmoidf_(float x) { return fast_rcp(1.0f + fast_exp2(-1.4426950408889634f * x)); }
__device__ __forceinline__ float wave_sum(float v) {
#pragma unroll
    for (int o = 1; o < 64; o <<= 1) v += __shfl_xor(v, o);
    return v;
}

namespace pg8 {
constexpr int BM = 256, BK = 64, HALF = 128, HTB = HALF * BK * 2, STAGE_BYTES = 8 * HTB, NXCD = 8, WGM = 4;
__host__ __device__ __forceinline__ int lds_byte(int r, int c) { const int st = (r >> 4) * 2 + (c >> 5), rr = r & 15, cc = c & 31, ob = rr * 64 + cc * 2; return st * 1024 + (ob ^ (((ob >> 9) & 1) << 5)); }
__host__ __device__ __forceinline__ void stage_rc(int b, int& R, int& C) { const int st = b / 1024, sb = b % 1024, swz = sb ^ (((sb >> 9) & 1) << 5); R = (st >> 1) * 16 + swz / 64; C = (st & 1) * 32 + (swz % 64) / 2; }
__host__ __device__ __forceinline__ int perm32(int rho) { const int n = rho >> 4, i = rho & 15; return 8 * (i >> 2) + 4 * n + (i & 3); }
struct Unit { int pm, pn; };
struct Gemm { const bf16_t* A; const bf16_t* Bt; int M, N, K, lda, ldb; };
struct StaticOrder {
    int nM, nN, nwg, G, c;
    __device__ void init(int M, int N, int G_, int c_) { nM = M / BM; nN = N / BM; nwg = nM * nN; G = G_; c = c_; }
    __device__ bool next(int i, Unit& u) const {
        const long L = (long)i * G + c; if (L >= nwg) return false;
        int wgid = (int)L; { const int q = nwg / NXCD, r = nwg % NXCD, xcd = wgid % NXCD, off = wgid / NXCD; wgid = (xcd < r ? xcd * (q + 1) : r * (q + 1) + (xcd - r) * q) + off; }
        const int nig = WGM * nN, gid = wgid / nig, fm = gid * WGM, gsz = (nM - fm) < WGM ? (nM - fm) : WGM;
        u.pm = fm + ((wgid % nig) % gsz); u.pn = (wgid % nig) / gsz; return true;
    }
};

template <class Epi, class Sched>
__device__ __forceinline__ void gemm_phase(LAS unsigned char* lds, const Gemm g, const Sched& S, const Epi& E, const int tid) {
    const int wid = __builtin_amdgcn_readfirstlane(tid >> 6), lane = tid & 63, wr = wid >> 2, wc = wid & 3, fr = lane & 15, fq = lane >> 4;
    const int K = g.K, nt = K / BK;
    unsigned voffA[2], voffB[2];
#pragma unroll
    for (int i = 0; i < 2; ++i) { int R, C; stage_rc(tid * 16 + i * 8192, R, C); const int Rb = (R & ~31) + perm32(R & 31);
        voffA[i] = (unsigned)(R * g.lda + C) * 2u; voffB[i] = (unsigned)(Rb * g.ldb + C) * 2u; }
    const size_t kstep = (size_t)(BK * 2);
    const size_t hA = (size_t)HALF * g.lda * 2, hB = (size_t)HALF * g.ldb * 2;
    const size_t tA = 2 * hA, tB = 2 * hB;
    const unsigned ldsw = (unsigned)wid * 1024u;
    const int aoff = lds_byte(wr * 64 + fr, fq * 8), boff = lds_byte(wc * 32 + fr, fq * 8);
#define PG8_SA(b, h) (((b) * 2 + (h)) * HTB)
#define PG8_SB(b, h) ((4 + (b) * 2 + (h)) * HTB)
#define PG8_STAGE(bufoff, gbase, voff) do { _Pragma("unroll") for (int _i = 0; _i < 2; ++_i) \
        __builtin_amdgcn_global_load_lds((const unsigned*)((const char*)(gbase) + (voff)[_i]), (LAS unsigned*)(lds + (bufoff) + ldsw + _i * 8192), 16, 0, 0); } while (0)
#define PG8_LDA(dst, b, h) do { _Pragma("unroll") for (int m = 0; m < 4; ++m) _Pragma("unroll") for (int k = 0; k < 2; ++k) dst[m][k] = *(const LAS bf16x8*)(lds + PG8_SA(b, h) + aoff + m * 2048 + k * 1024); } while (0)
#define PG8_LDB(dst, b, h) do { _Pragma("unroll") for (int n = 0; n < 2; ++n) _Pragma("unroll") for (int k = 0; k < 2; ++k) dst[n][k] = *(const LAS bf16x8*)(lds + PG8_SB(b, h) + boff + n * 2048 + k * 1024); } while (0)
#define PG8_MMA(ai, bj, At, Bt) do { __builtin_amdgcn_s_setprio(1); _Pragma("unroll") for (int m = 0; m < 4; ++m) _Pragma("unroll") for (int n = 0; n < 2; ++n) _Pragma("unroll") for (int k = 0; k < 2; ++k) \
        acc[ai][bj][m][n] = __builtin_amdgcn_mfma_f32_16x16x32_bf16(Bt[n][k], At[m][k], acc[ai][bj][m][n], 0, 0, 0); __builtin_amdgcn_s_setprio(0); } while (0)
#define PG8_WAIT_V(n) asm volatile("s_waitcnt vmcnt(" #n ")" ::: "memory")
#define PG8_WAIT_L(n) asm volatile("s_waitcnt lgkmcnt(" #n ")" ::: "memory")
#define PG8_BAR __builtin_amdgcn_s_barrier()
#define PG8_SCHED __builtin_amdgcn_sched_barrier(0)
    Unit cur, nxt; int ui = 0;
    if (!S.next(0, cur)) return;
    const bool hz = E.horner();
    f32x4 acc[2][2][4][2];
#pragma unroll
    for (int a = 0; a < 2; ++a)
#pragma unroll
        for (int b = 0; b < 2; ++b)
#pragma unroll
            for (int m = 0; m < 4; ++m)
#pragma unroll
                for (int n = 0; n < 2; ++n) acc[a][b][m][n] = (f32x4){0.f, 0.f, 0.f, 0.f};
    bf16x8 At[4][2], B0[2][2], B1[2][2];
    const char* cA = (const char*)g.A + (size_t)cur.pm * tA; const char* cB = (const char*)g.Bt + (size_t)cur.pn * tB;
    PG8_STAGE(PG8_SB(0, 0), cB, voffB); PG8_STAGE(PG8_SB(0, 1), cB + hB, voffB); PG8_STAGE(PG8_SA(0, 0), cA, voffA); PG8_STAGE(PG8_SA(0, 1), cA + hA, voffA);
    if (wr == 1) PG8_BAR;
    PG8_WAIT_V(2); PG8_BAR;
    PG8_STAGE(PG8_SB(1, 0), cB + kstep, voffB); PG8_STAGE(PG8_SA(1, 0), cA + kstep, voffA); PG8_STAGE(PG8_SB(1, 1), cB + hB + kstep, voffB);
    PG8_WAIT_V(6); PG8_BAR;
    for (;;) {
        const bool has_next = S.next(ui + 1, nxt);
        const char* nA = has_next ? (const char*)g.A + (size_t)nxt.pm * tA : cA; const char* nB = has_next ? (const char*)g.Bt + (size_t)nxt.pn * tB : cB;
        for (int t = 0; t < nt; t += 2) {
            if (hz && (t == 4 || t == 8)) E.mid(acc, cur, t >> 3, wr, wc, fr, fq);
            const bool last = (t == nt - 2);
            const char* a1 = cA + (size_t)(t + 1) * kstep;
            const char* a2 = last ? nA : cA + (size_t)(t + 2) * kstep; const char* b2 = last ? nB : cB + (size_t)(t + 2) * kstep;
            const char* a3 = a2 + kstep; const char* b3 = b2 + kstep;
            PG8_LDB(B0, 0, 0); PG8_LDB(B1, 0, 1); PG8_SCHED; PG8_LDA(At, 0, 0); PG8_STAGE(PG8_SA(1, 1), a1 + hA, voffA);
            PG8_WAIT_V(8); PG8_WAIT_L(0); PG8_BAR; PG8_MMA(0, 0, At, B0); PG8_MMA(0, 1, At, B1); PG8_BAR; PG8_SCHED;
            PG8_LDA(At, 0, 1); PG8_STAGE(PG8_SB(0, 0), b2, voffB); PG8_STAGE(PG8_SB(0, 1), b2 + hB, voffB); PG8_STAGE(PG8_SA(0, 0), a2, voffA);
            PG8_WAIT_V(8); PG8_WAIT_L(0); PG8_BAR; PG8_MMA(1, 0, At, B0); PG8_MMA(1, 1, At, B1); PG8_BAR; PG8_SCHED;
            PG8_LDB(B0, 1, 0); PG8_LDB(B1, 1, 1); PG8_SCHED; PG8_LDA(At, 1, 0); PG8_STAGE(PG8_SA(0, 1), a2 + hA, voffA);
            PG8_WAIT_V(8); PG8_WAIT_L(0); PG8_BAR; PG8_MMA(0, 0, At, B0); PG8_MMA(0, 1, At, B1); PG8_BAR; PG8_SCHED;
            PG8_LDA(At, 1, 1); PG8_STAGE(PG8_SB(1, 0), b3, voffB); PG8_STAGE(PG8_SB(1, 1), b3 + hB, voffB); PG8_STAGE(PG8_SA(1, 0), a3, voffA);
            PG8_WAIT_V(8); PG8_WAIT_L(0); PG8_BAR; PG8_MMA(1, 0, At, B0); PG8_MMA(1, 1, At, B1); PG8_BAR; PG8_SCHED;
        }
        if (wr == 0) PG8_BAR;
        E(acc, cur, wr, wc, fr, fq);
        if (!has_next) break;
#pragma unroll
        for (int a = 0; a < 2; ++a)
#pragma unroll
            for (int b = 0; b < 2; ++b)
#pragma unroll
                for (int m = 0; m < 4; ++m)
#pragma unroll
                    for (int n = 0; n < 2; ++n) acc[a][b][m][n] = (f32x4){0.f, 0.f, 0.f, 0.f};
        cur = nxt; cA = nA; cB = nB; ++ui;
        if (wr == 1) PG8_BAR;
    }
    PG8_WAIT_V(0);
    PG8_BAR;
#undef PG8_SA
#undef PG8_SB
#undef PG8_STAGE
#undef PG8_LDA
#undef PG8_LDB
#undef PG8_MMA
#undef PG8_WAIT_V
#undef PG8_WAIT_L
#undef PG8_BAR
#undef PG8_SCHED
}
}

enum { E_INPROJ = 0, E_GATE = 1, E_BRANCH = 2, E_RESID = 3, E_GU = 4, E_FOUR = 5 };
constexpr int LDS_EPI = 143360;
struct EpiD {
    int mode;
    int row_base;
    int ctx;
    int aux;
    float scale;
    int pad;
    void* out;
    const void* p1;
    const void* p2;
    void* p3; void* p4;
};
#define RFL2(x) ((unsigned)__builtin_amdgcn_readfirstlane((int)(x)))
struct Epi {
    const LAS unsigned* ed;
    __device__ __forceinline__ bool horner() const { return __builtin_amdgcn_readfirstlane((int)ed[0]) == E_BRANCH; }
    __device__ __forceinline__ void mid(f32x4 (&acc)[2][2][4][2], const pg8::Unit& u, int which, int wr, int wc, int fr, int fq) const {
        asm volatile("" : "+v"(fr), "+v"(fq));
        const int row_base = __builtin_amdgcn_readfirstlane((int)ed[1]);
        const unsigned lo = (unsigned)__builtin_amdgcn_readfirstlane((int)ed[8]), hi_ = (unsigned)__builtin_amdgcn_readfirstlane((int)ed[9]);
        const bf16_t* gbase = (const bf16_t*)(((unsigned long long)hi_ << 32) | lo) + (size_t)(row_base + u.pm * 256 + wr * 64 + fr) * 3072 + which * 1024 + u.pn * 256 + wc * 32 + 8 * fq;
#pragma unroll
        for (int ai = 0; ai < 2; ++ai) {
            u32x4 na[4][2], nb[4][2];
#pragma unroll
            for (int m = 0; m < 4; ++m)
#pragma unroll
                for (int bj = 0; bj < 2; ++bj) { const bf16_t* gp = gbase + (size_t)(ai * 128 + m * 16) * 3072 + bj * 128; na[m][bj] = *(const GAS u32x4*)gp; nb[m][bj] = *(const GAS u32x4*)(gp + 1024); }
            __builtin_amdgcn_sched_barrier(0);
#pragma unroll
            for (int m = 0; m < 4; ++m)
#pragma unroll
                for (int bj = 0; bj < 2; ++bj) {
                    const u32x4 xa = na[m][bj], xb = nb[m][bj];
                    f32x4 r0, r1;
                    r0[0] = bflo(xa.x) * fast_rcp(bflo(xb.x)); r0[1] = bfhi(xa.x) * fast_rcp(bfhi(xb.x)); r0[2] = bflo(xa.y) * fast_rcp(bflo(xb.y)); r0[3] = bfhi(xa.y) * fast_rcp(bfhi(xb.y));
                    r1[0] = bflo(xa.z) * fast_rcp(bflo(xb.z)); r1[1] = bfhi(xa.z) * fast_rcp(bfhi(xb.z)); r1[2] = bflo(xa.w) * fast_rcp(bflo(xb.w)); r1[3] = bfhi(xa.w) * fast_rcp(bfhi(xb.w));
                    acc[ai][bj][m][0] = acc[ai][bj][m][0] * r0; acc[ai][bj][m][1] = acc[ai][bj][m][1] * r1;
                }
            __builtin_amdgcn_sched_barrier(0);
        }
    }
    __device__ __forceinline__ void operator()(const f32x4 (&acc)[2][2][4][2], const pg8::Unit& u, int wr, int wc, int fr, int fq) const {
        asm volatile("" : "+v"(fr), "+v"(fq));
#define RFL(x) ((unsigned)__builtin_amdgcn_readfirstlane((int)(x)))
        const int mode = (int)RFL(ed[0]), row_base = (int)RFL(ed[1]), ctx = (int)RFL(ed[2]), aux = (int)RFL(ed[3]);
        const float scale = __uint_as_float(RFL(ed[4]));
        void* const out = (void*)(((unsigned long long)RFL(ed[7]) << 32) | RFL(ed[6]));
        const void* const p1 = (const void*)(((unsigned long long)RFL(ed[9]) << 32) | RFL(ed[8]));
        const void* const p2 = (const void*)(((unsigned long long)RFL(ed[11]) << 32) | RFL(ed[10]));
#undef RFL
        const int r0 = u.pm * 256 + wr * 64 + fr;
        const int c0 = wc * 32 + 8 * fq;
        const int colt = u.pn * 256;
        if (mode == E_INPROJ) {
            const int ct = aux + u.pn;
            const float* bias = (const float*)p1;
            if (ct < 2) {
                const int gpm = (row_base >> 8) + u.pm;
                bf16_t* dst; int ld, n0;
                if (ctx) { const int b = gpm - 64; dst = (bf16_t*)(((unsigned long long)RFL2(ed[15]) << 32) | RFL2(ed[14])) + (size_t)(b * 256) * 512 + ct * 256; ld = 512; n0 = 0; }
                else { const int b = gpm >> 3; dst = (bf16_t*)(((unsigned long long)RFL2(ed[13]) << 32) | RFL2(ed[12])) + (size_t)(b * 256) * 4096 + ct * 2048; ld = 4096; n0 = (gpm & 7) * 256; }
                LAS unsigned char* stg = (LAS unsigned char*)ed - LDS_EPI + 131072 + (wr * 4 + wc) * 1536;
                const int lane_ = fq * 16 + fr, tcol = lane_ >> 1, thalf = lane_ & 1;
#pragma unroll
                for (int bj = 0; bj < 2; ++bj) {
                    const f32x4 b0 = *(const GAS f32x4*)(bias + colt + bj * 128 + c0), b1 = *(const GAS f32x4*)(bias + colt + bj * 128 + c0 + 4);
                    bf16_t* dcol = dst + (size_t)(bj * 128 + wc * 32 + tcol) * ld + n0 + wr * 64 + thalf * 8;
#pragma unroll
                    for (int ai = 0; ai < 2; ++ai)
#pragma unroll
                        for (int m = 0; m < 4; ++m) {
                            const f32x4 v0 = acc[ai][bj][m][0] + b0, v1 = acc[ai][bj][m][1] + b1;
                            LAS bf16_t* sp = (LAS bf16_t*)stg + (fq * 8) * 16 + fr;
                            sp[0 * 16] = (bf16_t)f2bf(v0[0]); sp[1 * 16] = (bf16_t)f2bf(v0[1]); sp[2 * 16] = (bf16_t)f2bf(v0[2]); sp[3 * 16] = (bf16_t)f2bf(v0[3]);
                            sp[4 * 16] = (bf16_t)f2bf(v1[0]); sp[5 * 16] = (bf16_t)f2bf(v1[1]); sp[6 * 16] = (bf16_t)f2bf(v1[2]); sp[7 * 16] = (bf16_t)f2bf(v1[3]);
                            asm volatile("s_waitcnt lgkmcnt(0)" ::: "memory");
                            const u32x4 w = *(const LAS u32x4*)(stg + tcol * 32 + thalf * 16);
                            *(GAS u32x4*)(dcol + ai * 128 + m * 16) = w;
                            asm volatile("s_waitcnt lgkmcnt(0)" ::: "memory");
                        }
                }
            } else {
                const bool isqk = (ct >= 5 && ct <= 8), dorope = isqk && !ctx;
                const float sc = (ct == 5 || ct == 6) ? QSCALE : 1.0f;
                const int axis = wc & 1, half = fq >> 1;
                const LAS float* rope = (const LAS float*)((const LAS unsigned char*)ed - LDS_EPI + LDS_ROPE) + 8 * (fq & 1);
                bf16_t* obase = (bf16_t*)out + (size_t)(row_base + r0) * LDP + (ct - 2) * 256 + c0;
#pragma unroll
                for (int bj = 0; bj < 2; ++bj) {
                    const f32x4 b0 = *(const GAS f32x4*)(bias + colt + bj * 128 + c0), b1 = *(const GAS f32x4*)(bias + colt + bj * 128 + c0 + 4);
#pragma unroll
                    for (int ai = 0; ai < 2; ++ai)
#pragma unroll
                        for (int m = 0; m < 4; ++m) {
                            f32x4 v0 = acc[ai][bj][m][0] + b0, v1 = acc[ai][bj][m][1] + b1;
                            if (dorope) {
                                const int t = (row_base + r0 + ai * 128 + m * 16) & 2047, pos = axis ? (t & 63) : (t >> 6);
                                const LAS float* cp = rope + pos * 16;
                                const f32x4 cs0 = *(const LAS f32x4*)cp, cs1 = *(const LAS f32x4*)(cp + 4), sn0 = *(const LAS f32x4*)(cp + 1024), sn1 = *(const LAS f32x4*)(cp + 1028);
                                f32x4 w0, w1;
#pragma unroll
                                for (int j = 0; j < 4; ++j) { w0[j] = __shfl_xor(v0[j], 32); w1[j] = __shfl_xor(v1[j], 32); }
                                if (half) { v0 = v0 * cs0 + w0 * sn0; v1 = v1 * cs1 + w1 * sn1; }
                                else { v0 = v0 * cs0 - w0 * sn0; v1 = v1 * cs1 - w1 * sn1; }
                            }
                            v0 = v0 * sc; v1 = v1 * sc;
                            u32x4 w; w.x = cvt_pk_bf16(v0[0], v0[1]); w.y = cvt_pk_bf16(v0[2], v0[3]); w.z = cvt_pk_bf16(v1[0], v1[1]); w.w = cvt_pk_bf16(v1[2], v1[3]);
                            *(GAS u32x4*)(obase + (size_t)(ai * 128 + m * 16) * LDP + bj * 128) = w;
                        }
                }
            }
        } else if (mode == E_GATE) {
            const float* bias = (const float*)p1;
            bf16_t* obase = (bf16_t*)out + (size_t)(row_base + r0) * 3072 + colt + c0;
#pragma unroll
            for (int bj = 0; bj < 2; ++bj) {
                const f32x4 b0 = *(const GAS f32x4*)(bias + colt + bj * 128 + c0), b1 = *(const GAS f32x4*)(bias + colt + bj * 128 + c0 + 4);
#pragma unroll
                for (int ai = 0; ai < 2; ++ai)
#pragma unroll
                    for (int m = 0; m < 4; ++m) {
                        f32x4 v0 = acc[ai][bj][m][0] + b0, v1 = acc[ai][bj][m][1] + b1;
#pragma unroll
                        for (int j = 0; j < 4; ++j) { v0[j] = fmaxf(sigmoidf_(v0[j]), 1e-18f); v1[j] = fmaxf(sigmoidf_(v1[j]), 1e-18f); }
                        u32x4 w; w.x = cvt_pk_bf16(v0[0], v0[1]); w.y = cvt_pk_bf16(v0[2], v0[3]); w.z = cvt_pk_bf16(v1[0], v1[1]); w.w = cvt_pk_bf16(v1[2], v1[3]);
                        *(GAS u32x4*)(obase + (size_t)(ai * 128 + m * 16) * 3072 + bj * 128) = w;
                    }
            }
        } else if (mode == E_BRANCH) {
            const bf16_t* gbase = (const bf16_t*)p1 + (size_t)(row_base + r0) * 3072 + 2048 + colt + c0;
            bf16_t* ybase = (bf16_t*)out + (size_t)(row_base + r0) * 1024 + colt + c0;
            u32x4 gw[2][4][2];
#pragma unroll
            for (int ai = 0; ai < 2; ++ai)
#pragma unroll
                for (int m = 0; m < 4; ++m)
#pragma unroll
                    for (int bj = 0; bj < 2; ++bj) gw[ai][m][bj] = *(const GAS u32x4*)(gbase + (size_t)(ai * 128 + m * 16) * 3072 + bj * 128);
            __builtin_amdgcn_sched_barrier(0);
#pragma unroll
            for (int ai = 0; ai < 2; ++ai)
#pragma unroll
                for (int m = 0; m < 4; ++m) {
#pragma unroll
                    for (int bj = 0; bj < 2; ++bj) {
                        const u32x4 g = gw[ai][m][bj];
                        const f32x4 g0 = (f32x4){bflo(g.x), bfhi(g.x), bflo(g.y), bfhi(g.y)}, g1 = (f32x4){bflo(g.z), bfhi(g.z), bflo(g.w), bfhi(g.w)};
                        const f32x4 y0 = g0 * acc[ai][bj][m][0], y1 = g1 * acc[ai][bj][m][1];
                        u32x4 w; w.x = cvt_pk_bf16(y0[0], y0[1]); w.y = cvt_pk_bf16(y0[2], y0[3]); w.z = cvt_pk_bf16(y1[0], y1[1]); w.w = cvt_pk_bf16(y1[2], y1[3]);
                        *(GAS u32x4*)(ybase + (size_t)(ai * 128 + m * 16) * 1024 + bj * 128) = w;
                    }
                }
        } else if (mode == E_RESID) {
            const float* xin = (const float*)p1 + (size_t)r0 * 1024 + colt + c0;
            float* xout = (float*)out + (size_t)r0 * 1024 + colt + c0;
            const int b = ctx ? 8 : (u.pm >> 3);
            const float* modg = (const float*)p2 + (size_t)b * 6144 + colt + c0;
            f32x4 gv[2][2];
#pragma unroll
            for (int bj = 0; bj < 2; ++bj) { gv[bj][0] = *(const GAS f32x4*)(modg + bj * 128); gv[bj][1] = *(const GAS f32x4*)(modg + bj * 128 + 4); }
#pragma unroll
            for (int ai = 0; ai < 2; ++ai) {
                f32x4 xv[4][2][2];
#pragma unroll
                for (int m = 0; m < 4; ++m)
#pragma unroll
                    for (int bj = 0; bj < 2; ++bj) { const float* xi = xin + (size_t)(ai * 128 + m * 16) * 1024 + bj * 128; xv[m][bj][0] = *(const GAS f32x4*)xi; xv[m][bj][1] = *(const GAS f32x4*)(xi + 4); }
                __builtin_amdgcn_sched_barrier(0);
#pragma unroll
                for (int m = 0; m < 4; ++m)
#pragma unroll
                    for (int bj = 0; bj < 2; ++bj) { float* xo = xout + (size_t)(ai * 128 + m * 16) * 1024 + bj * 128;
                        *(GAS f32x4*)xo = xv[m][bj][0] + gv[bj][0] * acc[ai][bj][m][0]; *(GAS f32x4*)(xo + 4) = xv[m][bj][1] + gv[bj][1] * acc[ai][bj][m][1]; }
                __builtin_amdgcn_sched_barrier(0);
            }
        } else if (mode == E_GU) {
            bf16_t* obase = (bf16_t*)out + (size_t)(row_base + r0) * DFF + u.pn * 128 + c0;
#pragma unroll
            for (int ai = 0; ai < 2; ++ai)
#pragma unroll
                for (int m = 0; m < 4; ++m) {
                    f32x4 v0, v1;
#pragma unroll
                    for (int j = 0; j < 4; ++j) { const float a = acc[ai][0][m][0][j], b = acc[ai][0][m][1][j];
                        v0[j] = a * sigmoidf_(a) * acc[ai][1][m][0][j]; v1[j] = b * sigmoidf_(b) * acc[ai][1][m][1][j]; }
                    u32x4 w; w.x = cvt_pk_bf16(v0[0], v0[1]); w.y = cvt_pk_bf16(v0[2], v0[3]); w.z = cvt_pk_bf16(v1[0], v1[1]); w.w = cvt_pk_bf16(v1[2], v1[3]);
                    *(GAS u32x4*)(obase + (size_t)(ai * 128 + m * 16) * DFF) = w;
                }
        } else {
            const int L = ctx ? CTXL : SEQ;
            bf16_t* obase = (bf16_t*)out + (size_t)(row_base + u.pn * L + r0) * 1024 + c0;
#pragma unroll
            for (int ai = 0; ai < 2; ++ai)
#pragma unroll
                for (int m = 0; m < 4; ++m) {
#pragma unroll
                    for (int bj = 0; bj < 2; ++bj) {
                        const f32x4 v0 = acc[ai][bj][m][0] * scale, v1 = acc[ai][bj][m][1] * scale;
                        u32x4 w; w.x = cvt_pk_bf16(v0[0], v0[1]); w.y = cvt_pk_bf16(v0[2], v0[3]); w.z = cvt_pk_bf16(v1[0], v1[1]); w.w = cvt_pk_bf16(v1[2], v1[3]);
                        *(GAS u32x4*)(obase + (size_t)(ai * 128 + m * 16) * 1024 + bj * 128) = w;
                    }
                }
        }
    }
};

struct Args {
    const float* in[25];
    float* out; unsigned char* ws;
    int ph_lo, ph_hi;
};
enum { I_X = 0, I_C, I_CTX, I_CCTX, I_WADA, I_BADA, I_N1G, I_N2G, I_WIN, I_BIN, I_CONVW, I_CONVB, I_WFO, I_WCO, I_WAO, I_LQ1, I_LK1, I_LQ2, I_LK2, I_SUBG, I_WOUT, I_WG, I_WU, I_WD, I_FING };

struct Frame {
    LAS unsigned char* lds;
    int tid, lane, wave, G, bx, vcu, rot;
};

struct GJob { const bf16_t* A; const bf16_t* Bt; int lda, ldb, M, N, K, rot; int gfirst, gsub; EpiD E; };
__device__ __forceinline__ void gemm_call(Frame& F, const GJob& j) {
    pg8::Gemm g{j.A, j.Bt, j.M, j.N, j.K, j.lda, j.ldb};
    if (j.rot >= 0) F.rot = j.rot % F.G;
    pg8::StaticOrder S; int c = F.bx - F.rot; if (c < 0) c += F.G;
    int Ge = F.G;
    if (j.gsub > 0) { Ge = j.gsub; c = F.bx - j.gfirst; if (c < 0 || c >= j.gsub) c = 1 << 28; }
    S.init(j.M, j.N, Ge, c);
    if (F.tid == 0) { LAS unsigned* d = (LAS unsigned*)(F.lds + LDS_EPI);
        const unsigned long long o_ = (unsigned long long)j.E.out, a_ = (unsigned long long)j.E.p1, b_ = (unsigned long long)j.E.p2;
        d[0] = (unsigned)j.E.mode; d[1] = (unsigned)j.E.row_base; d[2] = (unsigned)j.E.ctx; d[3] = (unsigned)j.E.aux; d[4] = __float_as_uint(j.E.scale); d[5] = 0u;
        d[6] = (unsigned)o_; d[7] = (unsigned)(o_ >> 32); d[8] = (unsigned)a_; d[9] = (unsigned)(a_ >> 32); d[10] = (unsigned)b_; d[11] = (unsigned)(b_ >> 32);
        const unsigned long long c_ = (unsigned long long)j.E.p3, e_ = (unsigned long long)j.E.p4; d[12] = (unsigned)c_; d[13] = (unsigned)(c_ >> 32); d[14] = (unsigned)e_; d[15] = (unsigned)(e_ >> 32); }
    __syncthreads();
    Epi E{(const LAS unsigned*)(F.lds + LDS_EPI)};
    pg8::gemm_phase<Epi, pg8::StaticOrder>(F.lds, g, S, E, F.tid);
    F.rot = (F.rot + (j.M / 256) * (j.N / 256)) % F.G;
}

__device__ __forceinline__ void tr_item(const float* src, int ldsrc, bf16_t* dst, int ldd, LAS float* scr, int lane) {
    float tv[32];
#pragma unroll
    for (int i = 0; i < 32; ++i) tv[i] = src[(size_t)(2 * i + (lane >> 5)) * ldsrc + (lane & 31)];
#pragma unroll
    for (int i = 0; i < 32; ++i) scr[(2 * i + (lane >> 5)) * 33 + (lane & 31)] = tv[i];
    asm volatile("s_waitcnt lgkmcnt(0)" ::: "memory");
    const int c = lane & 7;
#pragma unroll
    for (int j = 0; j < 4; ++j) { const int n = (lane >> 3) + 8 * j; const LAS float* s = scr + (8 * c) * 33 + n;
        u32x4 o; o.x = pk2(s[0 * 33], s[1 * 33]); o.y = pk2(s[2 * 33], s[3 * 33]); o.z = pk2(s[4 * 33], s[5 * 33]); o.w = pk2(s[6 * 33], s[7 * 33]);
        *(u32x4*)(dst + (size_t)n * ldd + 8 * c) = o; }
    asm volatile("s_waitcnt lgkmcnt(0)" ::: "memory");
}

__device__ __forceinline__ void conv_setA(Frame& F, const Args& a, int l, int pidx, int pcnt, int part) {
    unsigned char* ws = a.ws;
    bf16_t* Win = (bf16_t*)(ws + WS_WIN); bf16_t* Wb = (bf16_t*)(ws + WS_WB); bf16_t* Wout = (bf16_t*)(ws + WS_WOUT);
    const float* w_in = a.in[I_WIN] + (size_t)l * D * DIN;
    LAS float* scr = (LAS float*)(F.lds + F.wave * 16384);
    const int gw = pidx * 8 + F.wave, NGW = pcnt * 8;
    constexpr int I1 = 16 * 168, I2 = 128, I3 = 128, I4 = 256, I5 = 512;
    for (int it = gw; it < I1 + I2 + I3 + I4 + I5; it += NGW) {
        int r = it;
        if (r < I1) { const int kb = r / 168, nb = r % 168, k0 = kb * 64, n0 = 256 + nb * 32;
            if (!((part >> (nb >= 72 ? 1 : 0)) & 1)) continue;
            tr_item(w_in + (size_t)k0 * DIN + n0, DIN, Win + (size_t)(n0 + 256) * 1024 + k0, 1024, scr, F.lane); continue; } r -= I1;
        if (!(part & 2)) break;
        if (r < I2) { const int kb = r / 32, nb = r % 32; tr_item(a.in[I_WFO] + (size_t)l * 256 * D + (size_t)kb * 64 * D + nb * 32, D, Wb + (size_t)(nb * 32) * 1024 + kb * 64, 1024, scr, F.lane); continue; } r -= I2;
        if (r < I3) { const int kb = r / 32, nb = r % 32; tr_item(a.in[I_WCO] + (size_t)l * 256 * D + (size_t)kb * 64 * D + nb * 32, D, Wb + (size_t)(nb * 32) * 1024 + 256 + kb * 64, 1024, scr, F.lane); continue; } r -= I3;
        if (r < I4) { const int kb = r / 32, nb = r % 32; tr_item(a.in[I_WAO] + (size_t)l * 512 * D + (size_t)kb * 64 * D + nb * 32, D, Wb + (size_t)(nb * 32) * 1024 + 512 + kb * 64, 1024, scr, F.lane); continue; } r -= I4;
        { const int kb = r / 32, nb = r % 32; tr_item(a.in[I_WOUT] + (size_t)l * D * D + (size_t)kb * 64 * D + nb * 32, D, Wout + (size_t)(nb * 32) * 1024 + kb * 64, 1024, scr, F.lane); }
    }
    if (!(part & 1)) return;
    const LAS float* ct = (const LAS float*)(F.lds + LDS_COSTAB);
    const int gt = pidx * 512 + F.tid, NGT = pcnt * 512;
    for (int o = gt; o < 1024 * 128; o += NGT) {
        const int k = o & 1023, g = (o >> 10) & 3, mq = o >> 12;
        const float* wp = w_in + (size_t)k * DIN + g * 64;
        f32x4 wv[16];
#pragma unroll
        for (int i = 0; i < 16; ++i) wv[i] = *(const f32x4*)(wp + 4 * i);
#pragma unroll 1
        for (int mm = 0; mm < 2; ++mm) {
            const int m = mq * 2 + mm; float sc = 0.f, ss = 0.f;
#pragma unroll
            for (int j = 0; j < 64; ++j) { const int i = ((j * m) & 63) * 32; const float w = wv[j >> 2][j & 3]; sc += w * ct[i]; ss += w * ct[(i + 1536) & 2047]; }
            Win[(size_t)(g * 64 + m) * 1024 + k] = (bf16_t)f2bf(sc * 0.125f);
            Win[(size_t)(256 + g * 64 + m) * 1024 + k] = (bf16_t)f2bf(ss * 0.125f);
        }
    }
    float* bi = (float*)(ws + WS_BIASIN) + l * NIN; const float* b_in = a.in[I_BIN] + (size_t)l * DIN;
    for (int r = gt; r < NIN; r += NGT) {
        float v;
        if (r < 512) { const int pt = r >> 8, g = (r >> 6) & 3, m = r & 63; float s_ = 0.f;
            for (int j = 0; j < 64; ++j) { const int i = (j * m) & 63; s_ += b_in[g * 64 + j] * ct[(i * 32 + (pt ? 1536 : 0)) & 2047]; }
            v = s_ * 0.125f; }
        else v = b_in[r - 256];
        bi[r] = v;
    }
}
__device__ __forceinline__ void conv_setB(Frame& F, const Args& a, int l, int pidx, int pcnt) {
    unsigned char* ws = a.ws;
    bf16_t* Wgu = (bf16_t*)(ws + (l ? WS_WGU1 : WS_WGU0)); bf16_t* Wd = (bf16_t*)(ws + (l ? WS_WD1 : WS_WD0));
    LAS float* scr = (LAS float*)(F.lds + F.wave * 16384);
    const int gw = pidx * 8 + F.wave, NGW = pcnt * 8;
    constexpr int J1 = 16 * 88, J3 = 44 * 32;
    for (int it = gw; it < 2 * J1 + J3; it += NGW) {
        int r = it;
        if (r < 2 * J1) { const int up = r >= J1; if (up) r -= J1; const int kb = r / 88, nb = r % 88, n0 = nb * 32;
            const float* W = a.in[up ? I_WU : I_WG] + (size_t)l * D * DFF;
            tr_item(W + (size_t)kb * 64 * DFF + n0, DFF, Wgu + (size_t)((n0 >> 7) * 256 + up * 128 + (n0 & 127)) * 1024 + kb * 64, 1024, scr, F.lane); continue; }
        r -= 2 * J1;
        { const int kb = r / 32, nb = r % 32; tr_item(a.in[I_WD] + (size_t)l * DFF * D + (size_t)kb * 64 * D + nb * 32, D, Wd + (size_t)(nb * 32) * DFF + kb * 64, DFF, scr, F.lane); }
    }
}

__device__ __forceinline__ void norm_row(const float* xrow, const float* g, const float* sh, const float* sc, bf16_t* orow, float* fout, int lane) {
    f32x4 v[4]; float s = 0.f;
#pragma unroll
    for (int j = 0; j < 4; ++j) { v[j] = *((const f32x4*)xrow + lane + 64 * j); s += (v[j].x * v[j].x + v[j].y * v[j].y) + (v[j].z * v[j].z + v[j].w * v[j].w); }
    const float rstd = 1.0f / sqrtf(wave_sum(s) * (1.0f / D) + EPS);
#pragma unroll
    for (int j = 0; j < 4; ++j) {
        const int c = (lane + 64 * j) * 4;
        f32x4 y = v[j] * rstd * *(const f32x4*)(g + c);
        if (fout) { *(f32x4*)(fout + c) = y; }
        else { y = y * (*(const f32x4*)(sc + c) + 1.0f) + *(const f32x4*)(sh + c);
            u32x2 w; w.x = cvt_pk_bf16(y.x, y.y); w.y = cvt_pk_bf16(y.z, y.w); *(u32x2*)(orow + c) = w; }
    }
}
__device__ __forceinline__ void norm_phase(Frame& F, const float* xl, const float* xc, const float* g, const float* mod, int sh_off, int sc_off, bf16_t* H, bool with_ctx) {
    const int gw = F.vcu * 8 + F.wave, NGW = F.G * 8, nrows = with_ctx ? MT : ML;
    for (int r = gw; r < nrows; r += NGW) {
        const int b = r < ML ? (r >> 11) : 8;
        const float* xr = r < ML ? xl + (size_t)r * D : xc + (size_t)(r - ML) * D;
        norm_row(xr, g, mod + (size_t)b * 6144 + sh_off, mod + (size_t)b * 6144 + sc_off, H + (size_t)r * D, nullptr, F.lane);
    }
}

__device__ __forceinline__ int crow(int r, int hi) { return (r & 3) + 8 * (r >> 2) + 4 * hi; }
__device__ __forceinline__ s16x4 vtr(const LAS unsigned char* p) { return __builtin_bit_cast(s16x4, __builtin_amdgcn_ds_read_tr16_b64_v4i16((LAS s16x4*)p)); }
constexpr int AT_WSF = 131072;
__device__ __forceinline__ void at_softmax(f32x16& p0, f32x16& p1, f32x16& negm, float& mhat, float& lsum, f32x16 (&o)[4], bf16x8 (&pa)[4], LAS float* wsf, bool first, int r32, int hi) {
    float rm = fmaxf(fmaxf(p0[0], p0[1]), p1[0]);
    { float rb = fmaxf(fmaxf(p0[2], p0[3]), p1[1]); rm = fmaxf(fmaxf(rm, p1[2]), p1[3]);
#pragma unroll
      for (int r = 4; r < 16; r += 4) { rm = fmaxf(fmaxf(rm, p0[r]), p0[r + 1]); rb = fmaxf(fmaxf(rb, p0[r + 2]), p0[r + 3]); rm = fmaxf(fmaxf(rm, p1[r]), p1[r + 1]); rb = fmaxf(fmaxf(rb, p1[r + 2]), p1[r + 3]); }
      rm = fmaxf(rm, rb); }
    rm = fmaxf(rm, __shfl_xor(rm, 32));
    const bool need = first || (rm > 6.0f);
    if (__any(need)) {
        const float dl = need ? rm : 0.f;
        mhat += dl;
#pragma unroll
        for (int r = 0; r < 16; ++r) { p0[r] -= dl; p1[r] -= dl; negm[r] = -mhat; }
        if (!first) {
            const float f = fast_exp2(-dl);
            lsum *= f;
            asm volatile("" ::: "memory");
            if (hi == 0) wsf[r32] = f;
            asm volatile("s_waitcnt lgkmcnt(0)" ::: "memory");
#pragma unroll
            for (int r = 0; r < 16; ++r) { const float fr_ = wsf[crow(r, hi)];
#pragma unroll
                for (int d0 = 0; d0 < 4; ++d0) o[d0][r] *= fr_; }
            asm volatile("s_waitcnt lgkmcnt(0)" ::: "memory");
        }
    }
    f32x2_t ls2 = (f32x2_t){0.f, 0.f};
#pragma unroll
    for (int r = 0; r < 16; r += 2) { p0[r] = fast_exp2(p0[r]); p0[r + 1] = fast_exp2(p0[r + 1]); p1[r] = fast_exp2(p1[r]); p1[r + 1] = fast_exp2(p1[r + 1]);
        ls2 += (f32x2_t){p0[r], p0[r + 1]}; ls2 += (f32x2_t){p1[r], p1[r + 1]}; }
    lsum += ls2.x + ls2.y;
    u32x4 w;
    w.x = cvt_pk_bf16(p0[0], p0[1]); w.y = cvt_pk_bf16(p0[2], p0[3]); w.z = cvt_pk_bf16(p0[4], p0[5]); w.w = cvt_pk_bf16(p0[6], p0[7]); pa[0] = __builtin_bit_cast(bf16x8, w);
    w.x = cvt_pk_bf16(p0[8], p0[9]); w.y = cvt_pk_bf16(p0[10], p0[11]); w.z = cvt_pk_bf16(p0[12], p0[13]); w.w = cvt_pk_bf16(p0[14], p0[15]); pa[1] = __builtin_bit_cast(bf16x8, w);
    w.x = cvt_pk_bf16(p1[0], p1[1]); w.y = cvt_pk_bf16(p1[2], p1[3]); w.z = cvt_pk_bf16(p1[4], p1[5]); w.w = cvt_pk_bf16(p1[6], p1[7]); pa[2] = __builtin_bit_cast(bf16x8, w);
    w.x = cvt_pk_bf16(p1[8], p1[9]); w.y = cvt_pk_bf16(p1[10], p1[11]); w.z = cvt_pk_bf16(p1[12], p1[13]); w.w = cvt_pk_bf16(p1[14], p1[15]); pa[3] = __builtin_bit_cast(bf16x8, w);
}
__device__ __forceinline__ void attn_unit(Frame& F, const bf16_t* P, bf16_t* BR, int qrow0, int base1, int n1, int base2, int nt, int h, float lam, float oscale, const float* subg) {
    LAS unsigned char* lds = F.lds;
    const int tid = F.tid, lane = F.lane, wid = F.wave, r32 = lane & 31, hi = lane >> 5, qg = wid & 3, comp = wid >> 2;
    bf16x8 qf[4];
    { const bf16_t* qp = P + (size_t)(qrow0 + qg * 32 + r32) * LDP + PQ + h * 128 + comp * 64 + hi * 8;
#pragma unroll
      for (int d0 = 0; d0 < 4; ++d0) qf[d0] = *(const bf16x8*)(qp + d0 * 16); }
    int ksrc[2], kdst[2], vsrc[2], vdst[2];
#pragma unroll
    for (int i = 0; i < 2; ++i) { const int pc = wid * 2 + i;
        { const int cmp = pc >> 3, rg = pc & 7, row = rg * 8 + (lane >> 3), c8 = (lane & 7) ^ (lane >> 3); ksrc[i] = row * LDP + PK + h * 128 + cmp * 64 + c8 * 8; kdst[i] = cmp * 8192 + rg * 1024; }
        { const int d0 = pc >> 2, rg = pc & 3; vsrc[i] = (rg * 16 + (lane >> 2)) * LDP + PV + h * 128 + d0 * 32 + (lane & 3) * 8; vdst[i] = 16384 + d0 * 4096 + rg * 1024; } }
#define AT_TROW(t) ((t) < n1 ? base1 + 64 * (t) : base2 + 64 * ((t) - n1))
    LAS float* wsf = (LAS float*)(lds + AT_WSF) + wid * 64;
    float mhat = 0.f, lsum = 0.f;
    f32x16 negm;
#pragma unroll
    for (int r = 0; r < 16; ++r) negm[r] = 0.f;
    f32x16 o[4];
#pragma unroll
    for (int d0 = 0; d0 < 4; ++d0)
#pragma unroll
        for (int r = 0; r < 16; ++r) o[d0][r] = 0.f;
    bf16x8 pa[4];
#pragma unroll
    for (int i = 0; i < 4; ++i) pa[i] = (bf16x8){0, 0, 0, 0, 0, 0, 0, 0};
    s16x4 va[8], vb[8];
#pragma unroll
    for (int i = 0; i < 8; ++i) { va[i] = (s16x4){0, 0, 0, 0}; vb[i] = (s16x4){0, 0, 0, 0}; }
    const int vlane = ((lane >> 4) & 1) * 32 + (lane & 3) * 8 + (4 * hi + ((lane & 15) >> 2)) * 64;
    const int klane = comp * 8192 + r32 * 128;
    int koff[4];
#pragma unroll
    for (int d0 = 0; d0 < 4; ++d0) koff[d0] = ((2 * d0 + hi) ^ (r32 & 7)) * 16;
#define AT_SB() __builtin_amdgcn_sched_barrier(0)
#define AT_DMA4(t, OFF) do { const bf16_t* tp = P + (size_t)AT_TROW(t) * LDP; \
        __builtin_amdgcn_global_load_lds((const unsigned*)(tp + ksrc[0]), (LAS unsigned*)(lds + (OFF) + kdst[0]), 16, 0, 0); \
        __builtin_amdgcn_global_load_lds((const unsigned*)(tp + ksrc[1]), (LAS unsigned*)(lds + (OFF) + kdst[1]), 16, 0, 0); \
        __builtin_amdgcn_global_load_lds((const unsigned*)(tp + vsrc[0]), (LAS unsigned*)(lds + (OFF) + vdst[0]), 16, 0, 0); \
        __builtin_amdgcn_global_load_lds((const unsigned*)(tp + vsrc[1]), (LAS unsigned*)(lds + (OFF) + vdst[1]), 16, 0, 0); } while (0)
#define AT_VF(x, s) ((bf16x8){x[2 * (s)][0], x[2 * (s)][1], x[2 * (s)][2], x[2 * (s)][3], x[2 * (s) + 1][0], x[2 * (s) + 1][1], x[2 * (s) + 1][2], x[2 * (s) + 1][3]})
#define AT_TR(dst, addr, off) asm volatile("ds_read_b64_tr_b16 %0, %1 offset:%c2" : "=&v"(dst) : "v"(addr), "i"(off) : "memory")
    const unsigned ldsb = (unsigned)(unsigned long long)lds;
#define AT_VPRE(OFF) do { const unsigned vp_ = ldsb + (OFF) + 16384 + vlane; \
        _Pragma("unroll") for (int s_ = 0; s_ < 4; ++s_) { AT_TR(va[2 * s_], vp_, s_ * 1024); AT_TR(va[2 * s_ + 1], vp_, s_ * 1024 + 512); AT_TR(vb[2 * s_], vp_, 4096 + s_ * 1024); AT_TR(vb[2 * s_ + 1], vp_, 4096 + s_ * 1024 + 512); } } while (0)
#define AT_PVMMA(OFF) do { const unsigned vp_ = ldsb + (OFF) + 16384 + vlane; \
        asm volatile("s_waitcnt lgkmcnt(0)" ::: "memory"); AT_SB(); __builtin_amdgcn_s_setprio(1); \
        _Pragma("unroll") for (int s_ = 0; s_ < 4; ++s_) { \
            o[0] = __builtin_amdgcn_mfma_f32_32x32x16_bf16(pa[s_], AT_VF(va, s_), o[0], 0, 0, 0); \
            o[1] = __builtin_amdgcn_mfma_f32_32x32x16_bf16(pa[s_], AT_VF(vb, s_), o[1], 0, 0, 0); \
            AT_SB(); \
            AT_TR(va[2 * s_], vp_, 8192 + s_ * 1024); AT_TR(va[2 * s_ + 1], vp_, 8192 + s_ * 1024 + 512); AT_TR(vb[2 * s_], vp_, 12288 + s_ * 1024); AT_TR(vb[2 * s_ + 1], vp_, 12288 + s_ * 1024 + 512); \
            AT_SB(); } \
        asm volatile("s_waitcnt lgkmcnt(0)" ::: "memory"); AT_SB(); \
        _Pragma("unroll") for (int s_ = 0; s_ < 4; ++s_) { \
            o[2] = __builtin_amdgcn_mfma_f32_32x32x16_bf16(pa[s_], AT_VF(va, s_), o[2], 0, 0, 0); \
            o[3] = __builtin_amdgcn_mfma_f32_32x32x16_bf16(pa[s_], AT_VF(vb, s_), o[3], 0, 0, 0); } \
        __builtin_amdgcn_s_setprio(0); AT_SB(); } while (0)
#define AT_STEP(t, CUR, NX2, PRV) do { \
        if ((t) + 2 < nt) AT_DMA4((t) + 2, NX2); \
        if (comp == 1 && (t) > 0) AT_PVMMA(PRV); \
        f32x16 p0, p1; \
        {   bf16x8 kf[8]; const LAS unsigned char* kb = lds + (CUR) + klane; \
            _Pragma("unroll") for (int d0 = 0; d0 < 4; ++d0) { kf[2 * d0] = *(const LAS bf16x8*)(kb + koff[d0]); kf[2 * d0 + 1] = *(const LAS bf16x8*)(kb + koff[d0] + 4096); } \
            AT_SB(); __builtin_amdgcn_s_setprio(1); \
            p0 = __builtin_amdgcn_mfma_f32_32x32x16_bf16(kf[0], qf[0], negm, 0, 0, 0); \
            p1 = __builtin_amdgcn_mfma_f32_32x32x16_bf16(kf[1], qf[0], negm, 0, 0, 0); \
            _Pragma("unroll") for (int d0 = 1; d0 < 4; ++d0) { \
                p0 = __builtin_amdgcn_mfma_f32_32x32x16_bf16(kf[2 * d0], qf[d0], p0, 0, 0, 0); \
                p1 = __builtin_amdgcn_mfma_f32_32x32x16_bf16(kf[2 * d0 + 1], qf[d0], p1, 0, 0, 0); } __builtin_amdgcn_s_setprio(0); } \
        AT_SB(); \
        AT_VPRE(CUR); \
        AT_SB(); \
        at_softmax(p0, p1, negm, mhat, lsum, o, pa, wsf, (t) == 0, r32, hi); \
        AT_SB(); \
        if (comp == 0) AT_PVMMA(CUR); \
          \
        if ((t) + 2 < nt) asm volatile("s_waitcnt vmcnt(4)" ::: "memory"); else asm volatile("s_waitcnt vmcnt(0)" ::: "memory"); \
        AT_SB(); __builtin_amdgcn_s_barrier(); AT_SB(); } while (0)
    AT_DMA4(0, 0);
    if (nt > 1) AT_DMA4(1, 32768);
    if (nt > 1) asm volatile("s_waitcnt vmcnt(4)" ::: "memory"); else asm volatile("s_waitcnt vmcnt(0)" ::: "memory");
    __syncthreads();
#pragma unroll 1
    for (int t = 0; t < nt; t += 4) {
        AT_STEP(t, 0, 65536, 98304);
        if (t + 1 < nt) AT_STEP(t + 1, 32768, 98304, 0);
        if (t + 2 < nt) AT_STEP(t + 2, 65536, 0, 32768);
        if (t + 3 < nt) AT_STEP(t + 3, 98304, 32768, 65536);
    }
    if (comp == 1) { const int lo_ = ((nt - 1) & 3) * 32768; AT_PVMMA(lo_); }
    __syncthreads();
#undef AT_STEP
#undef AT_PVMMA
#undef AT_VPRE
#undef AT_TR
#undef AT_VF
#undef AT_DMA4
#undef AT_SB
    lsum += __shfl_xor(lsum, 32);
    { float inv = 1.0f / lsum; if (comp) inv *= lam;
      asm volatile("" ::: "memory");
      if (hi == 0) wsf[r32] = inv;
      asm volatile("s_waitcnt lgkmcnt(0)" ::: "memory");
#pragma unroll
      for (int r = 0; r < 16; ++r) { const float fr_ = wsf[crow(r, hi)];
#pragma unroll
          for (int d0 = 0; d0 < 4; ++d0) o[d0][r] *= fr_; } }
    LAS float* X = (LAS float*)lds + qg * (32 * 132);
    if (comp == 1) {
#pragma unroll
        for (int d0 = 0; d0 < 4; ++d0)
#pragma unroll
            for (int r = 0; r < 16; ++r) X[crow(r, hi) * 132 + d0 * 32 + r32] = o[d0][r];
    }
    __syncthreads();
    if (comp == 0) {
#pragma unroll
        for (int d0 = 0; d0 < 4; ++d0)
#pragma unroll
            for (int r = 0; r < 16; ++r) { const int ix = crow(r, hi) * 132 + d0 * 32 + r32; X[ix] = o[d0][r] - X[ix]; }
        asm volatile("s_waitcnt lgkmcnt(0)" ::: "memory");
        const int row = lane >> 1, hf = lane & 1;
        const LAS float* xr = X + row * 132 + hf * 64;
        float ss = 0.f;
#pragma unroll
        for (int c = 0; c < 16; ++c) { const f32x4 v = *(const LAS f32x4*)(xr + c * 4); ss += (v.x * v.x + v.y * v.y) + (v.z * v.z + v.w * v.w); }
        ss += __shfl_xor(ss, 1);
        const float rstd = oscale / sqrtf(ss * (1.0f / 128.0f) + EPS);
        bf16_t* op = BR + (size_t)(qrow0 + qg * 32 + row) * 1024 + 512 + h * 128 + hf * 64;
        const float* gp = subg + hf * 64;
#pragma unroll
        for (int c = 0; c < 8; ++c) {
            const f32x4 v0 = *(const LAS f32x4*)(xr + c * 8) * rstd * *(const f32x4*)(gp + c * 8), v1 = *(const LAS f32x4*)(xr + c * 8 + 4) * rstd * *(const f32x4*)(gp + c * 8 + 4);
            u32x4 w; w.x = cvt_pk_bf16(v0.x, v0.y); w.y = cvt_pk_bf16(v0.z, v0.w); w.z = cvt_pk_bf16(v1.x, v1.y); w.w = cvt_pk_bf16(v1.z, v1.w);
            *(u32x4*)(op + c * 8) = w;
        }
    }
    __syncthreads();
#undef AT_TROW
}

__device__ __forceinline__ void norm_rows4(const float* x0, size_t xstride, const float* g, const float* sh, const float* sc, bf16_t* o0, size_t ostride, float* fout, int lane) {
    f32x4 v[4][4]; float ss[4];
#pragma unroll
    for (int r = 0; r < 4; ++r)
#pragma unroll
        for (int j = 0; j < 4; ++j) v[r][j] = *((const f32x4*)(x0 + (size_t)r * xstride) + lane + 64 * j);
#pragma unroll
    for (int r = 0; r < 4; ++r) { float s = 0.f;
#pragma unroll
        for (int j = 0; j < 4; ++j) s += (v[r][j].x * v[r][j].x + v[r][j].y * v[r][j].y) + (v[r][j].z * v[r][j].z + v[r][j].w * v[r][j].w);
        ss[r] = 1.0f / sqrtf(wave_sum(s) * (1.0f / D) + EPS); }
#pragma unroll
    for (int j = 0; j < 4; ++j) {
        const int c = (lane + 64 * j) * 4;
        const f32x4 gv = *(const f32x4*)(g + c);
        if (fout) {
#pragma unroll
            for (int r = 0; r < 4; ++r) *(f32x4*)(fout + (size_t)r * xstride + c) = v[r][j] * ss[r] * gv;
        } else {
            const f32x4 m1 = *(const f32x4*)(sc + c) + 1.0f, sv = *(const f32x4*)(sh + c);
#pragma unroll
            for (int r = 0; r < 4; ++r) { const f32x4 y = v[r][j] * ss[r] * gv * m1 + sv;
                u32x2 w; w.x = cvt_pk_bf16(y.x, y.y); w.y = cvt_pk_bf16(y.z, y.w); *(u32x2*)(o0 + (size_t)r * ostride + c) = w; }
        }
    }
}
__device__ __forceinline__ void norm_phase4(Frame& F, const float* xl, const float* xc, const float* g, const float* mod, int sh_off, int sc_off, bf16_t* H, bool with_ctx) {
    const int gw = F.vcu * 8 + F.wave, NGW = F.G * 8, nrows = with_ctx ? MT : ML;
    for (int r = gw * 4; r < nrows; r += NGW * 4) {
        const int b = r < ML ? (r >> 11) : 8;
        const float* xr = r < ML ? xl + (size_t)r * D : xc + (size_t)(r - ML) * D;
        norm_rows4(xr, D, g, mod + (size_t)b * 6144 + sh_off, mod + (size_t)b * 6144 + sc_off, H + (size_t)r * D, D, nullptr, F.lane);
    }
}
#define XB_TMO      128
#define XB_XCNT(j)  (256  + 64 * (j))
#define XB_XSUB(j)  (1280 + 64 * (j))
#define XB_XGEN(j)  (2304 + 64 * (j))
#define XB_TOP      3328
#define XB_TOPGEN   3392
#define XCD_BAR_WORDS 3456
#define XB_SPIN_CAP (1u << 18)
__device__ __forceinline__ unsigned xb_ld(unsigned* p)              { return __hip_atomic_load(p, __ATOMIC_RELAXED, __HIP_MEMORY_SCOPE_AGENT); }
__device__ __forceinline__ unsigned xb_add(unsigned* p, unsigned v) { return __hip_atomic_fetch_add(p, v, __ATOMIC_RELAXED, __HIP_MEMORY_SCOPE_AGENT); }
__device__ __forceinline__ unsigned xb_xcc_id() { return (unsigned)__builtin_amdgcn_s_getreg((3 << 11) | 20) & 0xFu; }
#define XB_SPIN(cond, bar) do { unsigned _sp = 0; while (cond) { __builtin_amdgcn_s_sleep(1); \
    if ((++_sp & 255u) == 0u) { if (xb_ld(&(bar)[XB_TMO])) break; if (_sp > XB_SPIN_CAP) { atomicAdd(&(bar)[XB_TMO], 1u); break; } } } } while (0)
struct XcdBarrier { unsigned* bar; unsigned x; volatile LAS unsigned* st; };
__device__ __forceinline__ XcdBarrier xcd_barrier_post(unsigned* bar, volatile LAS unsigned* st) {
    XcdBarrier b; b.bar = bar; b.x = xb_xcc_id(); b.st = st;
    if (threadIdx.x == 0) (void)xb_add(&bar[XB_XCNT(b.x)], 1u);
    return b;
}
__device__ __forceinline__ void xcd_barrier_complete(unsigned* bar, unsigned x, unsigned& nloc, unsigned& nx) {
    const unsigned G = gridDim.x * gridDim.y * gridDim.z;
    unsigned sum, cnt, mine, sp = 0u;
    for (;;) {
        sum = 0u; cnt = 0u; mine = 0u;
#pragma unroll
        for (unsigned j = 0; j < 16; ++j) { const unsigned c = xb_ld(&bar[XB_XCNT(j)]); sum += c; cnt += (c > 0u) ? 1u : 0u; mine = (j == x) ? c : mine; }
        if (sum == G) break;
        __builtin_amdgcn_s_sleep(1);
        if ((++sp & 255u) == 0u) { if (xb_ld(&bar[XB_TMO])) break; if (sp > XB_SPIN_CAP) { atomicAdd(&bar[XB_TMO], 1u); break; } }
    }
    nloc = mine > 0u ? mine : 1u; nx = cnt > 0u ? cnt : 1u;
}
__device__ __forceinline__ void xcd_barrier(const XcdBarrier& b) {
    asm volatile("s_waitcnt vmcnt(0)" ::: "memory");
    __syncthreads();
    if (threadIdx.x == 0) {
        unsigned* bar = b.bar;
        __builtin_amdgcn_s_waitcnt(0);
        unsigned nloc = b.st[0], nx = b.st[1];
        if (nloc == 0u) { xcd_barrier_complete(bar, b.x, nloc, nx); b.st[0] = nloc; b.st[1] = nx; }
        const unsigned old = xb_add(&bar[XB_XSUB(b.x)], 1u);
        const unsigned gen = old / nloc;
        if (old + 1u == (gen + 1u) * nloc) {
            __builtin_amdgcn_fence(__ATOMIC_RELEASE, "agent");
            asm volatile("s_waitcnt vmcnt(0)" ::: "memory");
            const unsigned og = xb_add(&bar[XB_TOP], 1u);
            const unsigned tg = og / nx;
            if (og + 1u == (tg + 1u) * nx) xb_add(&bar[XB_TOPGEN], 1u);
            else XB_SPIN(xb_ld(&bar[XB_TOPGEN]) == tg, bar);
            __builtin_amdgcn_fence(__ATOMIC_ACQUIRE, "agent");
            xb_add(&bar[XB_XGEN(b.x)], 1u);
            asm volatile("s_waitcnt vmcnt(0)" ::: "memory");
        } else {
            XB_SPIN(xb_ld(&bar[XB_XGEN(b.x)]) == gen, bar);
            __builtin_amdgcn_fence(__ATOMIC_ACQUIRE, "agent");
            asm volatile("s_waitcnt vmcnt(0)" ::: "memory");
        }
    }
    __syncthreads();
}

constexpr int N_PHASES = 20;
__global__ void __launch_bounds__(512, 2) fwd_kernel(Args args) {
    extern __shared__ __attribute__((aligned(16))) unsigned char lds_raw[];
    Frame F;
    F.lds = (LAS unsigned char*)lds_raw;
    F.tid = threadIdx.x; F.lane = F.tid & 63; F.wave = __builtin_amdgcn_readfirstlane(F.tid >> 6);
    F.G = gridDim.x; F.bx = blockIdx.x; F.vcu = (F.G % 8 == 0) ? (F.bx % 8) * (F.G / 8) + F.bx / 8 : F.bx; F.rot = 0;
    unsigned char* const ws = args.ws;
    float* const XL = args.out;
    if (F.tid < 2) ((LAS unsigned*)(F.lds + LDS_XB))[F.tid] = 0u;
    __syncthreads();
    if (args.ph_hi - args.ph_lo > 1) (void)xcd_barrier_post((unsigned*)(ws + WS_BAR), (volatile LAS unsigned*)(F.lds + LDS_XB));
#define WSP(T, off) ((T*)(ws + (off)))
#pragma unroll 1
    for (int ph = args.ph_lo, rep = 0; ph < args.ph_hi;) {
#define REFRESH_LANE() do { int l_ = (int)__builtin_amdgcn_mbcnt_hi(~0u, __builtin_amdgcn_mbcnt_lo(~0u, 0u)); asm volatile("" : "+v"(l_)); F.lane = l_; F.tid = F.wave * 64 + l_; } while (0)
        REFRESH_LANE();
        const int kind = ph < 2 ? ph : 2 + (ph - 2) % 9;
        const int l = ph < 2 ? 0 : (ph - 2) / 9;
        const bool last = (l == 1);
        const float* mod = WSP(float, WS_MOD) + (size_t)l * 9 * 6144;
        const float* biasin = WSP(float, WS_BIASIN) + l * NIN;
        if (kind == 0) {
            LAS float* ct = (LAS float*)(F.lds + LDS_COSTAB);
            for (int i = F.tid; i < 2048; i += 512) ct[i] = cospif((float)i * (1.0f / 1024.0f));
            __syncthreads();
        }
        if (kind == 0) {
            if (F.bx < 192) {
                LAS float* sv = (LAS float*)F.lds;
                LAS float* red = (LAS float*)(F.lds + 40960);
                for (int i = F.tid; i < 9 * 1024; i += 512) { const int r = i >> 10, k = i & 1023; const float c = r < 8 ? args.in[I_C][r * 1024 + k] : args.in[I_CCTX][k]; sv[i] = c / (1.0f + __expf(-c)); }
                __syncthreads();
                for (int job = F.bx; job < 192; job += F.G) {
                    const int jl = job / 96, n0 = (job % 96) * 64, kg = F.tid >> 6, nn = F.tid & 63;
                    const float* wp = args.in[I_WADA] + (size_t)jl * D * 6144 + (size_t)(kg * 128) * 6144 + n0 + nn;
                    float ac[9];
#pragma unroll
                    for (int r = 0; r < 9; ++r) ac[r] = 0.f;
#pragma unroll 1
                    for (int k0 = 0; k0 < 128; k0 += 32) {
                        float wv[32];
#pragma unroll
                        for (int i = 0; i < 32; ++i) wv[i] = wp[(size_t)(k0 + i) * 6144];
#pragma unroll
                        for (int i = 0; i < 32; ++i)
#pragma unroll
                            for (int r = 0; r < 9; ++r) ac[r] += sv[r * 1024 + kg * 128 + k0 + i] * wv[i]; }
#pragma unroll
                    for (int r = 0; r < 9; ++r) red[(kg * 9 + r) * 64 + nn] = ac[r];
                    __syncthreads();
                    for (int o = F.tid; o < 576; o += 512) { const int r = o >> 6, n = o & 63; float s = args.in[I_BADA][jl * 6144 + n0 + n];
#pragma unroll
                        for (int q = 0; q < 8; ++q) s += red[(q * 9 + r) * 64 + n];
                        WSP(float, WS_MOD)[((size_t)jl * 9 + r) * 6144 + n0 + n] = s; }
                    __syncthreads();
                }
            }
            __syncthreads();
            if (F.bx == F.G - 1) {
                float* ROPE = WSP(float, WS_ROPE);
                for (int i = F.tid; i < 1024; i += 512) { const int pos = i >> 4, f = i & 15; const float fr = powf(10000.0f, -(float)f * (1.0f / 16.0f)); const float ang = (float)pos * fr; ROPE[i] = cosf(ang); ROPE[1024 + i] = sinf(ang); }
                if (F.tid < 2) { const int jl = F.tid; float s1 = 0.f, s2 = 0.f;
                    for (int j = 0; j < 64; ++j) { s1 += args.in[I_LQ1][jl * 64 + j] * args.in[I_LK1][jl * 64 + j]; s2 += args.in[I_LQ2][jl * 64 + j] * args.in[I_LK2][jl * 64 + j]; }
                    WSP(float, WS_LAM)[jl] = expf(s1) - expf(s2) + (0.8f - 0.6f * expf(-0.3f * (float)jl)); }
            }
            __syncthreads();
        }
        if (kind == 0) { REFRESH_LANE(); conv_setA(F, args, 0, F.vcu, F.G, 1); }
        if (kind == 1 || kind == 7 || (kind == 10 && !last)) {
            REFRESH_LANE();
            const bool n2 = (kind == 7);
            const float* xl = (kind == 1) ? args.in[I_X] : XL;
            const float* xc = (kind == 1) ? args.in[I_CTX] : WSP(float, WS_XC);
            const float* g = n2 ? args.in[I_N2G] + l * 1024 : args.in[I_N1G] + (kind == 10 ? 1024 : 0);
            const float* m = (kind == 10) ? WSP(float, WS_MOD) + (size_t)9 * 6144 : mod;
            norm_phase4(F, xl, xc, g, m, n2 ? 3072 : 0, n2 ? 4096 : 1024, n2 ? WSP(bf16_t, WS_BR) : WSP(bf16_t, WS_H), n2 ? !last : true);
        }
        if (kind == 10 && last) {
            REFRESH_LANE();
            const int gw = F.vcu * 8 + F.wave, NGW = F.G * 8;
            for (int r = gw * 4; r < ML; r += NGW * 4) norm_rows4(XL + (size_t)r * D, D, args.in[I_FING], nullptr, nullptr, nullptr, 0, XL + (size_t)r * D, F.lane);
        }
        if (kind == 3) {
            const float lam = WSP(float, WS_LAM)[l]; const float osc = 1.0f - (0.8f - 0.6f * expf(-0.3f * (float)l)); const float* subg = args.in[I_SUBG] + l * 128;
            const bf16_t* P = WSP(bf16_t, WS_P); bf16_t* BR = WSP(bf16_t, WS_BR);
            const int npairs = (2 * F.vcu < 512) ? (512 - 2 * F.vcu + 2 * F.G - 1) / (2 * F.G) : 0, nlat = 2 * npairs;
#pragma unroll 1
            for (int rp = 0; rp <= PROBE_ATT; ++rp)
#pragma unroll 1
            for (int i = 0;; ++i) {
                int qrow0, base1, n1, base2, nt, h;
                if (i < nlat) { const int un = (i >> 1) * 2 * F.G + 2 * F.vcu + (i & 1); const int bh = un >> 4, qb = un & 15, b = bh >> 2; h = bh & 3;
                    qrow0 = b * SEQ + qb * 128; base1 = b * SEQ; n1 = 32; base2 = ML + b * CTXL; nt = 36; }
                else { const int cu = F.vcu + (i - nlat) * F.G; if (last || cu >= 64) break; const int bh = cu >> 1, qb = cu & 1, b = bh >> 2; h = bh & 3;
                    qrow0 = ML + b * CTXL + qb * 128; base1 = ML + b * CTXL; n1 = 4; base2 = 0; nt = 4; }
                REFRESH_LANE();
                attn_unit(F, P, BR, qrow0, base1, n1, base2, nt, h, lam, osc, subg);
            }
        }
        if (kind == 2) {
            REFRESH_LANE();
            const float* rp = WSP(float, WS_ROPE); LAS float* rl = (LAS float*)(F.lds + LDS_ROPE);
            for (int i = F.tid; i < 2048; i += 512) rl[i] = rp[i];
            __syncthreads();
        }
#pragma unroll 1
        for (int j = 0; j < 4; ++j) {
            GJob J{}; bool have = false;
            J.lda = 1024; J.ldb = 1024; J.K = 1024; J.rot = -1;
            if (kind == 2) {
                if (j < 2) { have = true; J.A = WSP(bf16_t, WS_H) + (j ? (size_t)ML * 1024 : 0); J.Bt = WSP(bf16_t, WS_WIN); J.M = j ? MC : ML; J.N = NP1;
                    J.E.mode = E_INPROJ; J.E.out = WSP(bf16_t, WS_P); J.E.p1 = biasin; J.E.p2 = WSP(float, WS_ROPE); J.E.row_base = j ? ML : 0; J.E.ctx = j; J.E.aux = 0; J.E.p3 = WSP(bf16_t, (l ? WS_FT1 : WS_FT0)); J.E.p4 = WSP(bf16_t, WS_FTC);
                    if (j == 0) J.rot = 0;
                    if (j && last) { J.Bt = WSP(bf16_t, WS_WIN) + (size_t)7 * 256 * 1024; J.N = 1024; J.E.aux = 7; J.E.p1 = biasin + 7 * 256; } }
            } else if (kind == 4) {
                const int nf = (F.G >= 128) ? 64 : 0;
                if (j == 0) { have = true; J.A = WSP(bf16_t, WS_DFT); J.lda = 4096; J.Bt = WSP(bf16_t, (l ? WS_FT1 : WS_FT0)); J.ldb = 4096; J.M = 2048; J.N = 2048; J.K = 4096; J.rot = 0;
                    if (nf) { J.gfirst = 0; J.gsub = nf; }
                    J.E.mode = E_FOUR; J.E.out = WSP(bf16_t, WS_BR); J.E.row_base = 0; J.E.ctx = 0; J.E.scale = 0.02209708691207961f; }
                else if (j == 1 && !last) { have = true; J.A = WSP(bf16_t, WS_DFT256); J.lda = 512; J.Bt = WSP(bf16_t, WS_FTC); J.ldb = 512; J.M = 256; J.N = 2048; J.K = 512; J.rot = 0;
                    if (nf) { J.gfirst = nf; J.gsub = F.G - nf; }
                    J.E.mode = E_FOUR; J.E.out = WSP(bf16_t, WS_BR); J.E.row_base = ML; J.E.ctx = 1; J.E.scale = 0.0625f; }
                else if (j == 2) { have = true; J.A = WSP(bf16_t, WS_H); J.Bt = WSP(bf16_t, WS_WIN) + (size_t)NP1 * 1024; J.M = (last || nf) ? ML : MT; J.N = 3072; J.rot = 0;
                    if (nf) { J.gfirst = nf; J.gsub = F.G - nf; }
                    J.E.mode = E_GATE; J.E.out = WSP(bf16_t, WS_P); J.E.p1 = biasin + NP1; J.E.row_base = 0; }
                else if (j == 3 && !last && nf) { have = true; J.A = WSP(bf16_t, WS_H) + (size_t)ML * 1024; J.Bt = WSP(bf16_t, WS_WIN) + (size_t)NP1 * 1024; J.M = MC; J.N = 3072; J.rot = 0;
                    J.gfirst = 0; J.gsub = nf;
                    J.E.mode = E_GATE; J.E.out = WSP(bf16_t, WS_P); J.E.p1 = biasin + NP1; J.E.row_base = ML; }
            } else if (kind == 5) {
                if (j == 0) { have = true; J.A = WSP(bf16_t, WS_BR); J.Bt = WSP(bf16_t, WS_WB); J.M = last ? ML : MT; J.N = 1024; J.K = 1024; J.rot = 0;
                    J.E.mode = E_BRANCH; J.E.out = WSP(bf16_t, WS_H); J.E.p1 = WSP(bf16_t, WS_P); J.E.aux = 0; J.E.row_base = 0; }
            } else if (kind == 6 || kind == 9) {
                if (j == 0 || (j == 1 && !last)) { have = true;
                    const bool dn = (kind == 9);
                    const bf16_t* Abase = dn ? WSP(bf16_t, WS_P) : WSP(bf16_t, WS_H);
                    J.lda = dn ? DFF : 1024; J.ldb = J.lda; J.K = J.lda;
                    J.A = Abase + (j ? (size_t)ML * J.lda : 0);
                    J.Bt = dn ? WSP(bf16_t, (l ? WS_WD1 : WS_WD0)) : WSP(bf16_t, WS_WOUT);
                    J.M = j ? MC : ML; J.N = 1024; if (j == 0) J.rot = 0;
                    J.E.mode = E_RESID; J.E.ctx = j; J.E.p2 = mod + (dn ? 5120 : 2048);
                    const float* xin_l = (!dn && l == 0) ? args.in[I_X] : XL; const float* xin_c = (!dn && l == 0) ? args.in[I_CTX] : WSP(float, WS_XC);
                    J.E.p1 = j ? xin_c : xin_l; J.E.out = j ? (void*)WSP(float, WS_XC) : (void*)XL; }
            } else if (kind == 8) {
                if (j == 0) { have = true; J.A = WSP(bf16_t, WS_BR); J.Bt = WSP(bf16_t, (l ? WS_WGU1 : WS_WGU0)); J.M = last ? ML : MT; J.N = 2 * DFF; J.rot = 0;
                    J.E.mode = E_GU; J.E.out = WSP(bf16_t, WS_P); J.E.row_base = 0; }
            }
            if (!have) { if (kind == 4) continue; break; }
            REFRESH_LANE();
            gemm_call(F, J);
        }
        if (!last && kind == 2) {
            const int nskip = (F.G > 64) ? 24 : 0;
            if (F.bx >= nskip) {
                const int pidx = F.bx - nskip, pcnt = F.G - nskip;
                REFRESH_LANE();
                { LAS float* ctw = (LAS float*)(F.lds + LDS_COSTAB);
                  for (int i = F.tid; i < 2048; i += 512) ctw[i] = cospif((float)i * (1.0f / 1024.0f));
                  __syncthreads(); }
            {
              const LAS float* ct = (const LAS float*)(F.lds + LDS_COSTAB);
              bf16_t* DFT = WSP(bf16_t, WS_DFT); bf16_t* DFT256 = WSP(bf16_t, WS_DFT256);
              const int gt = pidx * 512 + F.tid, NGT = pcnt * 512;
              for (int q = gt; q < 2048 * 512; q += NGT) { const int k = q >> 9, c8 = (q & 511) * 8; unsigned w[4];
#pragma unroll
                  for (int e = 0; e < 8; e += 2) { float v[2];
#pragma unroll
                      for (int z = 0; z < 2; ++z) { const int np = c8 + e + z; v[z] = np < 2048 ? ct[(k * np) & 2047] : -ct[((k * (np - 2048)) + 1536) & 2047]; }
                      w[e >> 1] = pk2(v[0], v[1]); }
                  *(u32x4*)(DFT + (size_t)k * 4096 + c8) = (u32x4){w[0], w[1], w[2], w[3]}; }
              for (int q = gt; q < 256 * 64; q += NGT) { const int k = q >> 6, c8 = (q & 63) * 8; unsigned w[4];
#pragma unroll
                  for (int e = 0; e < 8; e += 2) { float v[2];
#pragma unroll
                      for (int z = 0; z < 2; ++z) { const int np = c8 + e + z; v[z] = np < 256 ? ct[(((k * np) & 255) * 8) & 2047] : -ct[((((k * (np - 256)) & 255) * 8) + 1536) & 2047]; }
                      w[e >> 1] = pk2(v[0], v[1]); }
                  *(u32x4*)(DFT256 + (size_t)k * 512 + c8) = (u32x4){w[0], w[1], w[2], w[3]}; } }
                __syncthreads();
                REFRESH_LANE();
                conv_setA(F, args, 0, pidx, pcnt, 2);
            }
        }
        if (!last && (kind == 6 || kind == 9)) {
            const int nskip = (F.G > 64) ? 32 : 0;
            if (F.bx >= nskip) {
                const int pidx = F.bx - nskip, pcnt = F.G - nskip;
                if (kind == 6) { REFRESH_LANE(); conv_setB(F, args, 0, pidx, pcnt); }
                else {
                    LAS float* ct = (LAS float*)(F.lds + LDS_COSTAB);
                    REFRESH_LANE();
                    for (int i = F.tid; i < 2048; i += 512) ct[i] = cospif((float)i * (1.0f / 1024.0f));
                    __syncthreads();
                    conv_setA(F, args, 1, pidx, pcnt, 3);
                    REFRESH_LANE();
                    conv_setB(F, args, 1, pidx, pcnt);
                }
            }
        }
        if (kind == 3) {
            REFRESH_LANE();
            const bf16_t* P = WSP(bf16_t, WS_P); bf16_t* BR = WSP(bf16_t, WS_BR);
            const float* cw = args.in[I_CONVW] + l * 768; const float* cb_ = args.in[I_CONVB] + l * 256;
            const int cskip = (!last && F.G >= 128) ? 64 : 0;
            const int nrows = last ? ML : MT, gt = (F.vcu - cskip) * 512 + F.tid, NGT = (F.G - cskip) * 512;
            for (int idx = (F.vcu >= cskip) ? gt : nrows * 16; idx < nrows * 16; idx += NGT) {
                const int row = (idx >> 5) * 2, c8 = (idx & 31) * 8;
                const int L = row < ML ? SEQ : CTXL, t = row < ML ? (row & (SEQ - 1)) : ((row - ML) & (CTXL - 1));
                const bf16_t* pr = P + (size_t)row * LDP;
                const u32x4 b0v = *(const u32x4*)(pr + PCB + c8), b1v = *(const u32x4*)(pr + LDP + PCB + c8);
                const u32x4 c0 = *(const u32x4*)(pr + PCC + c8), x0 = *(const u32x4*)(pr + PCX + c8), c1 = *(const u32x4*)(pr + LDP + PCC + c8), x1 = *(const u32x4*)(pr + LDP + PCX + c8);
                u32x4 cm = (u32x4){0, 0, 0, 0}, xm = cm, cp = cm, xp = cm;
                if (t > 0) { cm = *(const u32x4*)(pr - LDP + PCC + c8); xm = *(const u32x4*)(pr - LDP + PCX + c8); }
                if (t + 1 < L - 1) { cp = *(const u32x4*)(pr + 2 * LDP + PCC + c8); xp = *(const u32x4*)(pr + 2 * LDP + PCX + c8); }
                unsigned o0[4], o1[4];
#pragma unroll
                for (int e = 0; e < 4; ++e) {
                    const int c = c8 + 2 * e;
                    const float w0l = cw[c], w1l = cw[256 + c], w2l = cw[512 + c], bl = cb_[c], w0h = cw[c + 1], w1h = cw[256 + c + 1], w2h = cw[512 + c + 1], bh = cb_[c + 1];
                    const float zml = bflo(cm[e]) * bflo(xm[e]), zmh = bfhi(cm[e]) * bfhi(xm[e]);
                    const float z0l = bflo(c0[e]) * bflo(x0[e]), z0h = bfhi(c0[e]) * bfhi(x0[e]);
                    const float z1l = bflo(c1[e]) * bflo(x1[e]), z1h = bfhi(c1[e]) * bfhi(x1[e]);
                    const float zpl = bflo(cp[e]) * bflo(xp[e]), zph = bfhi(cp[e]) * bfhi(xp[e]);
                    o0[e] = cvt_pk_bf16(bflo(b0v[e]) * (w0l * zml + w1l * z0l + w2l * z1l + bl), bfhi(b0v[e]) * (w0h * zmh + w1h * z0h + w2h * z1h + bh));
                    o1[e] = cvt_pk_bf16(bflo(b1v[e]) * (w0l * z0l + w1l * z1l + w2l * zpl + bl), bfhi(b1v[e]) * (w0h * z0h + w1h * z1h + w2h * zph + bh));
                }
                *(u32x4*)(BR + (size_t)row * 1024 + 256 + c8) = (u32x4){o0[0], o0[1], o0[2], o0[3]};
                *(u32x4*)(BR + (size_t)(row + 1) * 1024 + 256 + c8) = (u32x4){o1[0], o1[1], o1[2], o1[3]};
            }
        }
        const bool dup_again = (rep == 0) && (((DUP_MASK) >> kind) & 1);
        if (ph + 1 < args.ph_hi || dup_again) {
            if (args.ph_hi > 1000) cg::this_grid().sync();
            { XcdBarrier xbar; xbar.bar = (unsigned*)(ws + WS_BAR); xbar.x = xb_xcc_id(); xbar.st = (volatile LAS unsigned*)(F.lds + LDS_XB); xcd_barrier(xbar); }
        }
        if (dup_again) rep = 1; else { rep = 0; ++ph; }
    }
#undef WSP
}


#ifndef DBG_STOP
#define DBG_STOP N_PHASES
#endif
#ifndef DBG_DUMP
#define DBG_DUMP 0
#endif
__global__ void dbg_dump(const bf16_t* src, float* out, size_t n) {
    for (size_t i = (size_t)blockIdx.x * blockDim.x + threadIdx.x; i < n; i += (size_t)gridDim.x * blockDim.x) out[i] = __uint_as_float(((unsigned)src[i]) << 16);
}
extern "C" void kernel_launch(void* const* d_in, const int* in_sizes, int n_in, void* d_out, int out_size, void* d_ws, size_t ws_size, hipStream_t stream) {
    static int grid = 0;
    if (grid == 0) {
        if (n_in != 25 || in_sizes[0] != ML * D || out_size != ML * D || ws_size < WS_END) { fprintf(stderr, "kernel_launch: unexpected shapes (n_in %d, in0 %d, out %d, ws %zu)\n", n_in, n_in > 0 ? in_sizes[0] : -1, out_size, ws_size); grid = -1; return; }
        int dev = 0, cus = 0, per_cu = 0;
        hipGetDevice(&dev); hipDeviceGetAttribute(&cus, hipDeviceAttributeMultiprocessorCount, dev);
        if (hipFuncSetAttribute((const void*)fwd_kernel, hipFuncAttributeMaxDynamicSharedMemorySize, LDS_BYTES) != hipSuccess) { fprintf(stderr, "kernel_launch: hipFuncSetAttribute failed\n"); grid = -1; return; }
        if (hipOccupancyMaxActiveBlocksPerMultiprocessor(&per_cu, (const void*)fwd_kernel, 512, LDS_BYTES) != hipSuccess || per_cu < 1) { fprintf(stderr, "kernel_launch: occupancy query says %d\n", per_cu); per_cu = 1; }
        (void)hipGetLastError();
        grid = cus * 1;
        if (grid <= 0) grid = 256;
    }
    if (grid < 0) return;
    if (hipMemsetAsync((unsigned char*)d_ws + WS_BAR, 0, 16384, stream) != hipSuccess) { fprintf(stderr, "kernel_launch: memset failed\n"); return; }
    Args a{};
    for (int i = 0; i < 25; ++i) a.in[i] = (const float*)d_in[i];
    a.out = (float*)d_out; a.ws = (unsigned char*)d_ws;
#if MK_MULTI_LAUNCH
    for (int p = 0; p < DBG_STOP; ++p) {
        a.ph_lo = p; a.ph_hi = p + 1;
        hipLaunchKernelGGL(fwd_kernel, dim3(grid), dim3(512), LDS_BYTES, stream, a);
    }
#else
    a.ph_lo = 0; a.ph_hi = DBG_STOP;
    void* kargs[] = {&a};
    hipError_t e = hipLaunchCooperativeKernel((const void*)fwd_kernel, dim3(grid), dim3(512), kargs, LDS_BYTES, stream);
    if (e != hipSuccess) fprintf(stderr, "kernel_launch: cooperative launch failed: %s (grid %d)\n", hipGetErrorString(e), grid);
#endif
#if DBG_DUMP
    { const size_t off = DBG_DUMP == 1 ? WS_H : (DBG_DUMP == 2 ? WS_BR : (DBG_DUMP == 3 ? WS_P : WS_FT0));
      hipLaunchKernelGGL(dbg_dump, dim3(2048), dim3(256), 0, stream, (const bf16_t*)((unsigned char*)d_ws + off), (float*)d_out, (size_t)(DBG_DUMP == 4 ? 8 : 16) * 1024 * 1024); }
#endif
}
```
